# Optimizing an MI355X kernel written in HIP

```python
import jax, jax.numpy as jnp
from jax import lax
import numpy as np

D_MODEL = 1024
BATCH = 8
SEQ = 4096
DEPTH = 1

D_MIX = D_MODEL
D_RET = D_MIX // 2
D_POOL = D_MIX - D_RET
RET_HEADS = 8
RET_HEAD_DIM = D_RET // RET_HEADS
RET_CHUNK = 128
ROPE_BASE = 10000.0
POOL_WINDOWS = (2, 4, 8, 16)
POOL_GROUPS = len(POOL_WINDOWS)
POOL_GROUP_DIM = D_POOL // POOL_GROUPS
D_IN_PROJ = 4 * D_RET + D_POOL
N_EXPERTS = 32
TOP_K = 4
D_EXPERT = D_MODEL
SWIGLU_LIMIT = 7.0
SWIGLU_ALPHA = 1.702
PLE_DIM = 256
NORM_EPS = 1e-5
GN_EPS = 1e-5

kernel_name = "hybrid_retention_pool_moe_block"


def rms_norm(x, g):
    xf = x.astype(jnp.float32)
    y = xf * lax.rsqrt(jnp.mean(xf * xf, axis=-1, keepdims=True) + NORM_EPS)
    return (y * g.astype(jnp.float32)).astype(x.dtype)


def rope(x, positions):
    half = x.shape[-1] // 2
    inv_freq = ROPE_BASE ** (-jnp.arange(half, dtype=jnp.float32) / half)
    ang = positions.astype(jnp.float32)[..., None] * inv_freq
    cos = jnp.cos(ang)[:, :, None, :]
    sin = jnp.sin(ang)[:, :, None, :]
    xf = x.astype(jnp.float32)
    x1, x2 = xf[..., :half], xf[..., half:]
    out = jnp.concatenate([x1 * cos - x2 * sin, x2 * cos + x1 * sin], axis=-1)
    return out.astype(x.dtype)


def retention(q, k, v, gn_w):
    B, S, H, d = q.shape
    C = RET_CHUNK
    N = S // C
    log_gamma = jnp.log1p(-jnp.power(2.0, -5.0 - jnp.arange(H, dtype=jnp.float32)))
    qc = q.reshape(B, N, C, H, d)
    kc = (k * (d ** -0.5)).reshape(B, N, C, H, d)
    vc = v.reshape(B, N, C, H, d)
    idx = jnp.arange(C, dtype=jnp.float32)
    rel = idx[:, None] - idx[None, :]
    causal = rel >= 0
    decay = jnp.where(causal[None], jnp.exp(jnp.where(causal, rel, 0.0)[None] * log_gamma[:, None, None]), 0.0)
    scores = jnp.einsum('bnchd,bnmhd->bnhcm', qc, kc) * decay
    intra = jnp.einsum('bnhcm,bnmhd->bnchd', scores, vc)
    zeta = jnp.exp((C - 1 - idx)[None, :] * log_gamma[:, None])
    kv = jnp.einsum('bnmhd,hm,bnmhe->bnhde', kc, zeta, vc)
    chunk_decay = jnp.exp(C * log_gamma)[:, None, None]

    def step(state, kv_i):
        return chunk_decay * state + kv_i, state

    init = jnp.zeros((B, H, d, d), dtype=kv.dtype)
    _, states = lax.scan(step, init, jnp.moveaxis(kv, 1, 0))
    states = jnp.moveaxis(states, 0, 1)
    xi = jnp.exp((idx + 1.0)[None, :] * log_gamma[:, None])
    cross = jnp.einsum('bnchd,bnhde,hc->bnche', qc, states, xi)
    y = (intra + cross).reshape(B, S, H, d).astype(jnp.float32)
    mu = jnp.mean(y, axis=-1, keepdims=True)
    var = jnp.mean(jnp.square(y - mu), axis=-1, keepdims=True)
    y = (y - mu) * lax.rsqrt(var + GN_EPS)
    y = y.reshape(B, S, H * d) * gn_w.astype(jnp.float32)
    return y.astype(q.dtype)


def pool_mixer(u, w_pool, pool_scale):
    B, S, _ = u.shape
    ug = u.reshape(B, S, POOL_GROUPS, POOL_GROUP_DIM).astype(jnp.float32)
    P = jnp.pad(jnp.cumsum(ug, axis=1), ((0, 0), (1, 0), (0, 0), (0, 0)))
    t = jnp.arange(S, dtype=jnp.float32)
    outs = []
    for gi, w in enumerate(POOL_WINDOWS):
        Pg = P[:, :, gi]
        lag = jnp.pad(Pg, ((0, 0), (w, 0), (0, 0)))[:, :S + 1]
        window_sum = Pg[:, 1:] - lag[:, 1:]
        count = jnp.minimum(t + 1.0, float(w))
        outs.append(window_sum / count[None, :, None] - ug[:, :, gi])
    pooled = jnp.stack(outs, axis=2).astype(u.dtype)
    mixed = jnp.einsum('bsgc,gcd->bsgd', pooled, w_pool)
    return mixed.reshape(B, S, D_POOL) * pool_scale


def moe(hn, router_w, router_b, w_gu, b_gu, w_down, b_down):
    B, S, D = hn.shape
    xt = hn.reshape(-1, D)
    logits = xt.astype(jnp.float32) @ router_w.astype(jnp.float32) + router_b.astype(jnp.float32)
    top_vals, top_idx = lax.top_k(logits, TOP_K)
    gates = jax.nn.softmax(top_vals, axis=-1)
    flat_e = top_idx.reshape(-1)
    order = jnp.argsort(flat_e)
    sorted_e = flat_e[order]
    tok = order // TOP_K
    xs = xt[tok]
    group_sizes = jnp.bincount(flat_e, length=N_EXPERTS).astype(jnp.int32)
    gu = lax.ragged_dot(xs, w_gu, group_sizes) + b_gu[sorted_e]
    gate = jnp.minimum(gu[:, ::2], SWIGLU_LIMIT)
    up = jnp.clip(gu[:, 1::2], -SWIGLU_LIMIT, SWIGLU_LIMIT)
    act = (up + 1.0) * (gate * jax.nn.sigmoid(SWIGLU_ALPHA * gate))
    y = lax.ragged_dot(act.astype(w_down.dtype), w_down, group_sizes) + b_down[sorted_e]
    y = y * gates.reshape(-1)[order][:, None].astype(y.dtype)
    out = jnp.zeros_like(xt).at[tok].add(y.astype(xt.dtype))
    return out.reshape(B, S, D)


def setup_inputs(seed: int = 0) -> dict:
    key = jax.random.key(seed)
    ks = jax.random.split(key, 24)
    f32 = jnp.float32
    L = DEPTH

    def nrm(k, shape, scale):
        return jax.random.normal(k, shape, dtype=f32) * scale

    offsets = jax.random.randint(ks[2], (BATCH, 1), 0, 1024, dtype=jnp.int32)
    positions = (jnp.arange(SEQ, dtype=jnp.int32)[None, :] + offsets).astype(jnp.int32)
    return {
        "x": nrm(ks[0], (BATCH, SEQ, D_MODEL), 1.0),
        "p": nrm(ks[1], (DEPTH, BATCH, SEQ, PLE_DIM), 1.0),
        "positions": positions,
        "w_in": nrm(ks[3], (L, D_MODEL, D_IN_PROJ), D_MODEL ** -0.5),
        "w_out": nrm(ks[4], (L, D_MIX, D_MODEL), D_MIX ** -0.5),
        "ret_gn_w": 1.0 + nrm(ks[5], (L, D_RET), 0.02),
        "pool_w": nrm(ks[6], (L, POOL_GROUPS, POOL_GROUP_DIM, POOL_GROUP_DIM), POOL_GROUP_DIM ** -0.5),
        "pool_scale": 1.0 + nrm(ks[7], (L, D_POOL), 0.02),
        "norm_mix_w": 1.0 + nrm(ks[8], (L, D_MODEL), 0.02),
        "norm_moe_w": 1.0 + nrm(ks[9], (L, D_MODEL), 0.02),
        "router_w": nrm(ks[10], (L, D_MODEL, N_EXPERTS), D_MODEL ** -0.5),
        "router_b": nrm(ks[11], (L, N_EXPERTS), 0.01),
        "expert_w_gate_up": nrm(ks[12], (L, N_EXPERTS, D_MODEL, 2 * D_EXPERT), D_MODEL ** -0.5),
        "expert_b_gate_up": nrm(ks[13], (L, N_EXPERTS, 2 * D_EXPERT), 0.02),
        "expert_w_down": nrm(ks[14], (L, N_EXPERTS, D_EXPERT, D_MODEL), D_EXPERT ** -0.5),
        "expert_b_down": nrm(ks[15], (L, N_EXPERTS, D_MODEL), 0.02),
        "norm_ple_w": 1.0 + nrm(ks[16], (L, D_MODEL), 0.02),
        "ple_gate_w": nrm(ks[17], (L, D_MODEL, D_MODEL), D_MODEL ** -0.5),
        "ple_proj_w": nrm(ks[18], (L, PLE_DIM, D_MODEL), PLE_DIM ** -0.5),
        "final_norm_w": 1.0 + nrm(ks[19], (D_MODEL,), 0.02),
    }


def reference(x, p, positions, w_in, w_out, ret_gn_w, pool_w, pool_scale, norm_mix_w,
              norm_moe_w, router_w, router_b, expert_w_gate_up, expert_b_gate_up,
              expert_w_down, expert_b_down, norm_ple_w, ple_gate_w, ple_proj_w, final_norm_w):
    B, S, _ = x.shape
    h = x
    for l in range(DEPTH):
        hn = rms_norm(h, norm_mix_w[l])
        proj = hn @ w_in[l]
        q = proj[..., 0 * D_RET:1 * D_RET].reshape(B, S, RET_HEADS, RET_HEAD_DIM)
        k = proj[..., 1 * D_RET:2 * D_RET].reshape(B, S, RET_HEADS, RET_HEAD_DIM)
        v = proj[..., 2 * D_RET:3 * D_RET].reshape(B, S, RET_HEADS, RET_HEAD_DIM)
        g = proj[..., 3 * D_RET:4 * D_RET]
        u = proj[..., 4 * D_RET:]
        q = rope(q, positions)
        k = rope(k, positions)
        ret = jax.nn.silu(g) * retention(q, k, v, ret_gn_w[l])
        pool = pool_mixer(u, pool_w[l], pool_scale[l])
        h = h + jnp.concatenate([ret, pool], axis=-1) @ w_out[l]
        h = h + moe(rms_norm(h, norm_moe_w[l]), router_w[l], router_b[l],
                    expert_w_gate_up[l], expert_b_gate_up[l], expert_w_down[l], expert_b_down[l])
        gate = jax.nn.sigmoid(rms_norm(h, norm_ple_w[l]) @ ple_gate_w[l])
        h = h + gate * (p[l] @ ple_proj_w[l])
    return rms_norm(h, final_norm_w)
```

```cpp
#include <hip/hip_runtime.h>
#include <cstdio>
#include <cstdint>

#ifndef MK_PER_PHASE
#define MK_PER_PHASE 0
#endif
#ifndef MK_DEBUG
#define MK_DEBUG 0
#endif

#define GAS __attribute__((address_space(1)))
#define LAS __attribute__((address_space(3)))
typedef unsigned short bf16_t;
typedef short bf16x8 __attribute__((ext_vector_type(8)));
typedef float f32x4 __attribute__((ext_vector_type(4)));
typedef float f32x2 __attribute__((ext_vector_type(2)));
typedef unsigned u32x4 __attribute__((ext_vector_type(4)));
typedef unsigned u32x2 __attribute__((ext_vector_type(2)));

constexpr int T = 32768, D = 1024, SEQ = 4096, NBATCH = 8, NH = 8, HD = 64, CH = 128, NCH = 32;
constexpr int DRET = 512, DPOOL = 512, NIN = 2560, NE = 32, TOPK = 4, DE = 1024, PLE = 256;
constexpr float NORM_EPS = 1e-5f, GN_EPS = 1e-5f;
constexpr int MAXROWS = T * TOPK + NE * 256;
constexpr int MAXT = MAXROWS / 256;

constexpr size_t MiB = 1u << 20, KiB = 1u << 10;
constexpr size_t WS_CTL = 0, CTL_ZERO_BYTES = 64 * KiB;
constexpr size_t WS_ROUT = 1 * MiB, WS_PWT = 1 * MiB + 64 * KiB, WS_WPT = 1 * MiB + 256 * KiB;
constexpr size_t WS_TOPI = 2 * MiB, WS_TOPG = 2 * MiB + 512 * KiB, WS_SPOS = 3 * MiB, WS_RSTD1 = 3 * MiB + 512 * KiB, WS_RSTD2 = 3 * MiB + 640 * KiB, WS_BH = 3 * MiB + 768 * KiB;
constexpr size_t WS_SG = 4 * MiB, WS_SR = 5 * MiB, WS_SSQ1 = 6 * MiB, WS_VTAB = 8 * MiB;
constexpr size_t WS_WIN = 16 * MiB, WS_WOUT = 21 * MiB, WS_WG = 23 * MiB;
constexpr size_t WS_WGU = 32 * MiB, WS_WD = 160 * MiB, WS_PP = 224 * MiB;
constexpr size_t WS_HN1 = 288 * MiB  , WS_PB = 352 * MiB;
constexpr size_t WS_Q = 368 * MiB, WS_K = 400 * MiB, WS_V = 432 * MiB, WS_G = 464 * MiB, WS_U = 496 * MiB;
constexpr size_t WS_KV = 528 * MiB, WS_ST = 560 * MiB, WS_MIX = 576 * MiB;
constexpr size_t WS_ACT = 352 * MiB, WS_Y = 624 * MiB, WS_END = 896 * MiB;
static_assert(WS_K - WS_Q == (size_t)T * 512 * 2 && WS_V - WS_K == WS_K - WS_Q && WS_G - WS_V == WS_K - WS_Q && WS_U - WS_G == WS_K - WS_Q, "q|k|v|g|u equally spaced");
static_assert(WS_VTAB + (size_t)MAXT * 512 * 16 <= WS_WIN && WS_ACT + (size_t)MAXROWS * DE * 2 <= WS_Y && WS_Y + (size_t)MAXROWS * D * 2 <= WS_END, "ws map");
constexpr int CW_TMO = 0, CW_CODE = 1, CW_FAIL = 2, CW_TOT = 64, CW_BAR = 4096;

constexpr int VOFF_OFF = 131072;
constexpr int LCTL_OFF = 147456;
constexpr int LDS_BYTES = 151552;

#define LDS_WAIT() asm volatile("s_waitcnt lgkmcnt(0)" ::: "memory")
#define VM_WAIT() asm volatile("s_waitcnt vmcnt(0)" ::: "memory")
__device__ __forceinline__ unsigned cvt_pk_bf16(float lo, float hi) { unsigned r; asm volatile("v_cvt_pk_bf16_f32 %0, %1, %2" : "=v"(r) : "v"(lo), "v"(hi)); return r; }
__device__ __forceinline__ float bf_lo(unsigned w) { return __uint_as_float(w << 16); }
__device__ __forceinline__ float bf_hi(unsigned w) { return __uint_as_float(w & 0xffff0000u); }
__device__ __forceinline__ float wave_sum(float v) {
#pragma unroll
    for (int o = 1; o < 64; o <<= 1) v += __shfl_xor(v, o);
    return v;
}
__device__ __forceinline__ float sigmoidf_fast(float x) { return __builtin_amdgcn_rcpf(1.0f + __builtin_amdgcn_exp2f(-1.4426950408889634f * x)); }
__device__ __forceinline__ int lds_inc(LAS int* p) { return __hip_atomic_fetch_add(p, 1, __ATOMIC_RELAXED, __HIP_MEMORY_SCOPE_WORKGROUP); }
__device__ __forceinline__ float log2_gamma(int h) {
    const float x = __builtin_amdgcn_exp2f(-(float)(5 + h));
    const float ln = -x * (1.0f + x * (0.5f + x * (0.33333333f + x * (0.25f + x * 0.2f))));
    return ln * 1.4426950408889634f;
}

#define XB_TMO      128
#define XB_XCNT(j)  (256  + 64 * (j))
#define XB_XSUB(j)  (1280 + 64 * (j))
#define XB_XGEN(j)  (2304 + 64 * (j))
#define XB_TOP      3328
#define XB_TOPGEN   3392
#define XCD_BAR_WORDS 3456
#define XB_SPIN_CAP (1u << 18)
__device__ __forceinline__ unsigned xb_ld(unsigned* p)              { return __hip_atomic_load(p, __ATOMIC_RELAXED, __HIP_MEMORY_SCOPE_AGENT); }
__device__ __forceinline__ unsigned xb_add(unsigned* p, unsigned v) { return __hip_atomic_fetch_add(p, v, __ATOMIC_RELAXED, __HIP_MEMORY_SCOPE_AGENT); }
__device__ __forceinline__ unsigned xb_xcc_id() { return (unsigned)__builtin_amdgcn_s_getreg((3 << 11) | 20) & 0xFu; }
#define XB_SPIN(cond, bar) do { unsigned _sp = 0; while (cond) { __builtin_amdgcn_s_sleep(1); \
    if ((++_sp & 255u) == 0u) { if (xb_ld(&(bar)[XB_TMO])) break; if (_sp > XB_SPIN_CAP) { atomicAdd(&(bar)[XB_TMO], 1u); break; } } } } while (0)
struct XcdBarrier { unsigned* bar; unsigned x; volatile LAS unsigned* st; };
__device__ __forceinline__ XcdBarrier xcd_barrier_post(unsigned* bar, volatile LAS unsigned* st) {
    XcdBarrier b; b.bar = bar; b.x = xb_xcc_id(); b.st = st;
    if (threadIdx.x == 0) (void)xb_add(&bar[XB_XCNT(b.x)], 1u);
    return b;
}
__device__ __forceinline__ void xcd_barrier_complete(unsigned* bar, unsigned x, unsigned& nloc, unsigned& nx) {
    const unsigned G = gridDim.x * gridDim.y * gridDim.z;
    unsigned sum, cnt, mine, sp = 0u;
    for (;;) {
        sum = 0u; cnt = 0u; mine = 0u;
#pragma unroll
        for (unsigned j = 0; j < 16; ++j) { const unsigned c = xb_ld(&bar[XB_XCNT(j)]); sum += c; cnt += (c > 0u) ? 1u : 0u; mine = (j == x) ? c : mine; }
        if (sum == G) break;
        __builtin_amdgcn_s_sleep(1);
        if ((++sp & 255u) == 0u) { if (xb_ld(&bar[XB_TMO])) break; if (sp > XB_SPIN_CAP) { atomicAdd(&bar[XB_TMO], 1u); break; } }
    }
    nloc = mine > 0u ? mine : 1u; nx = cnt > 0u ? cnt : 1u;
}
__device__ __forceinline__ void xcd_barrier(const XcdBarrier& b) {
    asm volatile("s_waitcnt vmcnt(0)" ::: "memory");
    __syncthreads();
    if (threadIdx.x == 0) {
        unsigned* bar = b.bar;
        __builtin_amdgcn_s_waitcnt(0);
        unsigned nloc = b.st[0], nx = b.st[1];
        if (nloc == 0u) { xcd_barrier_complete(bar, b.x, nloc, nx); b.st[0] = nloc; b.st[1] = nx; }
        const unsigned old = xb_add(&bar[XB_XSUB(b.x)], 1u);
        const unsigned gen = old / nloc;
        if (old + 1u == (gen + 1u) * nloc) {
            __builtin_amdgcn_fence(__ATOMIC_RELEASE, "agent");
            asm volatile("s_waitcnt vmcnt(0)" ::: "memory");
            const unsigned og = xb_add(&bar[XB_TOP], 1u);
            const unsigned tg = og / nx;
            if (og + 1u == (tg + 1u) * nx) xb_add(&bar[XB_TOPGEN], 1u);
            else XB_SPIN(xb_ld(&bar[XB_TOPGEN]) == tg, bar);
            __builtin_amdgcn_fence(__ATOMIC_ACQUIRE, "agent");
            xb_add(&bar[XB_XGEN(b.x)], 1u);
            asm volatile("s_waitcnt vmcnt(0)" ::: "memory");
        } else {
            XB_SPIN(xb_ld(&bar[XB_XGEN(b.x)]) == gen, bar);
            __builtin_amdgcn_fence(__ATOMIC_ACQUIRE, "agent");
            asm volatile("s_waitcnt vmcnt(0)" ::: "memory");
        }
    }
    __syncthreads();
}

namespace pg8 {
constexpr int BM = 256, BK = 64, HALF = 128, HTB = HALF * BK * 2, STAGE_BYTES = 8 * HTB, NXCD = 8, WGM = 8;
__host__ __device__ __forceinline__ int lds_byte(int r, int c) { const int st = (r >> 4) * 2 + (c >> 5), rr = r & 15, cc = c & 31, ob = rr * 64 + cc * 2; return st * 1024 + (ob ^ (((ob >> 9) & 1) << 5)); }
__host__ __device__ __forceinline__ void stage_rc(int b, int& R, int& C) { const int st = b / 1024, sb = b % 1024, swz = sb ^ (((sb >> 9) & 1) << 5); R = (st >> 1) * 16 + swz / 64; C = (st & 1) * 32 + (swz % 64) / 2; }
__host__ __device__ __forceinline__ int perm32(int rho) { const int n = rho >> 4, i = rho & 15; return 8 * (i >> 2) + 4 * n + (i & 3); }
struct Unit { int pm, pn, e; };
__device__ __forceinline__ bool order_next(int i, int G, int c, int nM, int nN, int& pm, int& pn) {
    const int nwg = nM * nN; const long L = (long)i * G + c; if (L >= nwg) return false;
    int wgid = (int)L; { const int q = nwg / NXCD, r = nwg % NXCD, xcd = wgid % NXCD, off = wgid / NXCD; wgid = (xcd < r ? xcd * (q + 1) : r * (q + 1) + (xcd - r) * q) + off; }
    const int nig = WGM * nN, gid = wgid / nig, fm = gid * WGM, gsz = (nM - fm) < WGM ? (nM - fm) : WGM;
    pm = fm + ((wgid % nig) % gsz); pn = (wgid % nig) / gsz; return true;
}
struct DenseSched {
    static constexpr bool GATHER = false;
    int nM, nN, G, c; const unsigned char* vtab;
    __device__ __forceinline__ void init(int M, int N, int G_, int c_) { nM = M / BM; nN = N / BM; G = G_; c = c_; vtab = nullptr; }
    __device__ __forceinline__ bool next(int i, Unit& u) const { u.e = 0; return order_next(i, G, c, nM, nN, u.pm, u.pn); }
    __device__ __forceinline__ size_t b_off(const Unit& u, int K) const { return (size_t)u.pn * BM * K * 2; }
};
struct GroupSched {
    static constexpr bool GATHER_ = false;
    int nM, nN, G, c, NB; const LAS unsigned short* te; const unsigned char* vtab;
    __device__ __forceinline__ bool next(int i, Unit& u) const { if (!order_next(i, G, c, nM, nN, u.pm, u.pn)) return false; u.e = __builtin_amdgcn_readfirstlane((int)te[u.pm]); return true; }
    __device__ __forceinline__ size_t b_off(const Unit& u, int K) const { return ((size_t)u.e * NB + (size_t)u.pn * BM) * K * 2; }
};
struct GroupSchedG : GroupSched { static constexpr bool GATHER = true; };
struct GroupSchedD : GroupSched { static constexpr bool GATHER = false; };

template <class Epi, class Sched>
__device__ __forceinline__ void gemm_phase(LAS unsigned char* lds, const char* A, const char* Bt, const int K, const Sched& S, const Epi& E) {
    const int tid = threadIdx.x, wid = __builtin_amdgcn_readfirstlane(tid >> 6), lane = tid & 63, wr = wid >> 2, wc = wid & 3, fr = lane & 15, fq = lane >> 4;
    const int nt = K / BK;
    unsigned voffB[2], cA[2]; int RA[2];
#pragma unroll
    for (int i = 0; i < 2; ++i) { int R, C; stage_rc(tid * 16 + i * 8192, R, C); const int Rb = Epi::PERM ? ((R & ~31) + perm32(R & 31)) : R;
        RA[i] = R; cA[i] = (unsigned)C * 2u; voffB[i] = (unsigned)(Rb * K + C) * 2u; }
    const size_t kstep = (size_t)(BK * 2);
    const size_t hstep = (size_t)HALF * K * 2;
    const unsigned ldsw = (unsigned)wid * 1024u;
    const int aoff = lds_byte(wr * 64 + fr, fq * 8), boff = lds_byte(wc * 32 + fr, fq * 8);
#define PG8_SA(b, h) (((b) * 2 + (h)) * HTB)
#define PG8_SB(b, h) ((4 + (b) * 2 + (h)) * HTB)
#define PG8_STAGE(bufoff, gbase, voff) do { _Pragma("unroll") for (int _i = 0; _i < 2; ++_i) \
        __builtin_amdgcn_global_load_lds((const unsigned*)((const char*)(gbase) + (voff)[_i]), (LAS unsigned*)(lds + (bufoff) + ldsw + _i * 8192), 16, 0, 0); } while (0)
#define PG8_LDA(dst, b, h) do { _Pragma("unroll") for (int m = 0; m < 4; ++m) _Pragma("unroll") for (int k = 0; k < 2; ++k) dst[m][k] = *(const LAS bf16x8*)(lds + PG8_SA(b, h) + aoff + m * 2048 + k * 1024); } while (0)
#define PG8_LDB(dst, b, h) do { _Pragma("unroll") for (int n = 0; n < 2; ++n) _Pragma("unroll") for (int k = 0; k < 2; ++k) dst[n][k] = *(const LAS bf16x8*)(lds + PG8_SB(b, h) + boff + n * 2048 + k * 1024); } while (0)
#define PG8_MMA(ai, bj, At, Bt_) do { __builtin_amdgcn_s_setprio(1); _Pragma("unroll") for (int m = 0; m < 4; ++m) _Pragma("unroll") for (int n = 0; n < 2; ++n) _Pragma("unroll") for (int k = 0; k < 2; ++k) \
        acc[ai][bj][m][n] = __builtin_amdgcn_mfma_f32_16x16x32_bf16(Bt_[n][k], At[m][k], acc[ai][bj][m][n], 0, 0, 0); __builtin_amdgcn_s_setprio(0); } while (0)
#define PG8_WAIT_V(n) asm volatile("s_waitcnt vmcnt(" #n ")" ::: "memory")
#define PG8_WAIT_L(n) asm volatile("s_waitcnt lgkmcnt(" #n ")" ::: "memory")
#define PG8_BAR __builtin_amdgcn_s_barrier()
#define PG8_SCHED __builtin_amdgcn_sched_barrier(0)
#define PG8_DENSE_V(v, u) do { _Pragma("unroll") for (int _h = 0; _h < 2; ++_h) _Pragma("unroll") for (int _i = 0; _i < 2; ++_i) (v)[_h][_i] = (unsigned)((u).pm * BM + _h * HALF + RA[_i]) * (unsigned)(K * 2) + cA[_i]; } while (0)
    Unit cur, nxt; int ui = 0;
    if (!S.next(0, cur)) return;
    f32x4 acc[2][2][4][2];
#pragma unroll
    for (int a = 0; a < 2; ++a)
#pragma unroll
        for (int b = 0; b < 2; ++b)
#pragma unroll
            for (int m = 0; m < 4; ++m)
#pragma unroll
                for (int n = 0; n < 2; ++n) acc[a][b][m][n] = (f32x4){0.f, 0.f, 0.f, 0.f};
    bf16x8 At[4][2], B0[2][2], B1[2][2];
    unsigned vc[2][2], v2[2][2];
    if constexpr (Sched::GATHER) {
        __builtin_amdgcn_global_load_lds((const unsigned*)(S.vtab + ((size_t)cur.pm * 512 + tid) * 16), (LAS unsigned*)(lds + VOFF_OFF + ldsw), 16, 0, 0);
        PG8_WAIT_V(0);
        const u32x4 tv = *(const LAS u32x4*)(lds + VOFF_OFF + tid * 16); vc[0][0] = tv.x; vc[0][1] = tv.y; vc[1][0] = tv.z; vc[1][1] = tv.w;
    } else { PG8_DENSE_V(vc, cur); }
    const char* cB = Bt + S.b_off(cur, K);
    PG8_STAGE(PG8_SB(0, 0), cB, voffB); PG8_STAGE(PG8_SB(0, 1), cB + hstep, voffB); PG8_STAGE(PG8_SA(0, 0), A, vc[0]); PG8_STAGE(PG8_SA(0, 1), A, vc[1]);
    if (wr == 1) PG8_BAR;
    PG8_WAIT_V(2); PG8_BAR;
    PG8_STAGE(PG8_SB(1, 0), cB + kstep, voffB); PG8_STAGE(PG8_SA(1, 0), A + kstep, vc[0]); PG8_STAGE(PG8_SB(1, 1), cB + hstep + kstep, voffB);
    PG8_WAIT_V(6); PG8_BAR;
    for (;;) {
        const bool has_next = S.next(ui + 1, nxt);
        const char* nB = has_next ? Bt + S.b_off(nxt, K) : cB;
        unsigned dlt = 0u;
        if (has_next) {
            if constexpr (Sched::GATHER) __builtin_amdgcn_global_load_lds((const unsigned*)(S.vtab + ((size_t)nxt.pm * 512 + tid) * 16), (LAS unsigned*)(lds + VOFF_OFF + ((ui + 1) & 1) * 8192 + ldsw), 16, 0, 0);
            else dlt = (unsigned)(nxt.pm - cur.pm) * (unsigned)(BM * K * 2);
        }
#pragma nounroll
        for (int t = 0; t < nt; t += 2) {
            const bool last = (t == nt - 2);
#pragma unroll
            for (int h = 0; h < 2; ++h) { v2[h][0] = vc[h][0]; v2[h][1] = vc[h][1]; }
            if (last && has_next) {
                if constexpr (Sched::GATHER) { const u32x4 tv = *(const LAS u32x4*)(lds + VOFF_OFF + ((ui + 1) & 1) * 8192 + tid * 16); v2[0][0] = tv.x; v2[0][1] = tv.y; v2[1][0] = tv.z; v2[1][1] = tv.w; }
                else {
#pragma unroll
                    for (int h = 0; h < 2; ++h) { v2[h][0] += dlt; v2[h][1] += dlt; } }
            }
            const char* a1 = A + (size_t)(t + 1) * kstep;
            const char* a2 = last ? A : A + (size_t)(t + 2) * kstep; const char* b2 = last ? nB : cB + (size_t)(t + 2) * kstep;
            const char* a3 = a2 + kstep; const char* b3 = b2 + kstep;
            PG8_LDB(B0, 0, 0); PG8_LDB(B1, 0, 1); PG8_SCHED; PG8_LDA(At, 0, 0); PG8_STAGE(PG8_SA(1, 1), a1, vc[1]);
            PG8_WAIT_V(8); PG8_WAIT_L(0); PG8_BAR; PG8_MMA(0, 0, At, B0); PG8_MMA(0, 1, At, B1); PG8_BAR; PG8_SCHED;
            PG8_LDA(At, 0, 1); PG8_STAGE(PG8_SB(0, 0), b2, voffB); PG8_STAGE(PG8_SB(0, 1), b2 + hstep, voffB); PG8_STAGE(PG8_SA(0, 0), a2, v2[0]);
            PG8_WAIT_V(8); PG8_WAIT_L(0); PG8_BAR; PG8_MMA(1, 0, At, B0); PG8_MMA(1, 1, At, B1); PG8_BAR; PG8_SCHED;
            PG8_LDB(B0, 1, 0); PG8_LDB(B1, 1, 1); PG8_SCHED; PG8_LDA(At, 1, 0); PG8_STAGE(PG8_SA(0, 1), a2, v2[1]);
            PG8_WAIT_V(8); PG8_WAIT_L(0); PG8_BAR; PG8_MMA(0, 0, At, B0); PG8_MMA(0, 1, At, B1); PG8_BAR; PG8_SCHED;
            PG8_LDA(At, 1, 1); PG8_STAGE(PG8_SB(1, 0), b3, voffB); PG8_STAGE(PG8_SB(1, 1), b3 + hstep, voffB); PG8_STAGE(PG8_SA(1, 0), a3, v2[0]);
            PG8_WAIT_V(8); PG8_WAIT_L(0); PG8_BAR; PG8_MMA(1, 0, At, B0); PG8_MMA(1, 1, At, B1); PG8_BAR; PG8_SCHED;
        }
        if (wr == 0) PG8_BAR;
        E(acc, cur, wr, wc, fr, fq);
        if (!has_next) break;
#pragma unroll
        for (int a = 0; a < 2; ++a)
#pragma unroll
            for (int b = 0; b < 2; ++b)
#pragma unroll
                for (int m = 0; m < 4; ++m)
#pragma unroll
                    for (int n = 0; n < 2; ++n) acc[a][b][m][n] = (f32x4){0.f, 0.f, 0.f, 0.f};
        cur = nxt; cB = nB; ++ui;
#pragma unroll
        for (int h = 0; h < 2; ++h) { vc[h][0] = v2[h][0]; vc[h][1] = v2[h][1]; }
        if (wr == 1) PG8_BAR;
    }
    PG8_WAIT_V(0);
    PG8_BAR;
#undef PG8_SA
#undef PG8_SB
#undef PG8_STAGE
#undef PG8_LDA
#undef PG8_LDB
#undef PG8_MMA
#undef PG8_WAIT_V
#undef PG8_WAIT_L
#undef PG8_BAR
#undef PG8_SCHED
#undef PG8_DENSE_V
}

typedef f32x4 Acc[2][2][4][2];
struct EpiInProj {
    static constexpr bool PERM = true;
    bf16_t* Q; const int* pos;
    __device__ __forceinline__ void operator()(const Acc& acc, const Unit& u, int wr, int wc, int fr, int fq) const {
        const int sec = u.pn >> 1, hf = u.pn & 1, row0 = u.pm * BM + wr * 64 + fr;
        if (sec >= 2) {
            bf16_t* base = Q + (size_t)sec * (size_t)(T * 512);
            const int col0 = hf * 256 + wc * 32 + 8 * fq;
#pragma unroll
            for (int ai = 0; ai < 2; ++ai)
#pragma unroll
                for (int m = 0; m < 4; ++m) { bf16_t* rowp = base + (size_t)(row0 + ai * HALF + m * 16) * 512 + col0;
#pragma unroll
                    for (int bj = 0; bj < 2; ++bj) { const f32x4 v0 = acc[ai][bj][m][0], v1 = acc[ai][bj][m][1];
                        u32x4 w; w.x = cvt_pk_bf16(v0[0], v0[1]); w.y = cvt_pk_bf16(v0[2], v0[3]); w.z = cvt_pk_bf16(v1[0], v1[1]); w.w = cvt_pk_bf16(v1[2], v1[3]);
                        *(u32x4*)(rowp + bj * HALF) = w; } }
        } else {
            bf16_t* base = Q + (size_t)sec * (size_t)(T * 512);
            const int head = hf * 4 + wc;
            const float lg = log2_gamma(head);
#pragma unroll
            for (int ai = 0; ai < 2; ++ai)
#pragma unroll
                for (int m = 0; m < 4; ++m) {
                    const int row = row0 + ai * HALF + m * 16; const float p = (float)pos[row]; const float c = (float)(row & (CH - 1));
                    const float sc = sec == 0 ? __builtin_amdgcn_exp2f(c * lg) : __builtin_amdgcn_exp2f(-c * lg) * 0.125f;
                    bf16_t* rowp = base + (size_t)row * 512 + head * 64 + 8 * fq;
#pragma unroll
                    for (int n = 0; n < 2; ++n) { float o1[4], o2[4];
#pragma unroll
                        for (int j = 0; j < 4; ++j) { const float ifr = __builtin_amdgcn_exp2f(-(float)(8 * fq + 4 * n + j) * (13.287712379549449f / 32.0f)) * 0.15915494309189535f;
                            const float rev = __builtin_amdgcn_fractf(p * ifr); const float sn = __builtin_amdgcn_sinf(rev), cs = __builtin_amdgcn_cosf(rev);
                            const float x1 = acc[ai][0][m][n][j], x2 = acc[ai][1][m][n][j];
                            o1[j] = (x1 * cs - x2 * sn) * sc; o2[j] = (x2 * cs + x1 * sn) * sc; }
                        u32x2 w; w.x = cvt_pk_bf16(o1[0], o1[1]); w.y = cvt_pk_bf16(o1[2], o1[3]); *(u32x2*)(rowp + 4 * n) = w;
                        w.x = cvt_pk_bf16(o2[0], o2[1]); w.y = cvt_pk_bf16(o2[2], o2[3]); *(u32x2*)(rowp + 32 + 4 * n) = w; }
                }
        }
    }
};
struct EpiPlainBf16 {
    static constexpr bool PERM = true;
    bf16_t* O; int ldc;
    __device__ __forceinline__ void operator()(const Acc& acc, const Unit& u, int wr, int wc, int fr, int fq) const {
        const int row0 = u.pm * BM + wr * 64 + fr, col0 = u.pn * BM + wc * 32 + 8 * fq;
#pragma unroll
        for (int ai = 0; ai < 2; ++ai)
#pragma unroll
            for (int m = 0; m < 4; ++m) { bf16_t* rowp = O + (size_t)(row0 + ai * HALF + m * 16) * ldc + col0;
#pragma unroll
                for (int bj = 0; bj < 2; ++bj) { const f32x4 v0 = acc[ai][bj][m][0], v1 = acc[ai][bj][m][1];
                    u32x4 w; w.x = cvt_pk_bf16(v0[0], v0[1]); w.y = cvt_pk_bf16(v0[2], v0[3]); w.z = cvt_pk_bf16(v1[0], v1[1]); w.w = cvt_pk_bf16(v1[2], v1[3]);
                    *(u32x4*)(rowp + bj * HALF) = w; } }
    }
};
struct EpiWout {
    static constexpr bool PERM = false;
    const float* x; float* h1; bf16_t* h1w; const float* nw; float* ssq;
    __device__ __forceinline__ void operator()(const Acc& acc, const Unit& u, int wr, int wc, int fr, int fq) const {
        const int row0 = u.pm * BM + wr * 64 + fr, col0 = u.pn * BM + wc * 32 + 4 * fq;
        f32x4 wv[2][2];
#pragma unroll
        for (int bj = 0; bj < 2; ++bj)
#pragma unroll
            for (int n = 0; n < 2; ++n) wv[bj][n] = *(const f32x4*)(nw + col0 + bj * HALF + n * 16);
#pragma unroll
        for (int ai = 0; ai < 2; ++ai)
#pragma unroll
            for (int m = 0; m < 4; ++m) { const int row = row0 + ai * HALF + m * 16; const size_t off = (size_t)row * D + col0; float s = 0.f;
#pragma unroll
                for (int bj = 0; bj < 2; ++bj)
#pragma unroll
                    for (int n = 0; n < 2; ++n) { const f32x4 xv = *(const f32x4*)(x + off + bj * HALF + n * 16); const f32x4 h = acc[ai][bj][m][n] + xv;
                        *(f32x4*)(h1 + off + bj * HALF + n * 16) = h; s += (h[0] * h[0] + h[1] * h[1]) + (h[2] * h[2] + h[3] * h[3]);
                        const f32x4 hw = h * wv[bj][n]; u32x2 w; w.x = cvt_pk_bf16(hw[0], hw[1]); w.y = cvt_pk_bf16(hw[2], hw[3]);
                        *(u32x2*)(h1w + off + bj * HALF + n * 16) = w; }
                s += __shfl_xor(s, 16); s += __shfl_xor(s, 32);
                if (fq == 0) ssq[(size_t)row * 16 + u.pn * 4 + wc] = s;
                if (m & 1) asm volatile("" ::: "memory"); }
    }
};
struct EpiGateUp {
    static constexpr bool PERM = true;
    bf16_t* act; const float* bgu; const float* sr;
    __device__ __forceinline__ void operator()(const Acc& acc, const Unit& u, int wr, int wc, int fr, int fq) const {
        const int prow0 = u.pm * BM + wr * 64 + fr, acol = u.pn * 128 + wc * 32 + 8 * fq;
        const float* bp = bgu + (size_t)u.e * (2 * DE) + 2 * acol;
        f32x4 b4[4];
#pragma unroll
        for (int q = 0; q < 4; ++q) b4[q] = *(const f32x4*)(bp + 4 * q);
#pragma unroll
        for (int ai = 0; ai < 2; ++ai)
#pragma unroll
            for (int m = 0; m < 4; ++m) { const int prow = prow0 + ai * HALF + m * 16; const float r = sr[prow]; float o[8];
#pragma unroll
                for (int q = 0; q < 8; ++q) { float g = r * acc[ai][0][m][q >> 2][q & 3] + b4[q >> 1][(q & 1) * 2], up = r * acc[ai][1][m][q >> 2][q & 3] + b4[q >> 1][(q & 1) * 2 + 1];
                    g = fminf(g, 7.0f); up = fminf(fmaxf(up, -7.0f), 7.0f); o[q] = (up + 1.0f) * g * sigmoidf_fast(1.702f * g); }
                u32x4 w; w.x = cvt_pk_bf16(o[0], o[1]); w.y = cvt_pk_bf16(o[2], o[3]); w.z = cvt_pk_bf16(o[4], o[5]); w.w = cvt_pk_bf16(o[6], o[7]);
                *(u32x4*)(act + (size_t)prow * DE + acol) = w; }
    }
};
struct EpiDown {
    static constexpr bool PERM = true;
    bf16_t* y; const float* bd; const float* sg;
    __device__ __forceinline__ void operator()(const Acc& acc, const Unit& u, int wr, int wc, int fr, int fq) const {
        const int prow0 = u.pm * BM + wr * 64 + fr, col0 = u.pn * BM + wc * 32 + 8 * fq;
        const float* bp = bd + (size_t)u.e * D + col0;
        f32x4 bv[2][2];
#pragma unroll
        for (int bj = 0; bj < 2; ++bj)
#pragma unroll
            for (int n = 0; n < 2; ++n) bv[bj][n] = *(const f32x4*)(bp + bj * HALF + 4 * n);
#pragma unroll
        for (int ai = 0; ai < 2; ++ai)
#pragma unroll
            for (int m = 0; m < 4; ++m) { const int prow = prow0 + ai * HALF + m * 16; const float gw = sg[prow]; bf16_t* rowp = y + (size_t)prow * D + col0;
#pragma unroll
                for (int bj = 0; bj < 2; ++bj) { const f32x4 v0 = (acc[ai][bj][m][0] + bv[bj][0]) * gw, v1 = (acc[ai][bj][m][1] + bv[bj][1]) * gw;
                    u32x4 w; w.x = cvt_pk_bf16(v0[0], v0[1]); w.y = cvt_pk_bf16(v0[2], v0[3]); w.z = cvt_pk_bf16(v1[0], v1[1]); w.w = cvt_pk_bf16(v1[2], v1[3]);
                    *(u32x4*)(rowp + bj * HALF) = w; } }
    }
};
struct EpiPle {
    static constexpr bool PERM = true;
    float* h; const bf16_t* pp; const float* rstd2;
    __device__ __forceinline__ void operator()(const Acc& acc, const Unit& u, int wr, int wc, int fr, int fq) const {
        const int row0 = u.pm * BM + wr * 64 + fr, col0 = u.pn * BM + wc * 32 + 8 * fq;
#pragma unroll
        for (int ai = 0; ai < 2; ++ai)
#pragma unroll
            for (int m = 0; m < 4; ++m) { const int row = row0 + ai * HALF + m * 16; const float r = rstd2[row]; const size_t off = (size_t)row * D + col0;
#pragma unroll
                for (int bj = 0; bj < 2; ++bj) { const u32x4 pw = *(const u32x4*)(pp + off + bj * HALF);
                    const f32x4 h0 = *(const f32x4*)(h + off + bj * HALF), h1 = *(const f32x4*)(h + off + bj * HALF + 4);
                    const f32x4 a0 = acc[ai][bj][m][0] * r, a1 = acc[ai][bj][m][1] * r; f32x4 o0, o1;
                    o0[0] = h0[0] + sigmoidf_fast(a0[0]) * bf_lo(pw.x); o0[1] = h0[1] + sigmoidf_fast(a0[1]) * bf_hi(pw.x); o0[2] = h0[2] + sigmoidf_fast(a0[2]) * bf_lo(pw.y); o0[3] = h0[3] + sigmoidf_fast(a0[3]) * bf_hi(pw.y);
                    o1[0] = h1[0] + sigmoidf_fast(a1[0]) * bf_lo(pw.z); o1[1] = h1[1] + sigmoidf_fast(a1[1]) * bf_hi(pw.z); o1[2] = h1[2] + sigmoidf_fast(a1[2]) * bf_lo(pw.w); o1[3] = h1[3] + sigmoidf_fast(a1[3]) * bf_hi(pw.w);
                    *(f32x4*)(h + off + bj * HALF) = o0; *(f32x4*)(h + off + bj * HALF + 4) = o1; }
                if (m & 1) asm volatile("" ::: "memory"); }
    }
};
}

struct Args { const void* in[20]; float* out; unsigned char* ws; int ph_lo, ph_hi; };
enum { I_X = 0, I_P, I_POS, I_WIN, I_WOUT, I_GNW, I_POOLW, I_POOLS, I_NMIX, I_NMOE, I_RW, I_RB, I_WGU, I_BGU, I_WD, I_BD, I_NPLE, I_WG, I_WP, I_NFIN };
constexpr int NPH = 13;

enum { WK_PLAIN = 0, WK_WIN = 1, WK_GU = 2 };
template <int KIND> __device__ __forceinline__ int dst_row(int c) {
    if (KIND == WK_WIN) { if (c < 1024) { const int sec = c >> 9, within = c & 511, head = within >> 6, d = within & 63; return (sec * 2 + (head >> 2)) * 256 + (d >> 5) * 128 + (head & 3) * 32 + (d & 31); } return c; }
    if (KIND == WK_GU) { const int a = c >> 1; return (a >> 7) * 256 + (c & 1) * 128 + (a & 127); }
    return c;
}
template <int KIND> __device__ __forceinline__ void tr_item(const float* W, int K, int N, bf16_t* WT, LAS float* scr, int kb, int cb, int lane) {
    const int k0 = 64 * kb, c0 = 64 * cb; const bool ok = (c0 + lane) < N;
    const float* src = W + (size_t)k0 * N + c0 + lane;
#pragma unroll 16
    for (int kk = 0; kk < 64; ++kk) scr[kk * 65 + lane] = ok ? src[(size_t)kk * N] : 0.f;
    LDS_WAIT(); asm volatile("" ::: "memory");
    const int c = lane & 7;
#pragma unroll
    for (int w = 0; w < 8; ++w) { const int r = (lane >> 3) + 8 * w; const LAS float* s = scr + (8 * c) * 65 + r;
        u32x4 o; o.x = cvt_pk_bf16(s[0 * 65], s[1 * 65]); o.y = cvt_pk_bf16(s[2 * 65], s[3 * 65]); o.z = cvt_pk_bf16(s[4 * 65], s[5 * 65]); o.w = cvt_pk_bf16(s[6 * 65], s[7 * 65]);
        if (c0 + r < N) *(u32x4*)(WT + (size_t)dst_row<KIND>(c0 + r) * K + k0 + 8 * c) = o; }
    LDS_WAIT(); asm volatile("" ::: "memory");
}
__device__ __forceinline__ void phase_prologue(const Args& a, LAS unsigned char* lds, int vcu, int G) {
    const int tid = threadIdx.x, lane = tid & 63, wave = __builtin_amdgcn_readfirstlane(tid >> 6);
    LAS float* scr = (LAS float*)(lds + wave * 16640);
    const int gw = vcu * 8 + wave, NGW = G * 8;
    unsigned char* ws = a.ws;
    constexpr int I_GU = NE * 16 * 32, I_DN = NE * 16 * 16, I_WINI = 16 * 40, I_SQ = 16 * 16, I_WPI = 4 * 16, I_RT = 16, I_PW = 4 * 4;
    constexpr int NITEMS = I_GU + I_DN + I_WINI + 2 * I_SQ + I_WPI + I_RT + I_PW;
    for (int it = gw; it < NITEMS; it += NGW) {
        int r = it;
        if (r < I_GU) { const int e = r / 512, q = r % 512; tr_item<WK_GU>((const float*)a.in[I_WGU] + (size_t)e * D * 2 * DE, D, 2 * DE, (bf16_t*)(ws + WS_WGU) + (size_t)e * 2 * DE * D, scr, q / 32, q % 32, lane); continue; } r -= I_GU;
        if (r < I_DN) { const int e = r / 256, q = r % 256; tr_item<WK_PLAIN>((const float*)a.in[I_WD] + (size_t)e * DE * D, DE, D, (bf16_t*)(ws + WS_WD) + (size_t)e * D * DE, scr, q / 16, q % 16, lane); continue; } r -= I_DN;
        if (r < I_WINI) { tr_item<WK_WIN>((const float*)a.in[I_WIN], D, NIN, (bf16_t*)(ws + WS_WIN), scr, r / 40, r % 40, lane); continue; } r -= I_WINI;
        if (r < I_SQ) { tr_item<WK_PLAIN>((const float*)a.in[I_WOUT], D, D, (bf16_t*)(ws + WS_WOUT), scr, r / 16, r % 16, lane); continue; } r -= I_SQ;
        if (r < I_SQ) { tr_item<WK_PLAIN>((const float*)a.in[I_WG], D, D, (bf16_t*)(ws + WS_WG), scr, r / 16, r % 16, lane); continue; } r -= I_SQ;
        if (r < I_WPI) { tr_item<WK_PLAIN>((const float*)a.in[I_WP], PLE, D, (bf16_t*)(ws + WS_WPT), scr, r / 16, r % 16, lane); continue; } r -= I_WPI;
        if (r < I_RT) { tr_item<WK_PLAIN>((const float*)a.in[I_RW], D, NE, (bf16_t*)(ws + WS_ROUT), scr, r, 0, lane); continue; } r -= I_RT;
        { const int g = r / 4, q = r % 4; tr_item<WK_PLAIN>((const float*)a.in[I_POOLW] + (size_t)g * 128 * 128, 128, 128, (bf16_t*)(ws + WS_PWT) + (size_t)g * 128 * 128, scr, q / 2, q % 2, lane); }
    }
    const float* x = (const float*)a.in[I_X]; const float* nw = (const float*)a.in[I_NMIX]; bf16_t* hn = (bf16_t*)(ws + WS_HN1);
    f32x4 wv[4];
#pragma unroll
    for (int j = 0; j < 4; ++j) wv[j] = *((const f32x4*)nw + lane + 64 * j);
    for (int m = gw; m < T; m += NGW) {
        const f32x4* xr = (const f32x4*)(x + (size_t)m * D) + lane; f32x4 v[4]; float s = 0.f;
#pragma unroll
        for (int j = 0; j < 4; ++j) { v[j] = xr[64 * j]; s += (v[j][0] * v[j][0] + v[j][1] * v[j][1]) + (v[j][2] * v[j][2] + v[j][3] * v[j][3]); }
        const float rstd = __builtin_amdgcn_rsqf(wave_sum(s) * (1.f / D) + NORM_EPS);
        u32x2* o8 = (u32x2*)(hn + (size_t)m * D) + lane;
#pragma unroll
        for (int j = 0; j < 4; ++j) { const f32x4 y = v[j] * rstd * wv[j]; u32x2 w; w.x = cvt_pk_bf16(y[0], y[1]); w.y = cvt_pk_bf16(y[2], y[3]); o8[64 * j] = w; }
    }
    const f32x4* pv = (const f32x4*)a.in[I_P]; u32x2* pb = (u32x2*)(ws + WS_PB);
    for (size_t i = (size_t)vcu * 512 + tid; i < (size_t)T * PLE / 4; i += (size_t)G * 512) { const f32x4 v = pv[i]; u32x2 w; w.x = cvt_pk_bf16(v[0], v[1]); w.y = cvt_pk_bf16(v[2], v[3]); pb[i] = w; }
}

__device__ __forceinline__ int tt_off(int d, int m) { return d * 136 + ((((m >> 3) ^ ((d >> 3) & 7)) << 3) | (m & 7)); }
__device__ __forceinline__ void tt_write8(LAS bf16_t* base, int d0, int m, const u32x4 v) {
    const int blk = (((m >> 3) ^ ((d0 >> 3) & 7)) << 3) | (m & 7); LAS bf16_t* p = base + d0 * 136 + blk;
    p[0 * 136] = (bf16_t)(v.x & 0xffff); p[1 * 136] = (bf16_t)(v.x >> 16); p[2 * 136] = (bf16_t)(v.y & 0xffff); p[3 * 136] = (bf16_t)(v.y >> 16);
    p[4 * 136] = (bf16_t)(v.z & 0xffff); p[5 * 136] = (bf16_t)(v.z >> 16); p[6 * 136] = (bf16_t)(v.w & 0xffff); p[7 * 136] = (bf16_t)(v.w >> 16);
}
__device__ __forceinline__ void phase_kv(const Args& a, LAS unsigned char* lds, int G) {
    const int tid = threadIdx.x, lane = tid & 63, w = __builtin_amdgcn_readfirstlane(tid >> 6), fr = lane & 15, fq = lane >> 4;
    const bf16_t* Kb = (const bf16_t*)(a.ws + WS_K); const bf16_t* Vb = (const bf16_t*)(a.ws + WS_V); float* KV = (float*)(a.ws + WS_KV);
    const int seg = tid & 7, r0 = tid >> 3;
    u32x4 rk[2], rv[2];
    int u = blockIdx.x;
#define KV_LOAD(uu) do { const size_t tok0 = (size_t)((uu) >> 3) * CH; const int hc = ((uu) & 7) * HD; _Pragma("unroll") for (int i = 0; i < 2; ++i) { const size_t o = (tok0 + r0 + 64 * i) * 512 + hc + seg * 8; rk[i] = *(const u32x4*)(Kb + o); rv[i] = *(const u32x4*)(Vb + o); } } while (0)
    if (u < 2048) KV_LOAD(u);
    for (int buf = 0; u < 2048; u += G, buf ^= 1) {
        LAS bf16_t* KT = (LAS bf16_t*)(lds + buf * 34816); LAS bf16_t* VT = KT + 64 * 136;
#pragma unroll
        for (int i = 0; i < 2; ++i) { tt_write8(KT, seg * 8, r0 + 64 * i, rk[i]); tt_write8(VT, seg * 8, r0 + 64 * i, rv[i]); }
        __syncthreads();
        if (u + G < 2048) KV_LOAD(u + G);
        const int dt = w & 3; const float sc = __builtin_amdgcn_exp2f(127.0f * log2_gamma(u & 7));
#pragma unroll
        for (int q = 0; q < 2; ++q) { const int et = (w >> 2) * 2 + q; f32x4 acc = {0.f, 0.f, 0.f, 0.f};
#pragma unroll
            for (int ks = 0; ks < 4; ++ks) { const int d = 16 * dt + fr, e = 16 * et + fr, m0 = 32 * ks + 8 * fq;
                const bf16x8 A = *(const LAS bf16x8*)(KT + tt_off(d, m0)); const bf16x8 B = *(const LAS bf16x8*)(VT + tt_off(e, m0));
                acc = __builtin_amdgcn_mfma_f32_16x16x32_bf16(A, B, acc, 0, 0, 0); }
            *(f32x4*)(KV + (size_t)u * 4096 + (16 * et + fr) * 64 + 16 * dt + 4 * fq) = acc * sc; }
    }
#undef KV_LOAD
    __syncthreads();
}
__device__ __forceinline__ void phase_pool(const Args& a, LAS unsigned char* lds, int G) {
    const int tid = threadIdx.x, lane = tid & 63, w = __builtin_amdgcn_readfirstlane(tid >> 6), fr = lane & 15, fq = lane >> 4;
    const bf16_t* U = (const bf16_t*)(a.ws + WS_U); const bf16_t* PWt = (const bf16_t*)(a.ws + WS_PWT); bf16_t* MIX = (bf16_t*)(a.ws + WS_MIX);
    const float* pscale = (const float*)a.in[I_POOLS];
    LAS bf16_t* UB = (LAS bf16_t*)lds; LAS bf16_t* PA = (LAS bf16_t*)(lds + 38912); LAS bf16_t* PW = (LAS bf16_t*)(lds + 73728);
    int gl = -1;
    for (int u = blockIdx.x; u < (T / 128) * 4; u += G) {
        const int g = u & 3, t0 = (u >> 2) * 128;
        if (g != gl) { gl = g;
#pragma unroll
            for (int i = 0; i < 4; ++i) { const int p = tid + 512 * i, d = p >> 4, sg = p & 15; *(LAS u32x4*)(PW + d * 136 + sg * 8) = *(const u32x4*)(PWt + ((size_t)g * 128 + d) * 128 + sg * 8); } }
        const bool seq0 = (t0 & (SEQ - 1)) == 0;
#pragma unroll
        for (int i = 0; i < 5; ++i) { const int p = tid + 512 * i, lr = p >> 4, sg = p & 15;
            if (lr < 143) { u32x4 v = {0u, 0u, 0u, 0u}; if (lr >= 15 || !seq0) v = *(const u32x4*)(U + (size_t)(t0 - 15 + lr) * 512 + g * 128 + sg * 8); *(LAS u32x4*)(UB + lr * 136 + sg * 8) = v; } }
        __syncthreads();
        { const int cg = tid & 15, rg = tid >> 4, wnd = 2 << g;
#pragma unroll
          for (int q = 0; q < 4; ++q) { const int r = 4 * rg + q; const int s = (t0 + r) & (SEQ - 1); const float inv = 1.0f / (float)((s + 1) < wnd ? (s + 1) : wnd);
              float sum[8];
#pragma unroll
              for (int j = 0; j < 8; ++j) sum[j] = 0.f;
              for (int k = 0; k < wnd; ++k) { const u32x4 v = *(const LAS u32x4*)(UB + (r + 15 - k) * 136 + cg * 8);
                  sum[0] += bf_lo(v.x); sum[1] += bf_hi(v.x); sum[2] += bf_lo(v.y); sum[3] += bf_hi(v.y); sum[4] += bf_lo(v.z); sum[5] += bf_hi(v.z); sum[6] += bf_lo(v.w); sum[7] += bf_hi(v.w); }
              const u32x4 c = *(const LAS u32x4*)(UB + (r + 15) * 136 + cg * 8);
              u32x4 o; o.x = cvt_pk_bf16(sum[0] * inv - bf_lo(c.x), sum[1] * inv - bf_hi(c.x)); o.y = cvt_pk_bf16(sum[2] * inv - bf_lo(c.y), sum[3] * inv - bf_hi(c.y));
              o.z = cvt_pk_bf16(sum[4] * inv - bf_lo(c.z), sum[5] * inv - bf_hi(c.z)); o.w = cvt_pk_bf16(sum[6] * inv - bf_lo(c.w), sum[7] * inv - bf_hi(c.w));
              *(LAS u32x4*)(PA + r * 136 + cg * 8) = o; } }
        __syncthreads();
        f32x4 acc[8];
#pragma unroll
        for (int dt = 0; dt < 8; ++dt) acc[dt] = (f32x4){0.f, 0.f, 0.f, 0.f};
#pragma unroll
        for (int kk = 0; kk < 4; ++kk) { const bf16x8 B = *(const LAS bf16x8*)(PA + (16 * w + fr) * 136 + 32 * kk + 8 * fq);
#pragma unroll
            for (int dt = 0; dt < 8; ++dt) { const bf16x8 A = *(const LAS bf16x8*)(PW + (16 * dt + fr) * 136 + 32 * kk + 8 * fq); acc[dt] = __builtin_amdgcn_mfma_f32_16x16x32_bf16(A, B, acc[dt], 0, 0, 0); } }
        const size_t tok = (size_t)t0 + 16 * w + fr;
#pragma unroll
        for (int dt = 0; dt < 8; ++dt) { const int d = 16 * dt + 4 * fq; const f32x4 sc = *(const f32x4*)(pscale + g * 128 + d); const f32x4 o = acc[dt] * sc;
            u32x2 wv; wv.x = cvt_pk_bf16(o[0], o[1]); wv.y = cvt_pk_bf16(o[2], o[3]); *(u32x2*)(MIX + tok * D + 512 + g * 128 + d) = wv; }
        __syncthreads();
    }
}
__device__ __forceinline__ void phase_scan(const Args& a, int G) {
    const float* KV = (const float*)(a.ws + WS_KV); bf16_t* ST = (bf16_t*)(a.ws + WS_ST);
    for (int v = blockIdx.x * 512 + threadIdx.x; v < NBATCH * NH * 1024; v += G * 512) {
        const int bh = v >> 10, q = v & 1023, b = bh >> 3, h = bh & 7;
        const float lg = log2_gamma(h), gam = __builtin_amdgcn_exp2f(lg), cd = __builtin_amdgcn_exp2f(128.0f * lg);
        f32x4 s = {0.f, 0.f, 0.f, 0.f};
        for (int n0 = 0; n0 < NCH; n0 += 8) { f32x4 kv[8];
#pragma unroll
            for (int j = 0; j < 8; ++j) kv[j] = *(const f32x4*)(KV + ((size_t)((b * NCH + n0 + j) * NH + h)) * 4096 + q * 4);
#pragma unroll
            for (int j = 0; j < 8; ++j) { const f32x4 o = s * gam; u32x2 wv; wv.x = cvt_pk_bf16(o[0], o[1]); wv.y = cvt_pk_bf16(o[2], o[3]);
                *(u32x2*)(ST + ((size_t)((b * NCH + n0 + j) * NH + h)) * 4096 + q * 4) = wv; s = s * cd + kv[j]; } }
    }
}
__device__ __forceinline__ void phase_ret(const Args& a, LAS unsigned char* lds, int G) {
    const int tid = threadIdx.x, lane = tid & 63, w = __builtin_amdgcn_readfirstlane(tid >> 6), fr = lane & 15, fq = lane >> 4;
    const bf16_t* Qb = (const bf16_t*)(a.ws + WS_Q); const bf16_t* Kb = (const bf16_t*)(a.ws + WS_K); const bf16_t* Vb = (const bf16_t*)(a.ws + WS_V);
    const bf16_t* Gb = (const bf16_t*)(a.ws + WS_G); const bf16_t* STg = (const bf16_t*)(a.ws + WS_ST); bf16_t* MIX = (bf16_t*)(a.ws + WS_MIX);
    const float* gnw = (const float*)a.in[I_GNW];
    const int seg = tid & 7, r0 = tid >> 3;
    u32x4 rk[2], rv[2], rs;
    int u = blockIdx.x;
#define RT_LOAD(uu) do { const size_t tok0 = (size_t)((uu) >> 3) * CH; const int hc = ((uu) & 7) * HD; _Pragma("unroll") for (int i = 0; i < 2; ++i) { const size_t o = (tok0 + r0 + 64 * i) * 512 + hc + seg * 8; rk[i] = *(const u32x4*)(Kb + o); rv[i] = *(const u32x4*)(Vb + o); } \
        rs = *(const u32x4*)(STg + (size_t)(uu) * 4096 + r0 * 64 + seg * 8); } while (0)
    if (u < 2048) RT_LOAD(u);
    for (int buf = 0; u < 2048; u += G, buf ^= 1) {
        LAS bf16_t* Kr = (LAS bf16_t*)(lds + buf * 45056); LAS bf16_t* VT = Kr + 128 * 72; LAS bf16_t* SL = VT + 64 * 136;
#pragma unroll
        for (int i = 0; i < 2; ++i) { *(LAS u32x4*)(Kr + (r0 + 64 * i) * 72 + seg * 8) = rk[i]; tt_write8(VT, seg * 8, r0 + 64 * i, rv[i]); }
        *(LAS u32x4*)(SL + r0 * 72 + seg * 8) = rs;
        __syncthreads();
        if (u + G < 2048) RT_LOAD(u + G);
        const size_t tok0 = (size_t)(u >> 3) * CH; const int hc = (u & 7) * HD; const size_t ctok = tok0 + 16 * w + fr;
        bf16x8 qf[2];
#pragma unroll
        for (int kk = 0; kk < 2; ++kk) qf[kk] = *(const bf16x8*)(Qb + ctok * 512 + hc + 32 * kk + 8 * fq);
        u32x2 pk[8];
#pragma unroll
        for (int am = 0; am < 8; ++am) {
            if (am <= w) { f32x4 s = {0.f, 0.f, 0.f, 0.f};
#pragma unroll
                for (int kk = 0; kk < 2; ++kk) { const bf16x8 A = *(const LAS bf16x8*)(Kr + (16 * am + fr) * 72 + 32 * kk + 8 * fq); s = __builtin_amdgcn_mfma_f32_16x16x32_bf16(A, qf[kk], s, 0, 0, 0); }
                if (am == w) {
#pragma unroll
                    for (int j = 0; j < 4; ++j) if (4 * fq + j > fr) s[j] = 0.f; }
                pk[am].x = cvt_pk_bf16(s[0], s[1]); pk[am].y = cvt_pk_bf16(s[2], s[3]);
            } else { pk[am].x = 0u; pk[am].y = 0u; } }
        f32x4 y[4];
#pragma unroll
        for (int et = 0; et < 4; ++et) y[et] = (f32x4){0.f, 0.f, 0.f, 0.f};
#pragma unroll
        for (int s2 = 0; s2 < 4; ++s2) {
            if (2 * s2 <= w) { u32x4 bw; bw.x = pk[2 * s2].x; bw.y = pk[2 * s2].y; bw.z = pk[2 * s2 + 1].x; bw.w = pk[2 * s2 + 1].y; const bf16x8 B = __builtin_bit_cast(bf16x8, bw);
#pragma unroll
                for (int et = 0; et < 4; ++et) { const int e = 16 * et + fr, es = (e >> 3) & 7;
                    const u32x2 lo = *(const LAS u32x2*)(VT + e * 136 + (((4 * s2 + (fq >> 1)) ^ es) << 3) + 4 * (fq & 1));
                    const u32x2 hi = *(const LAS u32x2*)(VT + e * 136 + (((4 * s2 + 2 + (fq >> 1)) ^ es) << 3) + 4 * (fq & 1));
                    u32x4 aw; aw.x = lo.x; aw.y = lo.y; aw.z = hi.x; aw.w = hi.y;
                    y[et] = __builtin_amdgcn_mfma_f32_16x16x32_bf16(__builtin_bit_cast(bf16x8, aw), B, y[et], 0, 0, 0); } } }
#pragma unroll
        for (int kk = 0; kk < 2; ++kk)
#pragma unroll
            for (int et = 0; et < 4; ++et) { const bf16x8 A = *(const LAS bf16x8*)(SL + (16 * et + fr) * 72 + 32 * kk + 8 * fq); y[et] = __builtin_amdgcn_mfma_f32_16x16x32_bf16(A, qf[kk], y[et], 0, 0, 0); }
        float s = 0.f;
#pragma unroll
        for (int et = 0; et < 4; ++et) s += (y[et][0] + y[et][1]) + (y[et][2] + y[et][3]);
        s += __shfl_xor(s, 16); s += __shfl_xor(s, 32);
        const float mean = s * (1.0f / 64.0f); float q2 = 0.f;
#pragma unroll
        for (int et = 0; et < 4; ++et) { const f32x4 d = y[et] - mean; q2 += (d[0] * d[0] + d[1] * d[1]) + (d[2] * d[2] + d[3] * d[3]); }
        q2 += __shfl_xor(q2, 16); q2 += __shfl_xor(q2, 32);
        const float rstd = __builtin_amdgcn_rsqf(q2 * (1.0f / 64.0f) + GN_EPS);
#pragma unroll
        for (int et = 0; et < 4; ++et) { const int col = hc + 16 * et + 4 * fq; const u32x2 gv = *(const u32x2*)(Gb + ctok * 512 + col); const f32x4 gw = *(const f32x4*)(gnw + col);
            const float g0 = bf_lo(gv.x), g1 = bf_hi(gv.x), g2 = bf_lo(gv.y), g3 = bf_hi(gv.y);
            const float o0 = (y[et][0] - mean) * rstd * gw[0] * g0 * sigmoidf_fast(g0), o1 = (y[et][1] - mean) * rstd * gw[1] * g1 * sigmoidf_fast(g1);
            const float o2 = (y[et][2] - mean) * rstd * gw[2] * g2 * sigmoidf_fast(g2), o3 = (y[et][3] - mean) * rstd * gw[3] * g3 * sigmoidf_fast(g3);
            u32x2 wv; wv.x = cvt_pk_bf16(o0, o1); wv.y = cvt_pk_bf16(o2, o3); *(u32x2*)(MIX + ctok * D + col) = wv; }
    }
#undef RT_LOAD
    __syncthreads();
}

__device__ __forceinline__ void phase_router(const Args& a, LAS unsigned char* lds, int G) {
    const int tid = threadIdx.x, lane = tid & 63, w = __builtin_amdgcn_readfirstlane(tid >> 6), fr = lane & 15, fq = lane >> 4;
    const bf16_t* RT = (const bf16_t*)(a.ws + WS_ROUT); const bf16_t* H1W = (const bf16_t*)(a.ws + WS_HN1); const float* ssq = (const float*)(a.ws + WS_SSQ1);
    const float* rb = (const float*)a.in[I_RB];
    int* topi = (int*)(a.ws + WS_TOPI); float* topg = (float*)(a.ws + WS_TOPG); float* rstd1 = (float*)(a.ws + WS_RSTD1); int* bh = (int*)(a.ws + WS_BH);
    LAS bf16_t* RL = (LAS bf16_t*)lds;
    LAS float* LG = (LAS float*)(lds + 66048) + w * (16 * 33);
    LAS int* hist = (LAS int*)(lds + 66048 + 8 * 16 * 33 * 4);
#pragma unroll
    for (int i = 0; i < 8; ++i) { const int p = tid + 512 * i, e = p >> 7, sg = p & 127; *(LAS u32x4*)(RL + e * 1032 + sg * 8) = *(const u32x4*)(RT + (size_t)e * D + sg * 8); }
    for (int tb = blockIdx.x; tb < T / 128; tb += G) {
        if (tid < 32) hist[tid] = 0;
        __syncthreads();
        const size_t t0 = (size_t)tb * 128 + 16 * w;
        f32x4 acc0 = {0.f, 0.f, 0.f, 0.f}, acc1 = {0.f, 0.f, 0.f, 0.f};
#pragma unroll 8
        for (int kk = 0; kk < 32; ++kk) { const bf16x8 B = *(const bf16x8*)(H1W + (t0 + fr) * D + 32 * kk + 8 * fq);
            const bf16x8 A0 = *(const LAS bf16x8*)(RL + fr * 1032 + 32 * kk + 8 * fq), A1 = *(const LAS bf16x8*)(RL + (16 + fr) * 1032 + 32 * kk + 8 * fq);
            acc0 = __builtin_amdgcn_mfma_f32_16x16x32_bf16(A0, B, acc0, 0, 0, 0); acc1 = __builtin_amdgcn_mfma_f32_16x16x32_bf16(A1, B, acc1, 0, 0, 0); }
#pragma unroll
        for (int j = 0; j < 4; ++j) { LG[fr * 33 + 4 * fq + j] = acc0[j]; LG[fr * 33 + 16 + 4 * fq + j] = acc1[j]; }
        LDS_WAIT(); asm volatile("" ::: "memory");
        if (lane < 16) {
            const size_t t = t0 + lane; float sq = 0.f;
#pragma unroll
            for (int q = 0; q < 4; ++q) { const f32x4 v = *(const f32x4*)(ssq + t * 16 + 4 * q); sq += (v[0] + v[1]) + (v[2] + v[3]); }
            const float rstd = __builtin_amdgcn_rsqf(sq * (1.f / D) + NORM_EPS);
            float v0 = -3.0e38f, v1 = -3.0e38f, v2 = -3.0e38f, v3 = -3.0e38f; int i0 = 0, i1 = 0, i2 = 0, i3 = 0;
#pragma unroll
            for (int e = 0; e < NE; ++e) { const float v = LG[lane * 33 + e] * rstd + rb[e];
                if (v > v3) { if (v > v2) { v3 = v2; i3 = i2; if (v > v1) { v2 = v1; i2 = i1; if (v > v0) { v1 = v0; i1 = i0; v0 = v; i0 = e; } else { v1 = v; i1 = e; } } else { v2 = v; i2 = e; } } else { v3 = v; i3 = e; } } }
            const float e1 = __expf(v1 - v0), e2 = __expf(v2 - v0), e3 = __expf(v3 - v0), inv = 1.0f / (1.0f + e1 + e2 + e3);
            *(int4*)(topi + t * 4) = make_int4(i0, i1, i2, i3); *(float4*)(topg + t * 4) = make_float4(inv, e1 * inv, e2 * inv, e3 * inv); rstd1[t] = rstd;
            lds_inc(&hist[i0]); lds_inc(&hist[i1]); lds_inc(&hist[i2]); lds_inc(&hist[i3]);
        }
        __syncthreads();
        if (tid < 32) bh[tb * 32 + tid] = hist[tid];
        __syncthreads();
    }
}
__device__ __forceinline__ void vtab_put(unsigned* vt, int pos, unsigned tok) {
    const int tile = pos >> 8, r = pos & 255, hh = r >> 7, R = r & 127, rg = R >> 4, rr = R & 15;
#pragma unroll
    for (int ch = 0; ch < 2; ++ch)
#pragma unroll
        for (int p = 0; p < 4; ++p) { const int st = rg * 2 + ch, ob = rr * 64 + p * 16, sb = ob ^ (((ob >> 9) & 1) << 5), b = st * 1024 + sb, i = b >> 13, td = (b & 8191) >> 4;
            vt[((size_t)tile * 512 + td) * 4 + hh * 2 + i] = (tok * D + ch * 32 + p * 8) * 2u; }
}
__device__ __forceinline__ void phase_place(const Args& a, LAS unsigned char* lds, int G) {
    const int tid = threadIdx.x;
    const int* bh = (const int*)(a.ws + WS_BH); const int* topi = (const int*)(a.ws + WS_TOPI); const float* topg = (const float*)(a.ws + WS_TOPG); const float* rstd1 = (const float*)(a.ws + WS_RSTD1);
    int* spos = (int*)(a.ws + WS_SPOS); float* SG = (float*)(a.ws + WS_SG); float* SR = (float*)(a.ws + WS_SR); unsigned* vt = (unsigned*)(a.ws + WS_VTAB);
    unsigned* ctl = (unsigned*)(a.ws + WS_CTL);
    LAS int* pt = (LAS int*)lds; LAS int* pb = pt + 512; LAS int* tot = pb + 512; LAS int* off = tot + 32; LAS int* base = off + 32; LAS int* rank = base + 32;
    constexpr int NTB = T / 128;
    for (int it = 0, tb = blockIdx.x; it == 0 || tb < NTB; ++it, tb += G) {
        const int e = tid & 31, part = tid >> 5; int st = 0, sb = 0;
        for (int b = part; b < NTB; b += 16) { const int v = bh[b * 32 + e]; st += v; if (b < tb) sb += v; }
        pt[tid] = st; pb[tid] = sb;
        __syncthreads();
        if (tid < 32) { int s1 = 0, s2 = 0;
#pragma unroll
            for (int q = 0; q < 16; ++q) { s1 += pt[q * 32 + tid]; s2 += pb[q * 32 + tid]; }
            tot[tid] = s1; base[tid] = s2; rank[tid] = 0; }
        __syncthreads();
        if (tid == 0) { int o = 0; for (int q = 0; q < NE; ++q) { off[q] = o; o += (tot[q] + 255) & ~255; } }
        __syncthreads();
        if (tb < NTB) {
            const int t = tb * 128 + (tid >> 2), k = tid & 3; const int ex = topi[t * 4 + k];
            const int pos = off[ex] + base[ex] + lds_inc(&rank[ex]);
            spos[t * 4 + k] = pos; SG[pos] = topg[t * 4 + k]; SR[pos] = rstd1[t]; vtab_put(vt, pos, (unsigned)t);
        }
        if (it == 0) {
            for (int ex = blockIdx.x; ex < NE; ex += G) { const int n = tot[ex], np = (n + 255) & ~255;
                for (int r = n + tid; r < np; r += 512) { const int pos = off[ex] + r; SG[pos] = 0.f; SR[pos] = 0.f; vtab_put(vt, pos, 0u); } }
            if (blockIdx.x == 0 && tid < 32) ctl[CW_TOT + tid] = (unsigned)tot[tid];
        }
        __syncthreads();
    }
}
__device__ __forceinline__ int build_tiles(const Args& a, LAS unsigned short* te) {
    const unsigned* ctl = (const unsigned*)(a.ws + WS_CTL);
    int o = 0;
    for (int e = 0; e < NE; ++e) { const int n = (int)((ctl[CW_TOT + e] + 255u) >> 8); for (int q = threadIdx.x; q < n; q += 512) te[o + q] = (unsigned short)e; o += n; }
    __syncthreads();
    return o;
}
__device__ __forceinline__ void phase_combine(const Args& a, int vcu, int G) {
    const int tid = threadIdx.x, lane = tid & 63, wave = tid >> 6; const int gw = vcu * 8 + wave, NGW = G * 8;
    float* h = a.out; const bf16_t* Y = (const bf16_t*)(a.ws + WS_Y); const int* spos = (const int*)(a.ws + WS_SPOS);
    bf16_t* H2W = (bf16_t*)(a.ws + WS_HN1); float* rstd2 = (float*)(a.ws + WS_RSTD2); const float* nw = (const float*)a.in[I_NPLE];
    f32x4 wv[2][2];
#pragma unroll
    for (int j = 0; j < 2; ++j) { wv[j][0] = *(const f32x4*)(nw + 8 * lane + 512 * j); wv[j][1] = *(const f32x4*)(nw + 8 * lane + 512 * j + 4); }
    for (int t = gw; t < T; t += NGW) {
        const int4 ps = *(const int4*)(spos + (size_t)t * 4); const int pp[4] = {ps.x, ps.y, ps.z, ps.w};
        f32x4 v[2][2]; float s = 0.f;
#pragma unroll
        for (int j = 0; j < 2; ++j) { v[j][0] = *(const f32x4*)(h + (size_t)t * D + 8 * lane + 512 * j); v[j][1] = *(const f32x4*)(h + (size_t)t * D + 8 * lane + 512 * j + 4); }
#pragma unroll
        for (int k = 0; k < 4; ++k)
#pragma unroll
            for (int j = 0; j < 2; ++j) { const u32x4 yv = *(const u32x4*)(Y + (size_t)pp[k] * D + 8 * lane + 512 * j);
                v[j][0][0] += bf_lo(yv.x); v[j][0][1] += bf_hi(yv.x); v[j][0][2] += bf_lo(yv.y); v[j][0][3] += bf_hi(yv.y);
                v[j][1][0] += bf_lo(yv.z); v[j][1][1] += bf_hi(yv.z); v[j][1][2] += bf_lo(yv.w); v[j][1][3] += bf_hi(yv.w); }
#pragma unroll
        for (int j = 0; j < 2; ++j)
#pragma unroll
            for (int q = 0; q < 2; ++q) { const f32x4 x = v[j][q]; s += (x[0] * x[0] + x[1] * x[1]) + (x[2] * x[2] + x[3] * x[3]); *(f32x4*)(h + (size_t)t * D + 8 * lane + 512 * j + 4 * q) = x; }
        s = wave_sum(s);
        if (lane == 0) rstd2[t] = __builtin_amdgcn_rsqf(s * (1.f / D) + NORM_EPS);
#pragma unroll
        for (int j = 0; j < 2; ++j) { const f32x4 x0 = v[j][0] * wv[j][0], x1 = v[j][1] * wv[j][1];
            u32x4 o; o.x = cvt_pk_bf16(x0[0], x0[1]); o.y = cvt_pk_bf16(x0[2], x0[3]); o.z = cvt_pk_bf16(x1[0], x1[1]); o.w = cvt_pk_bf16(x1[2], x1[3]);
            *(u32x4*)(H2W + (size_t)t * D + 8 * lane + 512 * j) = o; }
    }
}
__device__ __forceinline__ void phase_final(const Args& a, int vcu, int G) {
    const int tid = threadIdx.x, lane = tid & 63, wave = tid >> 6; const int gw = vcu * 8 + wave, NGW = G * 8;
    float* h = a.out; const float* nw = (const float*)a.in[I_NFIN];
    f32x4 wv[4];
#pragma unroll
    for (int j = 0; j < 4; ++j) wv[j] = *((const f32x4*)nw + lane + 64 * j);
    float scale = 1.0f;
#if MK_DEBUG
    { const unsigned f = *(const unsigned*)(a.ws + WS_CTL + 4 * CW_FAIL); if (f) scale = 1.0f + 0.1f * (float)__builtin_ctz(f); }
#endif
    for (int t = gw; t < T; t += NGW) {
        f32x4* hr = (f32x4*)(h + (size_t)t * D) + lane; f32x4 v[4]; float s = 0.f;
#pragma unroll
        for (int j = 0; j < 4; ++j) { v[j] = hr[64 * j]; s += (v[j][0] * v[j][0] + v[j][1] * v[j][1]) + (v[j][2] * v[j][2] + v[j][3] * v[j][3]); }
        const float rstd = __builtin_amdgcn_rsqf(wave_sum(s) * (1.f / D) + NORM_EPS) * scale;
#pragma unroll
        for (int j = 0; j < 4; ++j) hr[64 * j] = v[j] * rstd * wv[j];
    }
}

__global__ void __launch_bounds__(512, 2) fwd_kernel(Args args) {
    extern __shared__ __attribute__((aligned(16))) unsigned char lds_raw[];
    LAS unsigned char* lds = (LAS unsigned char*)lds_raw;
    const int tid = threadIdx.x, G = gridDim.x;
    const int vcu = (G % 8 == 0) ? ((int)blockIdx.x % 8) * (G / 8) + (int)blockIdx.x / 8 : (int)blockIdx.x;
    volatile LAS unsigned* MISC = (volatile LAS unsigned*)(lds + LCTL_OFF);
    if (tid < 4) MISC[tid] = 0u;
    __syncthreads();
    unsigned* ctl = (unsigned*)(args.ws + WS_CTL);
    XcdBarrier bar; bar.bar = ctl + CW_BAR; bar.x = 0; bar.st = nullptr;
    const int lo = args.ph_lo, hi = args.ph_hi;
    if (hi - lo > 1) bar = xcd_barrier_post(ctl + CW_BAR, MISC);
#ifndef PH_MASK
#define PH_MASK 0x1fff
#endif
#define IN(k) (((PH_MASK >> (k)) & 1) && lo <= (k) && (k) < hi)
#define SEAM(k) do { if (IN(k) && IN((k) + 1)) xcd_barrier(bar); } while (0)
    LAS unsigned short* te = (LAS unsigned short*)(lds + LCTL_OFF + 64);
    const char* ws = (const char*)args.ws;

    if (IN(0)) phase_prologue(args, lds, vcu, G);
    SEAM(0);
    if (IN(1)) {
        { pg8::DenseSched S; S.init(T, NIN, G, (int)blockIdx.x);
          pg8::EpiInProj E{(bf16_t*)(args.ws + WS_Q), (const int*)args.in[I_POS]};
          pg8::gemm_phase(lds, ws + WS_HN1, ws + WS_WIN, D, S, E); }
        { pg8::DenseSched S; S.init(T, D, G, (int)blockIdx.x);
          pg8::EpiPlainBf16 E{(bf16_t*)(args.ws + WS_PP), D};
          pg8::gemm_phase(lds, ws + WS_PB, ws + WS_WPT, PLE, S, E); }
    }
    SEAM(1);
    if (IN(2)) { phase_kv(args, lds, G); phase_pool(args, lds, G); }
    SEAM(2);
    if (IN(3)) phase_scan(args, G);
    SEAM(3);
    if (IN(4)) phase_ret(args, lds, G);
    SEAM(4);
    if (IN(5)) {
        pg8::DenseSched S; S.init(T, D, G, (int)blockIdx.x);
        pg8::EpiWout E{(const float*)args.in[I_X], args.out, (bf16_t*)(args.ws + WS_HN1), (const float*)args.in[I_NMOE], (float*)(args.ws + WS_SSQ1)};
        pg8::gemm_phase(lds, ws + WS_MIX, ws + WS_WOUT, D, S, E);
    }
    SEAM(5);
    if (IN(6)) phase_router(args, lds, G);
    SEAM(6);
    if (IN(7)) phase_place(args, lds, G);
    SEAM(7);
    if (IN(8)) {
        const int MT = build_tiles(args, te);
        pg8::GroupSchedG S; S.nM = MT; S.nN = 2 * DE / 256; S.G = G; S.c = (int)blockIdx.x; S.NB = 2 * DE; S.te = te; S.vtab = args.ws + WS_VTAB;
        pg8::EpiGateUp E{(bf16_t*)(args.ws + WS_ACT), (const float*)args.in[I_BGU], (const float*)(args.ws + WS_SR)};
        pg8::gemm_phase(lds, ws + WS_HN1, ws + WS_WGU, D, S, E);
    }
    SEAM(8);
    if (IN(9)) {
        const int MT = build_tiles(args, te);
        pg8::GroupSchedD S; S.nM = MT; S.nN = D / 256; S.G = G; S.c = (int)blockIdx.x; S.NB = D; S.te = te; S.vtab = nullptr;
        pg8::EpiDown E{(bf16_t*)(args.ws + WS_Y), (const float*)args.in[I_BD], (const float*)(args.ws + WS_SG)};
        pg8::gemm_phase(lds, ws + WS_ACT, ws + WS_WD, DE, S, E);
    }
    SEAM(9);
    if (IN(10)) phase_combine(args, vcu, G);
    SEAM(10);
    if (IN(11)) {
        pg8::DenseSched S; S.init(T, D, G, (int)blockIdx.x);
        pg8::EpiPle E{args.out, (const bf16_t*)(args.ws + WS_PP), (const float*)(args.ws + WS_RSTD2)};
        pg8::gemm_phase(lds, ws + WS_HN1, ws + WS_WG, D, S, E);
    }
    SEAM(11);
    if (IN(12)) phase_final(args, vcu, G);
#undef IN
#undef SEAM
}


extern "C" void kernel_launch(void* const* d_in, const int* in_sizes, int n_in, void* d_out, int out_size, void* d_ws, size_t ws_size, hipStream_t stream) {
    static int grid = 0;
    if (grid == 0) {
        if (n_in != 20 || in_sizes[0] != T * D || out_size != T * D || ws_size < WS_END) { fprintf(stderr, "kernel_launch: unexpected shapes (n_in %d, in0 %d, out %d, ws %zu < %zu)\n", n_in, n_in > 0 ? in_sizes[0] : -1, out_size, ws_size, (size_t)WS_END); grid = -1; return; }
        int dev = 0, cus = 0, per_cu = 0;
        if (hipGetDevice(&dev) != hipSuccess || hipDeviceGetAttribute(&cus, hipDeviceAttributeMultiprocessorCount, dev) != hipSuccess) { grid = -1; return; }
        if (hipFuncSetAttribute((const void*)fwd_kernel, hipFuncAttributeMaxDynamicSharedMemorySize, LDS_BYTES) != hipSuccess) { fprintf(stderr, "kernel_launch: hipFuncSetAttribute failed\n"); grid = -1; return; }
        if (hipOccupancyMaxActiveBlocksPerMultiprocessor(&per_cu, (const void*)fwd_kernel, 512, LDS_BYTES) != hipSuccess || per_cu < 1) { fprintf(stderr, "kernel_launch: occupancy query says %d\n", per_cu); (void)hipGetLastError(); }
        grid = cus;
    }
    if (grid < 0) return;
    if (hipMemsetAsync((char*)d_ws + WS_CTL, 0, CTL_ZERO_BYTES, stream) != hipSuccess) return;
    Args a{};
    for (int i = 0; i < 20; ++i) a.in[i] = d_in[i];
    a.out = (float*)d_out; a.ws = (unsigned char*)d_ws;
#if MK_PER_PHASE
    for (int p = 0; p < NPH; ++p) { a.ph_lo = p; a.ph_hi = p + 1; hipLaunchKernelGGL(fwd_kernel, dim3(grid), dim3(512), LDS_BYTES, stream, a); }
#else
    a.ph_lo = 0; a.ph_hi = NPH; hipLaunchKernelGGL(fwd_kernel, dim3(grid), dim3(512), LDS_BYTES, stream, a);
#endif
}
```

```cpp
#include <hip/hip_runtime.h>
#include <cstdio>
#include <cstdint>

#ifndef MK_PER_PHASE
#define MK_PER_PHASE 0
#endif
#ifndef MOE_F8
#define MOE_F8 1
#endif
#ifndef MK_REPEAT
#define MK_REPEAT 0x0
#endif
#ifndef MK_DEBUG
#define MK_DEBUG 0
#endif

#define GAS __attribute__((address_space(1)))
#define LAS __attribute__((address_space(3)))
typedef unsigned short bf16_t;
typedef short bf16x8 __attribute__((ext_vector_type(8)));
typedef float f32x4 __attribute__((ext_vector_type(4)));
typedef float f32x2 __attribute__((ext_vector_type(2)));
typedef unsigned u32x4 __attribute__((ext_vector_type(4)));
typedef unsigned u32x2 __attribute__((ext_vector_type(2)));
typedef int v8i __attribute__((ext_vector_type(8)));
typedef int v4i __attribute__((ext_vector_type(4)));

constexpr int T = 32768, D = 1024, SEQ = 4096, NBATCH = 8, NH = 8, HD = 64, CH = 128, NCH = 32;
constexpr int DRET = 512, DPOOL = 512, NIN = 2560, NE = 32, TOPK = 4, DE = 1024, PLE = 256;
constexpr float NORM_EPS = 1e-5f, GN_EPS = 1e-5f;
constexpr int MAXROWS = T * TOPK + NE * 256;
constexpr int MAXT = MAXROWS / 256;

constexpr size_t MiB = 1u << 20, KiB = 1u << 10;
constexpr size_t WS_CTL = 0, CTL_ZERO_BYTES = 64 * KiB;
constexpr size_t WS_ROUT = 1 * MiB, WS_PWT = 1 * MiB + 64 * KiB, WS_WPT = 1 * MiB + 256 * KiB;
constexpr size_t WS_TOPI = 2 * MiB, WS_TOPG = 2 * MiB + 512 * KiB, WS_SPOS = 3 * MiB, WS_RSTD1 = 3 * MiB + 512 * KiB, WS_RSTD2 = 3 * MiB + 640 * KiB, WS_BH = 3 * MiB + 768 * KiB;
constexpr size_t WS_SG = 4 * MiB, WS_SR = 5 * MiB, WS_SSQ1 = 6 * MiB, WS_VTAB = 8 * MiB;
constexpr size_t WS_WIN = 16 * MiB, WS_WOUT = 21 * MiB, WS_WG = 23 * MiB;
constexpr size_t WS_WGU = 32 * MiB, WS_WD = 160 * MiB, WS_PP = 224 * MiB;
constexpr size_t WS_HN1 = 288 * MiB  , WS_PB = 352 * MiB;
constexpr size_t WS_Q = 368 * MiB, WS_K = 400 * MiB, WS_V = 432 * MiB, WS_G = 464 * MiB, WS_U = 496 * MiB;
constexpr size_t WS_KV = 528 * MiB, WS_ST = 560 * MiB, WS_MIX = 576 * MiB;
constexpr size_t WS_H1F8 = 496 * MiB;
constexpr size_t WS_ACT = 352 * MiB, WS_Y = 624 * MiB, WS_END = 896 * MiB;
static_assert(WS_K - WS_Q == (size_t)T * 512 * 2 && WS_V - WS_K == WS_K - WS_Q && WS_G - WS_V == WS_K - WS_Q && WS_U - WS_G == WS_K - WS_Q, "q|k|v|g|u equally spaced");
static_assert(WS_VTAB + (size_t)MAXT * 512 * 16 <= WS_WIN && WS_ACT + (size_t)MAXROWS * DE * 2 <= WS_Y && WS_Y + (size_t)MAXROWS * D * 2 <= WS_END, "ws map");
constexpr int CW_TMO = 0, CW_CODE = 1, CW_FAIL = 2, CW_TOT = 64, CW_BAR = 4096;

constexpr int VOFF_OFF = 131072;
constexpr int LCTL_OFF = 147456;
constexpr int LDS_BYTES = 151552;

#define LDS_WAIT() asm volatile("s_waitcnt lgkmcnt(0)" ::: "memory")
#define VM_WAIT() asm volatile("s_waitcnt vmcnt(0)" ::: "memory")
__device__ __forceinline__ unsigned cvt_pk_bf16(float lo, float hi) { unsigned r; asm volatile("v_cvt_pk_bf16_f32 %0, %1, %2" : "=v"(r) : "v"(lo), "v"(hi)); return r; }
__device__ __forceinline__ unsigned cvt4_fp8(float a, float b, float c, float d) { int w = __builtin_amdgcn_cvt_pk_fp8_f32(a, b, 0, false); w = __builtin_amdgcn_cvt_pk_fp8_f32(c, d, w, true); return (unsigned)w; }
__device__ __forceinline__ bf16x8 v8lo(const v8i x) { const v4i t = x.lo; return __builtin_bit_cast(bf16x8, t); }
__device__ __forceinline__ bf16x8 v8hi(const v8i x) { const v4i t = x.hi; return __builtin_bit_cast(bf16x8, t); }
__device__ __forceinline__ float bf_lo(unsigned w) { return __uint_as_float(w << 16); }
__device__ __forceinline__ float bf_hi(unsigned w) { return __uint_as_float(w & 0xffff0000u); }
__device__ __forceinline__ float wave_sum(float v) {
#pragma unroll
    for (int o = 1; o < 64; o <<= 1) v += __shfl_xor(v, o);
    return v;
}
__device__ __forceinline__ float sigmoidf_fast(float x) { return __builtin_amdgcn_rcpf(1.0f + __builtin_amdgcn_exp2f(-1.4426950408889634f * x)); }
__device__ __forceinline__ int lds_inc(LAS int* p) { return __hip_atomic_fetch_add(p, 1, __ATOMIC_RELAXED, __HIP_MEMORY_SCOPE_WORKGROUP); }
__device__ __forceinline__ float log2_gamma(int h) {
    const float x = __builtin_amdgcn_exp2f(-(float)(5 + h));
    const float ln = -x * (1.0f + x * (0.5f + x * (0.33333333f + x * (0.25f + x * 0.2f))));
    return ln * 1.4426950408889634f;
}

#define XB_TMO      128
#define XB_XCNT(j)  (256  + 64 * (j))
#define XB_XSUB(j)  (1280 + 64 * (j))
#define XB_XGEN(j)  (2304 + 64 * (j))
#define XB_TOP      3328
#define XB_TOPGEN   3392
#define XCD_BAR_WORDS 3456
#define XB_SPIN_CAP (1u << 18)
__device__ __forceinline__ unsigned xb_ld(unsigned* p)              { return __hip_atomic_load(p, __ATOMIC_RELAXED, __HIP_MEMORY_SCOPE_AGENT); }
__device__ __forceinline__ unsigned xb_add(unsigned* p, unsigned v) { return __hip_atomic_fetch_add(p, v, __ATOMIC_RELAXED, __HIP_MEMORY_SCOPE_AGENT); }
__device__ __forceinline__ unsigned xb_xcc_id() { return (unsigned)__builtin_amdgcn_s_getreg((3 << 11) | 20) & 0xFu; }
#define XB_SPIN(cond, bar) do { unsigned _sp = 0; while (cond) { __builtin_amdgcn_s_sleep(1); \
    if ((++_sp & 255u) == 0u) { if (xb_ld(&(bar)[XB_TMO])) break; if (_sp > XB_SPIN_CAP) { atomicAdd(&(bar)[XB_TMO], 1u); break; } } } } while (0)
struct XcdBarrier { unsigned* bar; unsigned x; volatile LAS unsigned* st; };
__device__ __forceinline__ XcdBarrier xcd_barrier_post(unsigned* bar, volatile LAS unsigned* st) {
    XcdBarrier b; b.bar = bar; b.x = xb_xcc_id(); b.st = st;
    if (threadIdx.x == 0) (void)xb_add(&bar[XB_XCNT(b.x)], 1u);
    return b;
}
__device__ __forceinline__ void xcd_barrier_complete(unsigned* bar, unsigned x, unsigned& nloc, unsigned& nx) {
    const unsigned G = gridDim.x * gridDim.y * gridDim.z;
    unsigned sum, cnt, mine, sp = 0u;
    for (;;) {
        sum = 0u; cnt = 0u; mine = 0u;
#pragma unroll
        for (unsigned j = 0; j < 16; ++j) { const unsigned c = xb_ld(&bar[XB_XCNT(j)]); sum += c; cnt += (c > 0u) ? 1u : 0u; mine = (j == x) ? c : mine; }
        if (sum == G) break;
        __builtin_amdgcn_s_sleep(1);
        if ((++sp & 255u) == 0u) { if (xb_ld(&bar[XB_TMO])) break; if (sp > XB_SPIN_CAP) { atomicAdd(&bar[XB_TMO], 1u); break; } }
    }
    nloc = mine > 0u ? mine : 1u; nx = cnt > 0u ? cnt : 1u;
}
__device__ __forceinline__ void xcd_barrier(const XcdBarrier& b) {
    asm volatile("s_waitcnt vmcnt(0)" ::: "memory");
    __syncthreads();
    if (threadIdx.x == 0) {
        unsigned* bar = b.bar;
        __builtin_amdgcn_s_waitcnt(0);
        unsigned nloc = b.st[0], nx = b.st[1];
        if (nloc == 0u) { xcd_barrier_complete(bar, b.x, nloc, nx); b.st[0] = nloc; b.st[1] = nx; }
        const unsigned old = xb_add(&bar[XB_XSUB(b.x)], 1u);
        const unsigned gen = old / nloc;
        if (old + 1u == (gen + 1u) * nloc) {
            __builtin_amdgcn_fence(__ATOMIC_RELEASE, "agent");
            asm volatile("s_waitcnt vmcnt(0)" ::: "memory");
            const unsigned og = xb_add(&bar[XB_TOP], 1u);
            const unsigned tg = og / nx;
            if (og + 1u == (tg + 1u) * nx) xb_add(&bar[XB_TOPGEN], 1u);
            else XB_SPIN(xb_ld(&bar[XB_TOPGEN]) == tg, bar);
            __builtin_amdgcn_fence(__ATOMIC_ACQUIRE, "agent");
            xb_add(&bar[XB_XGEN(b.x)], 1u);
            asm volatile("s_waitcnt vmcnt(0)" ::: "memory");
        } else {
            XB_SPIN(xb_ld(&bar[XB_XGEN(b.x)]) == gen, bar);
            __builtin_amdgcn_fence(__ATOMIC_ACQUIRE, "agent");
            asm volatile("s_waitcnt vmcnt(0)" ::: "memory");
        }
    }
    __syncthreads();
}

namespace pg8 {
constexpr int BM = 256, BK = 64, HALF = 128, HTB = HALF * BK * 2, STAGE_BYTES = 8 * HTB, NXCD = 8, WGM = 8;
__host__ __device__ __forceinline__ int lds_byte(int r, int c) { const int st = (r >> 4) * 2 + (c >> 5), rr = r & 15, cc = c & 31, ob = rr * 64 + cc * 2; return st * 1024 + (ob ^ (((ob >> 9) & 1) << 5)); }
__host__ __device__ __forceinline__ void stage_rc(int b, int& R, int& C) { const int st = b / 1024, sb = b % 1024, swz = sb ^ (((sb >> 9) & 1) << 5); R = (st >> 1) * 16 + swz / 64; C = (st & 1) * 32 + (swz % 64) / 2; }
__host__ __device__ __forceinline__ int perm32(int rho) { const int n = rho >> 4, i = rho & 15; return 8 * (i >> 2) + 4 * n + (i & 3); }
struct Unit { int pm, pn, e; };
__device__ __forceinline__ bool order_next(int i, int G, int c, int nM, int nN, int& pm, int& pn) {
    const int nwg = nM * nN; const long L = (long)i * G + c; if (L >= nwg) return false;
    int wgid = (int)L; { const int q = nwg / NXCD, r = nwg % NXCD, xcd = wgid % NXCD, off = wgid / NXCD; wgid = (xcd < r ? xcd * (q + 1) : r * (q + 1) + (xcd - r) * q) + off; }
    const int nig = WGM * nN, gid = wgid / nig, fm = gid * WGM, gsz = (nM - fm) < WGM ? (nM - fm) : WGM;
    pm = fm + ((wgid % nig) % gsz); pn = (wgid % nig) / gsz; return true;
}
struct DenseSched {
    static constexpr bool GATHER = false;
    int nM, nN, G, c; const unsigned char* vtab;
    __device__ __forceinline__ void init(int M, int N, int G_, int c_) { nM = M / BM; nN = N / BM; G = G_; c = c_; vtab = nullptr; }
    __device__ __forceinline__ bool next(int i, Unit& u) const { u.e = 0; return order_next(i, G, c, nM, nN, u.pm, u.pn); }
    __device__ __forceinline__ size_t b_off(const Unit& u, int RB) const { return (size_t)u.pn * BM * RB; }
};
struct GroupSched {
    static constexpr bool GATHER_ = false;
    int nM, nN, G, c, NB; const LAS unsigned short* te; const unsigned char* vtab;
    __device__ __forceinline__ bool next(int i, Unit& u) const { if (!order_next(i, G, c, nM, nN, u.pm, u.pn)) return false; u.e = __builtin_amdgcn_readfirstlane((int)te[u.pm]); return true; }
    __device__ __forceinline__ size_t b_off(const Unit& u, int RB) const { return ((size_t)u.e * NB + (size_t)u.pn * BM) * RB; }
};
struct GroupSchedG : GroupSched { static constexpr bool GATHER = true; };
struct GroupSchedD : GroupSched { static constexpr bool GATHER = false; };

template <bool F8, class Epi, class Sched>
__device__ __forceinline__ void gemm_phase(LAS unsigned char* lds, const char* A, const char* Bt, const int RB, const Sched& S, const Epi& E) {
    const int tid = threadIdx.x, wid = __builtin_amdgcn_readfirstlane(tid >> 6), lane = tid & 63, wr = wid >> 2, wc = wid & 3, fr = lane & 15, fq = lane >> 4;
    const int nt = RB / 128;
    unsigned voffB[2], cA[2]; int RA[2];
#pragma unroll
    for (int i = 0; i < 2; ++i) { int R, C; stage_rc(tid * 16 + i * 8192, R, C); const int Rb = Epi::PERM ? ((R & ~31) + perm32(R & 31)) : R;
        RA[i] = R; cA[i] = (unsigned)C * 2u; voffB[i] = (unsigned)(Rb * RB) + (unsigned)C * 2u; }
    const size_t kstep = (size_t)(BK * 2);
    const size_t hstep = (size_t)HALF * RB;
    const unsigned ldsw = (unsigned)wid * 1024u;
    const int aoff = lds_byte(wr * 64 + fr, fq * 8), boff = lds_byte(wc * 32 + fr, fq * 8);
#define PG8_SA(b, h) (((b) * 2 + (h)) * HTB)
#define PG8_SB(b, h) ((4 + (b) * 2 + (h)) * HTB)
#define PG8_STAGE(bufoff, gbase, voff) do { _Pragma("unroll") for (int _i = 0; _i < 2; ++_i) \
        __builtin_amdgcn_global_load_lds((const unsigned*)((const char*)(gbase) + (voff)[_i]), (LAS unsigned*)(lds + (bufoff) + ldsw + _i * 8192), 16, 0, 0); } while (0)
#define PG8_LDA(dst, b, h) do { _Pragma("unroll") for (int m = 0; m < 4; ++m) { dst[m].lo = *(const LAS v4i*)(lds + (b) + PG8_SA(0, h) + aoff + m * 2048); dst[m].hi = *(const LAS v4i*)(lds + (b) + PG8_SA(0, h) + aoff + m * 2048 + 1024); } } while (0)
#define PG8_LDB(dst, b, h) do { _Pragma("unroll") for (int n = 0; n < 2; ++n) { dst[n].lo = *(const LAS v4i*)(lds + (b) + PG8_SB(0, h) + boff + n * 2048); dst[n].hi = *(const LAS v4i*)(lds + (b) + PG8_SB(0, h) + boff + n * 2048 + 1024); } } while (0)
#define PG8_MMA(ai, bj, At, Bt_) do { __builtin_amdgcn_s_setprio(1); _Pragma("unroll") for (int m = 0; m < 4; ++m) _Pragma("unroll") for (int n = 0; n < 2; ++n) { \
        if constexpr (F8) acc[ai][bj][m][n] = __builtin_amdgcn_mfma_scale_f32_16x16x128_f8f6f4(Bt_[n], At[m], acc[ai][bj][m][n], 0, 0, 0, 0, 0, 0); \
        else { acc[ai][bj][m][n] = __builtin_amdgcn_mfma_f32_16x16x32_bf16(v8lo(Bt_[n]), v8lo(At[m]), acc[ai][bj][m][n], 0, 0, 0); \
               acc[ai][bj][m][n] = __builtin_amdgcn_mfma_f32_16x16x32_bf16(v8hi(Bt_[n]), v8hi(At[m]), acc[ai][bj][m][n], 0, 0, 0); } } \
        __builtin_amdgcn_s_setprio(0); } while (0)
#define PG8_WAIT_V(n) asm volatile("s_waitcnt vmcnt(" #n ")" ::: "memory")
#define PG8_WAIT_L(n) asm volatile("s_waitcnt lgkmcnt(" #n ")" ::: "memory")
#define PG8_BAR __builtin_amdgcn_s_barrier()
#define PG8_SCHED __builtin_amdgcn_sched_barrier(0)
#define PG8_DENSE_V(v, u) do { _Pragma("unroll") for (int _h = 0; _h < 2; ++_h) _Pragma("unroll") for (int _i = 0; _i < 2; ++_i) (v)[_h][_i] = (unsigned)((u).pm * BM + _h * HALF + RA[_i]) * (unsigned)RB + cA[_i]; } while (0)
    Unit cur, nxt; int ui = 0;
    if (!S.next(0, cur)) return;
    f32x4 acc[2][2][4][2];
#pragma unroll
    for (int a = 0; a < 2; ++a)
#pragma unroll
        for (int b = 0; b < 2; ++b)
#pragma unroll
            for (int m = 0; m < 4; ++m)
#pragma unroll
                for (int n = 0; n < 2; ++n) acc[a][b][m][n] = (f32x4){0.f, 0.f, 0.f, 0.f};
    v8i At[4], B0[2], B1[2];
    unsigned vc[2][2], v2[2][2];
    if constexpr (Sched::GATHER) {
        __builtin_amdgcn_global_load_lds((const unsigned*)(S.vtab + ((size_t)cur.pm * 512 + tid) * 16), (LAS unsigned*)(lds + VOFF_OFF + ldsw), 16, 0, 0);
        PG8_WAIT_V(0);
        const u32x4 tv = *(const LAS u32x4*)(lds + VOFF_OFF + tid * 16); vc[0][0] = tv.x; vc[0][1] = tv.y; vc[1][0] = tv.z; vc[1][1] = tv.w;
    } else { PG8_DENSE_V(vc, cur); }
    const char* cB = Bt + S.b_off(cur, RB);
    PG8_STAGE(PG8_SB(0, 0), cB, voffB); PG8_STAGE(PG8_SB(0, 1), cB + hstep, voffB); PG8_STAGE(PG8_SA(0, 0), A, vc[0]); PG8_STAGE(PG8_SA(0, 1), A, vc[1]);
    if (wr == 1) PG8_BAR;
    PG8_WAIT_V(2); PG8_BAR;
    PG8_STAGE(PG8_SB(1, 0), cB + kstep, voffB); PG8_STAGE(PG8_SA(1, 0), A + kstep, vc[0]); PG8_STAGE(PG8_SB(1, 1), cB + hstep + kstep, voffB);
    PG8_WAIT_V(6); PG8_BAR;
    for (;;) {
        const bool has_next = S.next(ui + 1, nxt);
        const char* nB = has_next ? Bt + S.b_off(nxt, RB) : cB;
        unsigned dlt = 0u;
        if (has_next) {
            if constexpr (Sched::GATHER) __builtin_amdgcn_global_load_lds((const unsigned*)(S.vtab + ((size_t)nxt.pm * 512 + tid) * 16), (LAS unsigned*)(lds + VOFF_OFF + ((ui + 1) & 1) * 8192 + ldsw), 16, 0, 0);
            else dlt = (unsigned)(nxt.pm - cur.pm) * (unsigned)(BM * RB);
        }
#pragma unroll
        for (int h = 0; h < 2; ++h) { v2[h][0] = vc[h][0]; v2[h][1] = vc[h][1]; }
#pragma nounroll
        for (int t = 0; t < nt; ++t) {
            const int bb = t & 1; const bool w1 = (t + 1 >= nt), w2 = (t + 2 >= nt);
            if (t == nt - 2 && has_next) {
                if constexpr (Sched::GATHER) { const u32x4 tv = *(const LAS u32x4*)(lds + VOFF_OFF + ((ui + 1) & 1) * 8192 + tid * 16); v2[0][0] = tv.x; v2[0][1] = tv.y; v2[1][0] = tv.z; v2[1][1] = tv.w; }
                else {
#pragma unroll
                    for (int h = 0; h < 2; ++h) { v2[h][0] += dlt; v2[h][1] += dlt; } }
            }
            const char* a1 = w1 ? A : A + (size_t)(t + 1) * kstep;
            const char* a2 = w2 ? A + (size_t)(t + 2 - nt) * kstep : A + (size_t)(t + 2) * kstep;
            const char* b2 = w2 ? nB + (size_t)(t + 2 - nt) * kstep : cB + (size_t)(t + 2) * kstep;
            unsigned va1[2], va2[2];
#pragma unroll
            for (int i = 0; i < 2; ++i) { va1[i] = w1 ? v2[1][i] : vc[1][i]; va2[i] = w2 ? v2[0][i] : vc[0][i]; }
            const int ob = bb * (2 * HTB), on = (bb ^ 1) * (2 * HTB);
            PG8_LDB(B0, ob, 0); PG8_LDB(B1, ob, 1); PG8_SCHED; PG8_LDA(At, ob, 0); PG8_STAGE(on + PG8_SA(0, 1), a1, va1);
            PG8_WAIT_V(8); PG8_WAIT_L(0); PG8_BAR; PG8_MMA(0, 0, At, B0); PG8_MMA(0, 1, At, B1); PG8_BAR; PG8_SCHED;
            PG8_LDA(At, ob, 1); PG8_STAGE(ob + PG8_SB(0, 0), b2, voffB); PG8_STAGE(ob + PG8_SB(0, 1), b2 + hstep, voffB); PG8_STAGE(ob + PG8_SA(0, 0), a2, va2);
            PG8_WAIT_V(8); PG8_WAIT_L(0); PG8_BAR; PG8_MMA(1, 0, At, B0); PG8_MMA(1, 1, At, B1); PG8_BAR; PG8_SCHED;
        }
        if (wr == 0) PG8_BAR;
        E(acc, cur, wr, wc, fr, fq);
        if (!has_next) break;
#pragma unroll
        for (int a = 0; a < 2; ++a)
#pragma unroll
            for (int b = 0; b < 2; ++b)
#pragma unroll
                for (int m = 0; m < 4; ++m)
#pragma unroll
                    for (int n = 0; n < 2; ++n) acc[a][b][m][n] = (f32x4){0.f, 0.f, 0.f, 0.f};
        cur = nxt; cB = nB; ++ui;
#pragma unroll
        for (int h = 0; h < 2; ++h) { vc[h][0] = v2[h][0]; vc[h][1] = v2[h][1]; }
        if (wr == 1) PG8_BAR;
    }
    PG8_WAIT_V(0);
    PG8_BAR;
#undef PG8_SA
#undef PG8_SB
#undef PG8_STAGE
#undef PG8_LDA
#undef PG8_LDB
#undef PG8_MMA
#undef PG8_WAIT_V
#undef PG8_WAIT_L
#undef PG8_BAR
#undef PG8_SCHED
#undef PG8_DENSE_V
}

typedef f32x4 Acc[2][2][4][2];
struct EpiInProj {
    static constexpr bool PERM = true;
    bf16_t* Q; const int* pos;
    __device__ __forceinline__ void operator()(const Acc& acc, const Unit& u, int wr, int wc, int fr, int fq) const {
        const int sec = u.pn >> 1, hf = u.pn & 1, row0 = u.pm * BM + wr * 64 + fr;
        if (sec >= 2) {
            bf16_t* base = Q + (size_t)sec * (size_t)(T * 512);
            const int col0 = hf * 256 + wc * 32 + 8 * fq;
#pragma unroll
            for (int ai = 0; ai < 2; ++ai)
#pragma unroll
                for (int m = 0; m < 4; ++m) { bf16_t* rowp = base + (size_t)(row0 + ai * HALF + m * 16) * 512 + col0;
#pragma unroll
                    for (int bj = 0; bj < 2; ++bj) { const f32x4 v0 = acc[ai][bj][m][0], v1 = acc[ai][bj][m][1];
                        u32x4 w; w.x = cvt_pk_bf16(v0[0], v0[1]); w.y = cvt_pk_bf16(v0[2], v0[3]); w.z = cvt_pk_bf16(v1[0], v1[1]); w.w = cvt_pk_bf16(v1[2], v1[3]);
                        *(u32x4*)(rowp + bj * HALF) = w; } }
        } else {
            bf16_t* base = Q + (size_t)sec * (size_t)(T * 512);
            const int head = hf * 4 + wc;
            const float lg = log2_gamma(head);
#pragma unroll
            for (int ai = 0; ai < 2; ++ai)
#pragma unroll
                for (int m = 0; m < 4; ++m) {
                    const int row = row0 + ai * HALF + m * 16; const float p = (float)pos[row]; const float c = (float)(row & (CH - 1));
                    const float sc = sec == 0 ? __builtin_amdgcn_exp2f(c * lg) : __builtin_amdgcn_exp2f(-c * lg) * 0.125f;
                    bf16_t* rowp = base + (size_t)row * 512 + head * 64 + 8 * fq;
#pragma unroll
                    for (int n = 0; n < 2; ++n) { float o1[4], o2[4];
#pragma unroll
                        for (int j = 0; j < 4; ++j) { const float ifr = __builtin_amdgcn_exp2f(-(float)(8 * fq + 4 * n + j) * (13.287712379549449f / 32.0f)) * 0.15915494309189535f;
                            const float rev = __builtin_amdgcn_fractf(p * ifr); const float sn = __builtin_amdgcn_sinf(rev), cs = __builtin_amdgcn_cosf(rev);
                            const float x1 = acc[ai][0][m][n][j], x2 = acc[ai][1][m][n][j];
                            o1[j] = (x1 * cs - x2 * sn) * sc; o2[j] = (x2 * cs + x1 * sn) * sc; }
                        u32x2 w; w.x = cvt_pk_bf16(o1[0], o1[1]); w.y = cvt_pk_bf16(o1[2], o1[3]); *(u32x2*)(rowp + 4 * n) = w;
                        w.x = cvt_pk_bf16(o2[0], o2[1]); w.y = cvt_pk_bf16(o2[2], o2[3]); *(u32x2*)(rowp + 32 + 4 * n) = w; }
                }
        }
    }
};
struct EpiPlainBf16 {
    static constexpr bool PERM = true;
    bf16_t* O; int ldc;
    __device__ __forceinline__ void operator()(const Acc& acc, const Unit& u, int wr, int wc, int fr, int fq) const {
        const int row0 = u.pm * BM + wr * 64 + fr, col0 = u.pn * BM + wc * 32 + 8 * fq;
#pragma unroll
        for (int ai = 0; ai < 2; ++ai)
#pragma unroll
            for (int m = 0; m < 4; ++m) { bf16_t* rowp = O + (size_t)(row0 + ai * HALF + m * 16) * ldc + col0;
#pragma unroll
                for (int bj = 0; bj < 2; ++bj) { const f32x4 v0 = acc[ai][bj][m][0], v1 = acc[ai][bj][m][1];
                    u32x4 w; w.x = cvt_pk_bf16(v0[0], v0[1]); w.y = cvt_pk_bf16(v0[2], v0[3]); w.z = cvt_pk_bf16(v1[0], v1[1]); w.w = cvt_pk_bf16(v1[2], v1[3]);
                    *(u32x4*)(rowp + bj * HALF) = w; } }
    }
};
struct EpiWout {
    static constexpr bool PERM = true;
    const float* x; bf16_t* h1b; unsigned char* h1f8; float* ssq;
    __device__ __forceinline__ void operator()(const Acc& acc, const Unit& u, int wr, int wc, int fr, int fq) const {
        const int row0 = u.pm * BM + wr * 64 + fr, col0 = u.pn * BM + wc * 32 + 8 * fq;
#pragma unroll
        for (int ai = 0; ai < 2; ++ai)
#pragma unroll
            for (int m = 0; m < 4; ++m) { const int row = row0 + ai * HALF + m * 16; const size_t off = (size_t)row * D + col0; float s = 0.f;
#pragma unroll
                for (int bj = 0; bj < 2; ++bj) { const f32x4 x0 = *(const f32x4*)(x + off + bj * HALF), x1 = *(const f32x4*)(x + off + bj * HALF + 4);
                    const f32x4 h0 = acc[ai][bj][m][0] + x0, h1 = acc[ai][bj][m][1] + x1;
                    s += (h0[0] * h0[0] + h0[1] * h0[1]) + (h0[2] * h0[2] + h0[3] * h0[3]) + (h1[0] * h1[0] + h1[1] * h1[1]) + (h1[2] * h1[2] + h1[3] * h1[3]);
                    u32x4 w; w.x = cvt_pk_bf16(h0[0], h0[1]); w.y = cvt_pk_bf16(h0[2], h0[3]); w.z = cvt_pk_bf16(h1[0], h1[1]); w.w = cvt_pk_bf16(h1[2], h1[3]);
                    *(u32x4*)(h1b + off + bj * HALF) = w;
                    u32x2 q; q.x = cvt4_fp8(h0[0], h0[1], h0[2], h0[3]); q.y = cvt4_fp8(h1[0], h1[1], h1[2], h1[3]);
                    *(u32x2*)(h1f8 + off + bj * HALF) = q; }
                s += __shfl_xor(s, 16); s += __shfl_xor(s, 32);
                if (fq == 0) ssq[(size_t)row * 16 + u.pn * 4 + wc] = s;
                if (m & 1) asm volatile("" ::: "memory"); }
    }
};
struct EpiGateUp {
    static constexpr bool PERM = true;
    unsigned char* act; const float* bgu; const float* sr;
    __device__ __forceinline__ void operator()(const Acc& acc, const Unit& u, int wr, int wc, int fr, int fq) const {
        const int prow0 = u.pm * BM + wr * 64 + fr, acol = u.pn * 128 + wc * 32 + 8 * fq;
        const float* bp = bgu + (size_t)u.e * (2 * DE) + 2 * acol;
        f32x4 b4[4];
#pragma unroll
        for (int q = 0; q < 4; ++q) b4[q] = *(const f32x4*)(bp + 4 * q);
#pragma unroll
        for (int ai = 0; ai < 2; ++ai)
#pragma unroll
            for (int m = 0; m < 4; ++m) { const int prow = prow0 + ai * HALF + m * 16; const float r = sr[prow] * (MOE_F8 ? 0.03125f : 1.0f); float o[8];
#pragma unroll
                for (int q = 0; q < 8; ++q) { float g = r * acc[ai][0][m][q >> 2][q & 3] + b4[q >> 1][(q & 1) * 2], up = r * acc[ai][1][m][q >> 2][q & 3] + b4[q >> 1][(q & 1) * 2 + 1];
                    g = fminf(g, 7.0f); up = fminf(fmaxf(up, -7.0f), 7.0f); o[q] = (up + 1.0f) * g * sigmoidf_fast(1.702f * g); }
                if (MOE_F8) { u32x2 w; w.x = cvt4_fp8(o[0], o[1], o[2], o[3]); w.y = cvt4_fp8(o[4], o[5], o[6], o[7]); *(u32x2*)(act + (size_t)prow * DE + acol) = w; }
                else { u32x4 w; w.x = cvt_pk_bf16(o[0], o[1]); w.y = cvt_pk_bf16(o[2], o[3]); w.z = cvt_pk_bf16(o[4], o[5]); w.w = cvt_pk_bf16(o[6], o[7]); *(u32x4*)(act + ((size_t)prow * DE + acol) * 2) = w; } }
    }
};
struct EpiDown {
    static constexpr bool PERM = true;
    bf16_t* y; const float* bd; const float* sg;
    __device__ __forceinline__ void operator()(const Acc& acc, const Unit& u, int wr, int wc, int fr, int fq) const {
        const int prow0 = u.pm * BM + wr * 64 + fr, col0 = u.pn * BM + wc * 32 + 8 * fq;
        const float* bp = bd + (size_t)u.e * D + col0;
        f32x4 bv[2][2];
#pragma unroll
        for (int bj = 0; bj < 2; ++bj)
#pragma unroll
            for (int n = 0; n < 2; ++n) bv[bj][n] = *(const f32x4*)(bp + bj * HALF + 4 * n);
#pragma unroll
        for (int ai = 0; ai < 2; ++ai)
#pragma unroll
            for (int m = 0; m < 4; ++m) { const int prow = prow0 + ai * HALF + m * 16; const float gw = sg[prow]; bf16_t* rowp = y + (size_t)prow * D + col0;
#pragma unroll
                for (int bj = 0; bj < 2; ++bj) { const f32x4 v0 = (acc[ai][bj][m][0] * (MOE_F8 ? 0.03125f : 1.0f) + bv[bj][0]) * gw, v1 = (acc[ai][bj][m][1] * (MOE_F8 ? 0.03125f : 1.0f) + bv[bj][1]) * gw;
                    u32x4 w; w.x = cvt_pk_bf16(v0[0], v0[1]); w.y = cvt_pk_bf16(v0[2], v0[3]); w.z = cvt_pk_bf16(v1[0], v1[1]); w.w = cvt_pk_bf16(v1[2], v1[3]);
                    *(u32x4*)(rowp + bj * HALF) = w; } }
    }
};
struct EpiPle {
    static constexpr bool PERM = true;
    float* out; const bf16_t* h2b; const bf16_t* pp; const float* rstd2;
    __device__ __forceinline__ void operator()(const Acc& acc, const Unit& u, int wr, int wc, int fr, int fq) const {
        const int row0 = u.pm * BM + wr * 64 + fr, col0 = u.pn * BM + wc * 32 + 8 * fq;
#pragma unroll
        for (int ai = 0; ai < 2; ++ai)
#pragma unroll
            for (int m = 0; m < 4; ++m) { const int row = row0 + ai * HALF + m * 16; const float r = rstd2[row]; const size_t off = (size_t)row * D + col0;
#pragma unroll
                for (int bj = 0; bj < 2; ++bj) { const u32x4 pw = *(const u32x4*)(pp + off + bj * HALF); const u32x4 hw = *(const u32x4*)(h2b + off + bj * HALF);
                    const f32x4 a0 = acc[ai][bj][m][0] * r, a1 = acc[ai][bj][m][1] * r; f32x4 o0, o1;
                    o0[0] = bf_lo(hw.x) + sigmoidf_fast(a0[0]) * bf_lo(pw.x); o0[1] = bf_hi(hw.x) + sigmoidf_fast(a0[1]) * bf_hi(pw.x); o0[2] = bf_lo(hw.y) + sigmoidf_fast(a0[2]) * bf_lo(pw.y); o0[3] = bf_hi(hw.y) + sigmoidf_fast(a0[3]) * bf_hi(pw.y);
                    o1[0] = bf_lo(hw.z) + sigmoidf_fast(a1[0]) * bf_lo(pw.z); o1[1] = bf_hi(hw.z) + sigmoidf_fast(a1[1]) * bf_hi(pw.z); o1[2] = bf_lo(hw.w) + sigmoidf_fast(a1[2]) * bf_lo(pw.w); o1[3] = bf_hi(hw.w) + sigmoidf_fast(a1[3]) * bf_hi(pw.w);
                    *(f32x4*)(out + off + bj * HALF) = o0; *(f32x4*)(out + off + bj * HALF + 4) = o1; }
                if (m & 1) asm volatile("" ::: "memory"); }
    }
};
}

struct Args { const void* in[20]; float* out; unsigned char* ws; int ph_lo, ph_hi; };
enum { I_X = 0, I_P, I_POS, I_WIN, I_WOUT, I_GNW, I_POOLW, I_POOLS, I_NMIX, I_NMOE, I_RW, I_RB, I_WGU, I_BGU, I_WD, I_BD, I_NPLE, I_WG, I_WP, I_NFIN };
constexpr int NPH = 13;

enum { WK_PLAIN = 0, WK_WIN = 1, WK_GU = 2 };
template <int KIND> __device__ __forceinline__ int dst_row(int c) {
    if (KIND == WK_WIN) { if (c < 1024) { const int sec = c >> 9, within = c & 511, head = within >> 6, d = within & 63; return (sec * 2 + (head >> 2)) * 256 + (d >> 5) * 128 + (head & 3) * 32 + (d & 31); } return c; }
    if (KIND == WK_GU) { const int a = c >> 1; return (a >> 7) * 256 + (c & 1) * 128 + (a & 127); }
    return c;
}
template <int KIND, bool OUT8> __device__ __forceinline__ void tr_item(const float* W, int K, int N, void* WT, LAS float* scr, int kb, int cb, int lane, const float* ks, float mul) {
    const int k0 = 64 * kb, c0 = 64 * cb; const bool ok = (c0 + lane) < N;
    const float* src = W + (size_t)k0 * N + c0 + lane;
#pragma unroll 16
    for (int kk = 0; kk < 64; ++kk) { const float sc = ks ? ks[k0 + kk] * mul : mul; scr[kk * 65 + lane] = ok ? src[(size_t)kk * N] * sc : 0.f; }
    LDS_WAIT(); asm volatile("" ::: "memory");
    const int c = lane & 7;
#pragma unroll
    for (int w = 0; w < 8; ++w) { const int r = (lane >> 3) + 8 * w; const LAS float* s = scr + (8 * c) * 65 + r;
        if (OUT8) { u32x2 o; o.x = cvt4_fp8(s[0 * 65], s[1 * 65], s[2 * 65], s[3 * 65]); o.y = cvt4_fp8(s[4 * 65], s[5 * 65], s[6 * 65], s[7 * 65]);
            if (c0 + r < N) *(u32x2*)((unsigned char*)WT + (size_t)dst_row<KIND>(c0 + r) * K + k0 + 8 * c) = o; }
        else { u32x4 o; o.x = cvt_pk_bf16(s[0 * 65], s[1 * 65]); o.y = cvt_pk_bf16(s[2 * 65], s[3 * 65]); o.z = cvt_pk_bf16(s[4 * 65], s[5 * 65]); o.w = cvt_pk_bf16(s[6 * 65], s[7 * 65]);
            if (c0 + r < N) *(u32x4*)((bf16_t*)WT + (size_t)dst_row<KIND>(c0 + r) * K + k0 + 8 * c) = o; } }
    LDS_WAIT(); asm volatile("" ::: "memory");
}
__device__ __forceinline__ void phase_prologue(const Args& a, LAS unsigned char* lds, int vcu, int G) {
    const int tid = threadIdx.x, lane = tid & 63, wave = __builtin_amdgcn_readfirstlane(tid >> 6);
    LAS float* scr = (LAS float*)(lds + wave * 16640);
    const int gw = vcu * 8 + wave, NGW = G * 8;
    unsigned char* ws = a.ws;
    constexpr int I_GU = NE * 16 * 32, I_DN = NE * 16 * 16, I_WINI = 16 * 40, I_SQ = 16 * 16, I_WPI = 4 * 16, I_RT = 16, I_PW = 4 * 4;
    constexpr int NITEMS = I_GU + I_DN + I_WINI + 2 * I_SQ + I_WPI + I_RT + I_PW;
    for (int it = gw; it < NITEMS; it += NGW) {
        int r = it;
        if (r < I_GU) { const int e = r / 512, q = r % 512; tr_item<WK_GU, MOE_F8 != 0>((const float*)a.in[I_WGU] + (size_t)e * D * 2 * DE, D, 2 * DE, ws + WS_WGU + (size_t)e * 2 * DE * D * (MOE_F8 ? 1 : 2), scr, q / 32, q % 32, lane, (const float*)a.in[I_NMOE], MOE_F8 ? 32.0f : 1.0f); continue; } r -= I_GU;
        if (r < I_DN) { const int e = r / 256, q = r % 256; tr_item<WK_PLAIN, MOE_F8 != 0>((const float*)a.in[I_WD] + (size_t)e * DE * D, DE, D, ws + WS_WD + (size_t)e * D * DE * (MOE_F8 ? 1 : 2), scr, q / 16, q % 16, lane, nullptr, MOE_F8 ? 32.0f : 1.0f); continue; } r -= I_DN;
        if (r < I_WINI) { tr_item<WK_WIN, false>((const float*)a.in[I_WIN], D, NIN, ws + WS_WIN, scr, r / 40, r % 40, lane, nullptr, 1.0f); continue; } r -= I_WINI;
        if (r < I_SQ) { tr_item<WK_PLAIN, false>((const float*)a.in[I_WOUT], D, D, ws + WS_WOUT, scr, r / 16, r % 16, lane, nullptr, 1.0f); continue; } r -= I_SQ;
        if (r < I_SQ) { tr_item<WK_PLAIN, false>((const float*)a.in[I_WG], D, D, ws + WS_WG, scr, r / 16, r % 16, lane, (const float*)a.in[I_NPLE], 1.0f); continue; } r -= I_SQ;
        if (r < I_WPI) { tr_item<WK_PLAIN, false>((const float*)a.in[I_WP], PLE, D, ws + WS_WPT, scr, r / 16, r % 16, lane, nullptr, 1.0f); continue; } r -= I_WPI;
        if (r < I_RT) { tr_item<WK_PLAIN, false>((const float*)a.in[I_RW], D, NE, ws + WS_ROUT, scr, r, 0, lane, (const float*)a.in[I_NMOE], 1.0f); continue; } r -= I_RT;
        { const int g = r / 4, q = r % 4; tr_item<WK_PLAIN, false>((const float*)a.in[I_POOLW] + (size_t)g * 128 * 128, 128, 128, ws + WS_PWT + (size_t)g * 128 * 128 * 2, scr, q / 2, q % 2, lane, nullptr, 1.0f); }
    }
    const float* x = (const float*)a.in[I_X]; const float* nw = (const float*)a.in[I_NMIX]; bf16_t* hn = (bf16_t*)(ws + WS_HN1);
    f32x4 wv[4];
#pragma unroll
    for (int j = 0; j < 4; ++j) wv[j] = *((const f32x4*)nw + lane + 64 * j);
    for (int m = gw; m < T; m += NGW) {
        const f32x4* xr = (const f32x4*)(x + (size_t)m * D) + lane; f32x4 v[4]; float s = 0.f;
#pragma unroll
        for (int j = 0; j < 4; ++j) { v[j] = xr[64 * j]; s += (v[j][0] * v[j][0] + v[j][1] * v[j][1]) + (v[j][2] * v[j][2] + v[j][3] * v[j][3]); }
        const float rstd = __builtin_amdgcn_rsqf(wave_sum(s) * (1.f / D) + NORM_EPS);
        u32x2* o8 = (u32x2*)(hn + (size_t)m * D) + lane;
#pragma unroll
        for (int j = 0; j < 4; ++j) { const f32x4 y = v[j] * rstd * wv[j]; u32x2 w; w.x = cvt_pk_bf16(y[0], y[1]); w.y = cvt_pk_bf16(y[2], y[3]); o8[64 * j] = w; }
    }
    const f32x4* pv = (const f32x4*)a.in[I_P]; u32x2* pb = (u32x2*)(ws + WS_PB);
    for (size_t i = (size_t)vcu * 512 + tid; i < (size_t)T * PLE / 4; i += (size_t)G * 512) { const f32x4 v = pv[i]; u32x2 w; w.x = cvt_pk_bf16(v[0], v[1]); w.y = cvt_pk_bf16(v[2], v[3]); pb[i] = w; }
}

__device__ __forceinline__ int tt_off(int d, int m) { return d * 136 + ((((m >> 3) ^ ((d >> 3) & 7)) << 3) | (m & 7)); }
__device__ __forceinline__ void tt_write8(LAS bf16_t* base, int d0, int m, const u32x4 v) {
    const int blk = (((m >> 3) ^ ((d0 >> 3) & 7)) << 3) | (m & 7); LAS bf16_t* p = base + d0 * 136 + blk;
    p[0 * 136] = (bf16_t)(v.x & 0xffff); p[1 * 136] = (bf16_t)(v.x >> 16); p[2 * 136] = (bf16_t)(v.y & 0xffff); p[3 * 136] = (bf16_t)(v.y >> 16);
    p[4 * 136] = (bf16_t)(v.z & 0xffff); p[5 * 136] = (bf16_t)(v.z >> 16); p[6 * 136] = (bf16_t)(v.w & 0xffff); p[7 * 136] = (bf16_t)(v.w >> 16);
}
__device__ __forceinline__ void phase_kv(const Args& a, LAS unsigned char* lds, int G) {
    const int tid = threadIdx.x, lane = tid & 63, w = __builtin_amdgcn_readfirstlane(tid >> 6), fr = lane & 15, fq = lane >> 4;
    const bf16_t* Kb = (const bf16_t*)(a.ws + WS_K); const bf16_t* Vb = (const bf16_t*)(a.ws + WS_V); float* KV = (float*)(a.ws + WS_KV);
    const int seg = tid & 7, r0 = tid >> 3;
    u32x4 rk[2], rv[2];
    int u = blockIdx.x;
#define KV_LOAD(uu) do { const size_t tok0 = (size_t)((uu) >> 3) * CH; const int hc = ((uu) & 7) * HD; _Pragma("unroll") for (int i = 0; i < 2; ++i) { const size_t o = (tok0 + r0 + 64 * i) * 512 + hc + seg * 8; rk[i] = *(const u32x4*)(Kb + o); rv[i] = *(const u32x4*)(Vb + o); } } while (0)
    if (u < 2048) KV_LOAD(u);
    for (int buf = 0; u < 2048; u += G, buf ^= 1) {
        LAS bf16_t* KT = (LAS bf16_t*)(lds + buf * 34816); LAS bf16_t* VT = KT + 64 * 136;
#pragma unroll
        for (int i = 0; i < 2; ++i) { tt_write8(KT, seg * 8, r0 + 64 * i, rk[i]); tt_write8(VT, seg * 8, r0 + 64 * i, rv[i]); }
        __syncthreads();
        if (u + G < 2048) KV_LOAD(u + G);
        const int dt = w & 3; const float sc = __builtin_amdgcn_exp2f(127.0f * log2_gamma(u & 7));
#pragma unroll
        for (int q = 0; q < 2; ++q) { const int et = (w >> 2) * 2 + q; f32x4 acc = {0.f, 0.f, 0.f, 0.f};
#pragma unroll
            for (int ks = 0; ks < 4; ++ks) { const int d = 16 * dt + fr, e = 16 * et + fr, m0 = 32 * ks + 8 * fq;
                const bf16x8 A = *(const LAS bf16x8*)(KT + tt_off(d, m0)); const bf16x8 B = *(const LAS bf16x8*)(VT + tt_off(e, m0));
                acc = __builtin_amdgcn_mfma_f32_16x16x32_bf16(A, B, acc, 0, 0, 0); }
            *(f32x4*)(KV + (size_t)u * 4096 + (16 * et + fr) * 64 + 16 * dt + 4 * fq) = acc * sc; }
    }
#undef KV_LOAD
    __syncthreads();
}
__device__ __forceinline__ void phase_pool(const Args& a, LAS unsigned char* lds, int G) {
    const int tid = threadIdx.x, lane = tid & 63, w = __builtin_amdgcn_readfirstlane(tid >> 6), fr = lane & 15, fq = lane >> 4;
    const bf16_t* U = (const bf16_t*)(a.ws + WS_U); const bf16_t* PWt = (const bf16_t*)(a.ws + WS_PWT); bf16_t* MIX = (bf16_t*)(a.ws + WS_MIX);
    const float* pscale = (const float*)a.in[I_POOLS];
    LAS bf16_t* UB = (LAS bf16_t*)lds; LAS bf16_t* PA = (LAS bf16_t*)(lds + 38912); LAS bf16_t* PW = (LAS bf16_t*)(lds + 73728);
    int gl = -1;
    for (int u = blockIdx.x; u < (T / 128) * 4; u += G) {
        const int g = u & 3, t0 = (u >> 2) * 128;
        if (g != gl) { gl = g;
#pragma unroll
            for (int i = 0; i < 4; ++i) { const int p = tid + 512 * i, d = p >> 4, sg = p & 15; *(LAS u32x4*)(PW + d * 136 + sg * 8) = *(const u32x4*)(PWt + ((size_t)g * 128 + d) * 128 + sg * 8); } }
        const bool seq0 = (t0 & (SEQ - 1)) == 0;
#pragma unroll
        for (int i = 0; i < 5; ++i) { const int p = tid + 512 * i, lr = p >> 4, sg = p & 15;
            if (lr < 143) { u32x4 v = {0u, 0u, 0u, 0u}; if (lr >= 15 || !seq0) v = *(const u32x4*)(U + (size_t)(t0 - 15 + lr) * 512 + g * 128 + sg * 8); *(LAS u32x4*)(UB + lr * 136 + sg * 8) = v; } }
        __syncthreads();
        { const int cg = tid & 15, rg = tid >> 4, wnd = 2 << g;
#pragma unroll
          for (int q = 0; q < 4; ++q) { const int r = 4 * rg + q; const int s = (t0 + r) & (SEQ - 1); const float inv = 1.0f / (float)((s + 1) < wnd ? (s + 1) : wnd);
              float sum[8];
#pragma unroll
              for (int j = 0; j < 8; ++j) sum[j] = 0.f;
              for (int k = 0; k < wnd; ++k) { const u32x4 v = *(const LAS u32x4*)(UB + (r + 15 - k) * 136 + cg * 8);
                  sum[0] += bf_lo(v.x); sum[1] += bf_hi(v.x); sum[2] += bf_lo(v.y); sum[3] += bf_hi(v.y); sum[4] += bf_lo(v.z); sum[5] += bf_hi(v.z); sum[6] += bf_lo(v.w); sum[7] += bf_hi(v.w); }
              const u32x4 c = *(const LAS u32x4*)(UB + (r + 15) * 136 + cg * 8);
              u32x4 o; o.x = cvt_pk_bf16(sum[0] * inv - bf_lo(c.x), sum[1] * inv - bf_hi(c.x)); o.y = cvt_pk_bf16(sum[2] * inv - bf_lo(c.y), sum[3] * inv - bf_hi(c.y));
              o.z = cvt_pk_bf16(sum[4] * inv - bf_lo(c.z), sum[5] * inv - bf_hi(c.z)); o.w = cvt_pk_bf16(sum[6] * inv - bf_lo(c.w), sum[7] * inv - bf_hi(c.w));
              *(LAS u32x4*)(PA + r * 136 + cg * 8) = o; } }
        __syncthreads();
        f32x4 acc[8];
#pragma unroll
        for (int dt = 0; dt < 8; ++dt) acc[dt] = (f32x4){0.f, 0.f, 0.f, 0.f};
#pragma unroll
        for (int kk = 0; kk < 4; ++kk) { const bf16x8 B = *(const LAS bf16x8*)(PA + (16 * w + fr) * 136 + 32 * kk + 8 * fq);
#pragma unroll
            for (int dt = 0; dt < 8; ++dt) { const bf16x8 A = *(const LAS bf16x8*)(PW + (16 * dt + fr) * 136 + 32 * kk + 8 * fq); acc[dt] = __builtin_amdgcn_mfma_f32_16x16x32_bf16(A, B, acc[dt], 0, 0, 0); } }
        const size_t tok = (size_t)t0 + 16 * w + fr;
#pragma unroll
        for (int dt = 0; dt < 8; ++dt) { const int d = 16 * dt + 4 * fq; const f32x4 sc = *(const f32x4*)(pscale + g * 128 + d); const f32x4 o = acc[dt] * sc;
            u32x2 wv; wv.x = cvt_pk_bf16(o[0], o[1]); wv.y = cvt_pk_bf16(o[2], o[3]); *(u32x2*)(MIX + tok * D + 512 + g * 128 + d) = wv; }
        __syncthreads();
    }
}
__device__ __forceinline__ void phase_scan(const Args& a, int G) {
    const float* KV = (const float*)(a.ws + WS_KV); bf16_t* ST = (bf16_t*)(a.ws + WS_ST);
    for (int v = blockIdx.x * 512 + threadIdx.x; v < NBATCH * NH * 1024; v += G * 512) {
        const int bh = v >> 10, q = v & 1023, b = bh >> 3, h = bh & 7;
        const float lg = log2_gamma(h), gam = __builtin_amdgcn_exp2f(lg), cd = __builtin_amdgcn_exp2f(128.0f * lg);
        f32x4 s = {0.f, 0.f, 0.f, 0.f};
        for (int n0 = 0; n0 < NCH; n0 += 8) { f32x4 kv[8];
#pragma unroll
            for (int j = 0; j < 8; ++j) kv[j] = *(const f32x4*)(KV + ((size_t)((b * NCH + n0 + j) * NH + h)) * 4096 + q * 4);
#pragma unroll
            for (int j = 0; j < 8; ++j) { const f32x4 o = s * gam; u32x2 wv; wv.x = cvt_pk_bf16(o[0], o[1]); wv.y = cvt_pk_bf16(o[2], o[3]);
                *(u32x2*)(ST + ((size_t)((b * NCH + n0 + j) * NH + h)) * 4096 + q * 4) = wv; s = s * cd + kv[j]; } }
    }
}
__device__ __forceinline__ void phase_ret(const Args& a, LAS unsigned char* lds, int G) {
    const int tid = threadIdx.x, lane = tid & 63, w = __builtin_amdgcn_readfirstlane(tid >> 6), fr = lane & 15, fq = lane >> 4;
    const bf16_t* Qb = (const bf16_t*)(a.ws + WS_Q); const bf16_t* Kb = (const bf16_t*)(a.ws + WS_K); const bf16_t* Vb = (const bf16_t*)(a.ws + WS_V);
    const bf16_t* Gb = (const bf16_t*)(a.ws + WS_G); const bf16_t* STg = (const bf16_t*)(a.ws + WS_ST); bf16_t* MIX = (bf16_t*)(a.ws + WS_MIX);
    const float* gnw = (const float*)a.in[I_GNW];
    const int seg = tid & 7, r0 = tid >> 3;
    u32x4 rk[2], rv[2], rs;
    int u = blockIdx.x;
#define RT_LOAD(uu) do { const size_t tok0 = (size_t)((uu) >> 3) * CH; const int hc = ((uu) & 7) * HD; _Pragma("unroll") for (int i = 0; i < 2; ++i) { const size_t o = (tok0 + r0 + 64 * i) * 512 + hc + seg * 8; rk[i] = *(const u32x4*)(Kb + o); rv[i] = *(const u32x4*)(Vb + o); } \
        rs = *(const u32x4*)(STg + (size_t)(uu) * 4096 + r0 * 64 + seg * 8); } while (0)
    if (u < 2048) RT_LOAD(u);
    for (int buf = 0; u < 2048; u += G, buf ^= 1) {
        LAS bf16_t* Kr = (LAS bf16_t*)(lds + buf * 45056); LAS bf16_t* VT = Kr + 128 * 72; LAS bf16_t* SL = VT + 64 * 136;
#pragma unroll
        for (int i = 0; i < 2; ++i) { *(LAS u32x4*)(Kr + (r0 + 64 * i) * 72 + seg * 8) = rk[i]; tt_write8(VT, seg * 8, r0 + 64 * i, rv[i]); }
        *(LAS u32x4*)(SL + r0 * 72 + seg * 8) = rs;
        __syncthreads();
        if (u + G < 2048) RT_LOAD(u + G);
        const size_t tok0 = (size_t)(u >> 3) * CH; const int hc = (u & 7) * HD; const size_t ctok = tok0 + 16 * w + fr;
        bf16x8 qf[2];
#pragma unroll
        for (int kk = 0; kk < 2; ++kk) qf[kk] = *(const bf16x8*)(Qb + ctok * 512 + hc + 32 * kk + 8 * fq);
        u32x2 pk[8];
#pragma unroll
        for (int am = 0; am < 8; ++am) {
            if (am <= w) { f32x4 s = {0.f, 0.f, 0.f, 0.f};
#pragma unroll
                for (int kk = 0; kk < 2; ++kk) { const bf16x8 A = *(const LAS bf16x8*)(Kr + (16 * am + fr) * 72 + 32 * kk + 8 * fq); s = __builtin_amdgcn_mfma_f32_16x16x32_bf16(A, qf[kk], s, 0, 0, 0); }
                if (am == w) {
#pragma unroll
                    for (int j = 0; j < 4; ++j) if (4 * fq + j > fr) s[j] = 0.f; }
                pk[am].x = cvt_pk_bf16(s[0], s[1]); pk[am].y = cvt_pk_bf16(s[2], s[3]);
            } else { pk[am].x = 0u; pk[am].y = 0u; } }
        f32x4 y[4];
#pragma unroll
        for (int et = 0; et < 4; ++et) y[et] = (f32x4){0.f, 0.f, 0.f, 0.f};
#pragma unroll
        for (int s2 = 0; s2 < 4; ++s2) {
            if (2 * s2 <= w) { u32x4 bw; bw.x = pk[2 * s2].x; bw.y = pk[2 * s2].y; bw.z = pk[2 * s2 + 1].x; bw.w = pk[2 * s2 + 1].y; const bf16x8 B = __builtin_bit_cast(bf16x8, bw);
#pragma unroll
                for (int et = 0; et < 4; ++et) { const int e = 16 * et + fr, es = (e >> 3) & 7;
                    const u32x2 lo = *(const LAS u32x2*)(VT + e * 136 + (((4 * s2 + (fq >> 1)) ^ es) << 3) + 4 * (fq & 1));
                    const u32x2 hi = *(const LAS u32x2*)(VT + e * 136 + (((4 * s2 + 2 + (fq >> 1)) ^ es) << 3) + 4 * (fq & 1));
                    u32x4 aw; aw.x = lo.x; aw.y = lo.y; aw.z = hi.x; aw.w = hi.y;
                    y[et] = __builtin_amdgcn_mfma_f32_16x16x32_bf16(__builtin_bit_cast(bf16x8, aw), B, y[et], 0, 0, 0); } } }
#pragma unroll
        for (int kk = 0; kk < 2; ++kk)
#pragma unroll
            for (int et = 0; et < 4; ++et) { const bf16x8 A = *(const LAS bf16x8*)(SL + (16 * et + fr) * 72 + 32 * kk + 8 * fq); y[et] = __builtin_amdgcn_mfma_f32_16x16x32_bf16(A, qf[kk], y[et], 0, 0, 0); }
        float s = 0.f;
#pragma unroll
        for (int et = 0; et < 4; ++et) s += (y[et][0] + y[et][1]) + (y[et][2] + y[et][3]);
        s += __shfl_xor(s, 16); s += __shfl_xor(s, 32);
        const float mean = s * (1.0f / 64.0f); float q2 = 0.f;
#pragma unroll
        for (int et = 0; et < 4; ++et) { const f32x4 d = y[et] - mean; q2 += (d[0] * d[0] + d[1] * d[1]) + (d[2] * d[2] + d[3] * d[3]); }
        q2 += __shfl_xor(q2, 16); q2 += __shfl_xor(q2, 32);
        const float rstd = __builtin_amdgcn_rsqf(q2 * (1.0f / 64.0f) + GN_EPS);
#pragma unroll
        for (int et = 0; et < 4; ++et) { const int col = hc + 16 * et + 4 * fq; const u32x2 gv = *(const u32x2*)(Gb + ctok * 512 + col); const f32x4 gw = *(const f32x4*)(gnw + col);
            const float g0 = bf_lo(gv.x), g1 = bf_hi(gv.x), g2 = bf_lo(gv.y), g3 = bf_hi(gv.y);
            const float o0 = (y[et][0] - mean) * rstd * gw[0] * g0 * sigmoidf_fast(g0), o1 = (y[et][1] - mean) * rstd * gw[1] * g1 * sigmoidf_fast(g1);
            const float o2 = (y[et][2] - mean) * rstd * gw[2] * g2 * sigmoidf_fast(g2), o3 = (y[et][3] - mean) * rstd * gw[3] * g3 * sigmoidf_fast(g3);
            u32x2 wv; wv.x = cvt_pk_bf16(o0, o1); wv.y = cvt_pk_bf16(o2, o3); *(u32x2*)(MIX + ctok * D + col) = wv; }
    }
#undef RT_LOAD
    __syncthreads();
}

__device__ __forceinline__ void phase_router(const Args& a, LAS unsigned char* lds, int G) {
    const int tid = threadIdx.x, lane = tid & 63, w = __builtin_amdgcn_readfirstlane(tid >> 6), fr = lane & 15, fq = lane >> 4;
    const bf16_t* RT = (const bf16_t*)(a.ws + WS_ROUT); const bf16_t* H1W = (const bf16_t*)(a.ws + WS_HN1); const float* ssq = (const float*)(a.ws + WS_SSQ1);
    const float* rb = (const float*)a.in[I_RB];
    int* topi = (int*)(a.ws + WS_TOPI); float* topg = (float*)(a.ws + WS_TOPG); float* rstd1 = (float*)(a.ws + WS_RSTD1); int* bh = (int*)(a.ws + WS_BH);
    LAS bf16_t* RL = (LAS bf16_t*)lds;
    LAS float* LG = (LAS float*)(lds + 66048) + w * (16 * 33);
    LAS int* hist = (LAS int*)(lds + 66048 + 8 * 16 * 33 * 4);
#pragma unroll
    for (int i = 0; i < 8; ++i) { const int p = tid + 512 * i, e = p >> 7, sg = p & 127; *(LAS u32x4*)(RL + e * 1032 + sg * 8) = *(const u32x4*)(RT + (size_t)e * D + sg * 8); }
    for (int tb = blockIdx.x; tb < T / 128; tb += G) {
        if (tid < 32) hist[tid] = 0;
        __syncthreads();
        const size_t t0 = (size_t)tb * 128 + 16 * w;
        f32x4 acc0 = {0.f, 0.f, 0.f, 0.f}, acc1 = {0.f, 0.f, 0.f, 0.f};
#pragma unroll 8
        for (int kk = 0; kk < 32; ++kk) { const bf16x8 B = *(const bf16x8*)(H1W + (t0 + fr) * D + 32 * kk + 8 * fq);
            const bf16x8 A0 = *(const LAS bf16x8*)(RL + fr * 1032 + 32 * kk + 8 * fq), A1 = *(const LAS bf16x8*)(RL + (16 + fr) * 1032 + 32 * kk + 8 * fq);
            acc0 = __builtin_amdgcn_mfma_f32_16x16x32_bf16(A0, B, acc0, 0, 0, 0); acc1 = __builtin_amdgcn_mfma_f32_16x16x32_bf16(A1, B, acc1, 0, 0, 0); }
#pragma unroll
        for (int j = 0; j < 4; ++j) { LG[fr * 33 + 4 * fq + j] = acc0[j]; LG[fr * 33 + 16 + 4 * fq + j] = acc1[j]; }
        LDS_WAIT(); asm volatile("" ::: "memory");
        if (lane < 16) {
            const size_t t = t0 + lane; float sq = 0.f;
#pragma unroll
            for (int q = 0; q < 4; ++q) { const f32x4 v = *(const f32x4*)(ssq + t * 16 + 4 * q); sq += (v[0] + v[1]) + (v[2] + v[3]); }
            const float rstd = __builtin_amdgcn_rsqf(sq * (1.f / D) + NORM_EPS);
            float v0 = -3.0e38f, v1 = -3.0e38f, v2 = -3.0e38f, v3 = -3.0e38f; int i0 = 0, i1 = 0, i2 = 0, i3 = 0;
#pragma unroll
            for (int e = 0; e < NE; ++e) { const float v = LG[lane * 33 + e] * rstd + rb[e];
                if (v > v3) { if (v > v2) { v3 = v2; i3 = i2; if (v > v1) { v2 = v1; i2 = i1; if (v > v0) { v1 = v0; i1 = i0; v0 = v; i0 = e; } else { v1 = v; i1 = e; } } else { v2 = v; i2 = e; } } else { v3 = v; i3 = e; } } }
            const float e1 = __expf(v1 - v0), e2 = __expf(v2 - v0), e3 = __expf(v3 - v0), inv = 1.0f / (1.0f + e1 + e2 + e3);
            *(int4*)(topi + t * 4) = make_int4(i0, i1, i2, i3); *(float4*)(topg + t * 4) = make_float4(inv, e1 * inv, e2 * inv, e3 * inv); rstd1[t] = rstd;
            lds_inc(&hist[i0]); lds_inc(&hist[i1]); lds_inc(&hist[i2]); lds_inc(&hist[i3]);
        }
        __syncthreads();
        if (tid < 32) bh[tb * 32 + tid] = hist[tid];
        __syncthreads();
    }
}
__device__ __forceinline__ void vtab_put(unsigned* vt, int pos, unsigned tok) {
    const int tile = pos >> 8, r = pos & 255, hh = r >> 7, R = r & 127, rg = R >> 4, rr = R & 15;
#pragma unroll
    for (int ch = 0; ch < 2; ++ch)
#pragma unroll
        for (int p = 0; p < 4; ++p) { const int st = rg * 2 + ch, ob = rr * 64 + p * 16, sb = ob ^ (((ob >> 9) & 1) << 5), b = st * 1024 + sb, i = b >> 13, td = (b & 8191) >> 4;
            vt[((size_t)tile * 512 + td) * 4 + hh * 2 + i] = tok * (unsigned)(MOE_F8 ? D : 2 * D) + ch * 64 + p * 16; }
}
__device__ __forceinline__ void phase_place(const Args& a, LAS unsigned char* lds, int G) {
    const int tid = threadIdx.x;
    const int* bh = (const int*)(a.ws + WS_BH); const int* topi = (const int*)(a.ws + WS_TOPI); const float* topg = (const float*)(a.ws + WS_TOPG); const float* rstd1 = (const float*)(a.ws + WS_RSTD1);
    int* spos = (int*)(a.ws + WS_SPOS); float* SG = (float*)(a.ws + WS_SG); float* SR = (float*)(a.ws + WS_SR); unsigned* vt = (unsigned*)(a.ws + WS_VTAB);
    unsigned* ctl = (unsigned*)(a.ws + WS_CTL);
    LAS int* pt = (LAS int*)lds; LAS int* pb = pt + 512; LAS int* tot = pb + 512; LAS int* off = tot + 32; LAS int* base = off + 32; LAS int* rank = base + 32;
    constexpr int NTB = T / 128;
    for (int it = 0, tb = blockIdx.x; it == 0 || tb < NTB; ++it, tb += G) {
        const int e = tid & 31, part = tid >> 5; int st = 0, sb = 0;
        for (int b = part; b < NTB; b += 16) { const int v = bh[b * 32 + e]; st += v; if (b < tb) sb += v; }
        pt[tid] = st; pb[tid] = sb;
        __syncthreads();
        if (tid < 32) { int s1 = 0, s2 = 0;
#pragma unroll
            for (int q = 0; q < 16; ++q) { s1 += pt[q * 32 + tid]; s2 += pb[q * 32 + tid]; }
            tot[tid] = s1; base[tid] = s2; rank[tid] = 0; }
        __syncthreads();
        if (tid == 0) { int o = 0; for (int q = 0; q < NE; ++q) { off[q] = o; o += (tot[q] + 255) & ~255; } }
        __syncthreads();
        if (tb < NTB) {
            const int t = tb * 128 + (tid >> 2), k = tid & 3; const int ex = topi[t * 4 + k];
            const int pos = off[ex] + base[ex] + lds_inc(&rank[ex]);
            spos[t * 4 + k] = pos; SG[pos] = topg[t * 4 + k]; SR[pos] = rstd1[t]; vtab_put(vt, pos, (unsigned)t);
        }
        if (it == 0) {
            for (int ex = blockIdx.x; ex < NE; ex += G) { const int n = tot[ex], np = (n + 255) & ~255;
                for (int r = n + tid; r < np; r += 512) { const int pos = off[ex] + r; SG[pos] = 0.f; SR[pos] = 0.f; vtab_put(vt, pos, 0u); } }
            if (blockIdx.x == 0 && tid < 32) ctl[CW_TOT + tid] = (unsigned)tot[tid];
        }
        __syncthreads();
    }
}
__device__ __forceinline__ int build_tiles(const Args& a, LAS unsigned short* te) {
    const unsigned* ctl = (const unsigned*)(a.ws + WS_CTL);
    int o = 0;
    for (int e = 0; e < NE; ++e) { const int n = (int)((ctl[CW_TOT + e] + 255u) >> 8); for (int q = threadIdx.x; q < n; q += 512) te[o + q] = (unsigned short)e; o += n; }
    __syncthreads();
    return o;
}
__device__ __forceinline__ void phase_combine(const Args& a, int vcu, int G) {
    const int tid = threadIdx.x, lane = tid & 63, wave = tid >> 6; const int gw = vcu * 8 + wave, NGW = G * 8;
    bf16_t* hb = (bf16_t*)(a.ws + WS_HN1); const bf16_t* Y = (const bf16_t*)(a.ws + WS_Y); const int* spos = (const int*)(a.ws + WS_SPOS); float* rstd2 = (float*)(a.ws + WS_RSTD2);
    for (int t = gw; t < T; t += NGW) {
        const int4 ps = *(const int4*)(spos + (size_t)t * 4);
        float v[2][8]; float s = 0.f;
#pragma unroll
        for (int j = 0; j < 2; ++j) { const u32x4 hv = *(const u32x4*)(hb + (size_t)t * D + 8 * lane + 512 * j);
            v[j][0] = bf_lo(hv.x); v[j][1] = bf_hi(hv.x); v[j][2] = bf_lo(hv.y); v[j][3] = bf_hi(hv.y); v[j][4] = bf_lo(hv.z); v[j][5] = bf_hi(hv.z); v[j][6] = bf_lo(hv.w); v[j][7] = bf_hi(hv.w); }
#pragma unroll
        for (int k = 0; k < 4; ++k) { const int pk = k == 0 ? ps.x : (k == 1 ? ps.y : (k == 2 ? ps.z : ps.w));
#pragma unroll
            for (int j = 0; j < 2; ++j) { const u32x4 yv = *(const u32x4*)(Y + (size_t)pk * D + 8 * lane + 512 * j);
                v[j][0] += bf_lo(yv.x); v[j][1] += bf_hi(yv.x); v[j][2] += bf_lo(yv.y); v[j][3] += bf_hi(yv.y); v[j][4] += bf_lo(yv.z); v[j][5] += bf_hi(yv.z); v[j][6] += bf_lo(yv.w); v[j][7] += bf_hi(yv.w); } }
#pragma unroll
        for (int j = 0; j < 2; ++j) {
#pragma unroll
            for (int q = 0; q < 8; ++q) s += v[j][q] * v[j][q];
            u32x4 o; o.x = cvt_pk_bf16(v[j][0], v[j][1]); o.y = cvt_pk_bf16(v[j][2], v[j][3]); o.z = cvt_pk_bf16(v[j][4], v[j][5]); o.w = cvt_pk_bf16(v[j][6], v[j][7]);
            *(u32x4*)(hb + (size_t)t * D + 8 * lane + 512 * j) = o; }
        s = wave_sum(s);
        if (lane == 0) rstd2[t] = __builtin_amdgcn_rsqf(s * (1.f / D) + NORM_EPS);
    }
}
__device__ __forceinline__ void phase_final(const Args& a, int vcu, int G) {
    const int tid = threadIdx.x, lane = tid & 63, wave = tid >> 6; const int gw = vcu * 8 + wave, NGW = G * 8;
    float* h = a.out; const float* nw = (const float*)a.in[I_NFIN];
    f32x4 wv[4];
#pragma unroll
    for (int j = 0; j < 4; ++j) wv[j] = *((const f32x4*)nw + lane + 64 * j);
    float scale = 1.0f;
#if MK_DEBUG
    { const unsigned f = *(const unsigned*)(a.ws + WS_CTL + 4 * CW_FAIL); if (f) scale = 1.0f + 0.1f * (float)__builtin_ctz(f); }
#endif
    for (int t = gw; t < T; t += NGW) {
        f32x4* hr = (f32x4*)(h + (size_t)t * D) + lane; f32x4 v[4]; float s = 0.f;
#pragma unroll
        for (int j = 0; j < 4; ++j) { v[j] = hr[64 * j]; s += (v[j][0] * v[j][0] + v[j][1] * v[j][1]) + (v[j][2] * v[j][2] + v[j][3] * v[j][3]); }
        const float rstd = __builtin_amdgcn_rsqf(wave_sum(s) * (1.f / D) + NORM_EPS) * scale;
#pragma unroll
        for (int j = 0; j < 4; ++j) hr[64 * j] = v[j] * rstd * wv[j];
    }
}

__global__ void __launch_bounds__(512, 2) fwd_kernel(Args args) {
    extern __shared__ __attribute__((aligned(16))) unsigned char lds_raw[];
    LAS unsigned char* lds = (LAS unsigned char*)lds_raw;
    const int tid = threadIdx.x, G = gridDim.x;
    const int vcu = (G % 8 == 0) ? ((int)blockIdx.x % 8) * (G / 8) + (int)blockIdx.x / 8 : (int)blockIdx.x;
    volatile LAS unsigned* MISC = (volatile LAS unsigned*)(lds + LCTL_OFF);
    if (tid < 4) MISC[tid] = 0u;
    __syncthreads();
    unsigned* ctl = (unsigned*)(args.ws + WS_CTL);
    XcdBarrier bar; bar.bar = ctl + CW_BAR; bar.x = 0; bar.st = nullptr;
    const int lo = args.ph_lo, hi = args.ph_hi;
    if (hi - lo > 1) bar = xcd_barrier_post(ctl + CW_BAR, MISC);
#ifndef PH_MASK
#define PH_MASK 0x1fff
#endif
#define IN(k) (((PH_MASK >> (k)) & 1) && lo <= (k) && (k) < hi)
#define SEAM(k) do { if (IN(k) && IN((k) + 1)) xcd_barrier(bar); } while (0)
    LAS unsigned short* te = (LAS unsigned short*)(lds + LCTL_OFF + 64);
    const char* ws = (const char*)args.ws;

    if (IN(0)) phase_prologue(args, lds, vcu, G);
    SEAM(0);
    if (IN(1)) {
        { pg8::DenseSched S; S.init(T, NIN, G, (int)blockIdx.x);
          pg8::EpiInProj E{(bf16_t*)(args.ws + WS_Q), (const int*)args.in[I_POS]};
          pg8::gemm_phase<false>(lds, ws + WS_HN1, ws + WS_WIN, D * 2, S, E); }
        { pg8::DenseSched S; S.init(T, D, G, (int)blockIdx.x);
          pg8::EpiPlainBf16 E{(bf16_t*)(args.ws + WS_PP), D};
          pg8::gemm_phase<false>(lds, ws + WS_PB, ws + WS_WPT, PLE * 2, S, E); }
    }
    SEAM(1);
    if (IN(2)) { phase_kv(args, lds, G); phase_pool(args, lds, G); }
    SEAM(2);
    if (IN(3)) phase_scan(args, G);
    SEAM(3);
    if (IN(4)) phase_ret(args, lds, G);
    SEAM(4);
    if (IN(5)) {
        pg8::DenseSched S; S.init(T, D, G, (int)blockIdx.x);
        pg8::EpiWout E{(const float*)args.in[I_X], (bf16_t*)(args.ws + WS_HN1), args.ws + WS_H1F8, (float*)(args.ws + WS_SSQ1)};
        pg8::gemm_phase<false>(lds, ws + WS_MIX, ws + WS_WOUT, D * 2, S, E);
    }
    SEAM(5);
    if (IN(6)) phase_router(args, lds, G);
    SEAM(6);
    if (IN(7)) phase_place(args, lds, G);
    SEAM(7);
    if (IN(8)) {
        const int MT = build_tiles(args, te);
        pg8::GroupSchedG S; S.nM = MT; S.nN = 2 * DE / 256; S.G = G; S.c = (int)blockIdx.x; S.NB = 2 * DE; S.te = te; S.vtab = args.ws + WS_VTAB;
        pg8::EpiGateUp E{args.ws + WS_ACT, (const float*)args.in[I_BGU], (const float*)(args.ws + WS_SR)};
        pg8::gemm_phase<MOE_F8 != 0>(lds, MOE_F8 ? ws + WS_H1F8 : ws + WS_HN1, ws + WS_WGU, MOE_F8 ? D : 2 * D, S, E);
    }
    SEAM(8);
    if (IN(9)) {
        const int MT = build_tiles(args, te);
        pg8::GroupSchedD S; S.nM = MT; S.nN = D / 256; S.G = G; S.c = (int)blockIdx.x; S.NB = D; S.te = te; S.vtab = nullptr;
        pg8::EpiDown E{(bf16_t*)(args.ws + WS_Y), (const float*)args.in[I_BD], (const float*)(args.ws + WS_SG)};
        pg8::gemm_phase<MOE_F8 != 0>(lds, ws + WS_ACT, ws + WS_WD, MOE_F8 ? DE : 2 * DE, S, E);
    }
    SEAM(9);
    if (IN(10)) phase_combine(args, vcu, G);
    SEAM(10);
    if (IN(11)) {
        pg8::DenseSched S; S.init(T, D, G, (int)blockIdx.x);
        pg8::EpiPle E{args.out, (const bf16_t*)(args.ws + WS_HN1), (const bf16_t*)(args.ws + WS_PP), (const float*)(args.ws + WS_RSTD2)};
        pg8::gemm_phase<false>(lds, ws + WS_HN1, ws + WS_WG, D * 2, S, E);
    }
    SEAM(11);
    if (IN(12)) phase_final(args, vcu, G);
#undef IN
#undef SEAM
}


extern "C" void kernel_launch(void* const* d_in, const int* in_sizes, int n_in, void* d_out, int out_size, void* d_ws, size_t ws_size, hipStream_t stream) {
    static int grid = 0;
    if (grid == 0) {
        if (n_in != 20 || in_sizes[0] != T * D || out_size != T * D || ws_size < WS_END) { fprintf(stderr, "kernel_launch: unexpected shapes (n_in %d, in0 %d, out %d, ws %zu < %zu)\n", n_in, n_in > 0 ? in_sizes[0] : -1, out_size, ws_size, (size_t)WS_END); grid = -1; return; }
        int dev = 0, cus = 0, per_cu = 0;
        if (hipGetDevice(&dev) != hipSuccess || hipDeviceGetAttribute(&cus, hipDeviceAttributeMultiprocessorCount, dev) != hipSuccess) { grid = -1; return; }
        if (hipFuncSetAttribute((const void*)fwd_kernel, hipFuncAttributeMaxDynamicSharedMemorySize, LDS_BYTES) != hipSuccess) { fprintf(stderr, "kernel_launch: hipFuncSetAttribute failed\n"); grid = -1; return; }
        if (hipOccupancyMaxActiveBlocksPerMultiprocessor(&per_cu, (const void*)fwd_kernel, 512, LDS_BYTES) != hipSuccess || per_cu < 1) { fprintf(stderr, "kernel_launch: occupancy query says %d\n", per_cu); (void)hipGetLastError(); }
        grid = cus;
    }
    if (grid < 0) return;
    if (hipMemsetAsync((char*)d_ws + WS_CTL, 0, CTL_ZERO_BYTES, stream) != hipSuccess) return;
    Args a{};
    for (int i = 0; i < 20; ++i) a.in[i] = d_in[i];
    a.out = (float*)d_out; a.ws = (unsigned char*)d_ws;
#if MK_PER_PHASE
    for (int p = 0; p < NPH; ++p) { a.ph_lo = p; a.ph_hi = p + 1; for (int r = 0; r < 1 + ((MK_REPEAT >> p) & 1); ++r) hipLaunchKernelGGL(fwd_kernel, dim3(grid), dim3(512), LDS_BYTES, stream, a); }
#else
    a.ph_lo = 0; a.ph_hi = NPH; hipLaunchKernelGGL(fwd_kernel, dim3(grid), dim3(512), LDS_BYTES, stream, a);
#endif
}
```

```cpp
#include <hip/hip_runtime.h>
#include <cstdio>
#include <cstdint>

#ifndef MK_PER_PHASE
#define MK_PER_PHASE 0
#endif
#ifndef MOE_F8
#define MOE_F8 1
#endif
#ifndef MK_REPEAT
#define MK_REPEAT 0x0
#endif
#ifndef MK_DEBUG
#define MK_DEBUG 0
#endif

#define GAS __attribute__((address_space(1)))
#define LAS __attribute__((address_space(3)))
typedef unsigned short bf16_t;
typedef short bf16x8 __attribute__((ext_vector_type(8)));
typedef float f32x4 __attribute__((ext_vector_type(4)));
typedef float f32x2 __attribute__((ext_vector_type(2)));
typedef unsigned u32x4 __attribute__((ext_vector_type(4)));
typedef unsigned u32x2 __attribute__((ext_vector_type(2)));
typedef int v8i __attribute__((ext_vector_type(8)));
typedef int v4i __attribute__((ext_vector_type(4)));

constexpr int T = 32768, D = 1024, SEQ = 4096, NBATCH = 8, NH = 8, HD = 64, CH = 128, NCH = 32;
constexpr int DRET = 512, DPOOL = 512, NIN = 2560, NE = 32, TOPK = 4, DE = 1024, PLE = 256;
constexpr float NORM_EPS = 1e-5f, GN_EPS = 1e-5f;
constexpr int MAXROWS = T * TOPK + NE * 256;
constexpr int MAXT = MAXROWS / 256;

constexpr size_t MiB = 1u << 20, KiB = 1u << 10;
constexpr size_t WS_CTL = 0, CTL_ZERO_BYTES = 64 * KiB;
constexpr size_t WS_ROUT = 1 * MiB, WS_PWT = 1 * MiB + 64 * KiB, WS_WPT = 1 * MiB + 256 * KiB;
constexpr size_t WS_TOPI = 2 * MiB, WS_TOPG = 2 * MiB + 512 * KiB, WS_SPOS = 3 * MiB, WS_RSTD1 = 3 * MiB + 512 * KiB, WS_RSTD2 = 3 * MiB + 640 * KiB, WS_BH = 3 * MiB + 768 * KiB;
constexpr size_t WS_SG = 4 * MiB, WS_SR = 5 * MiB, WS_SSQ1 = 6 * MiB, WS_VTAB = 8 * MiB;
constexpr size_t WS_WIN = 16 * MiB, WS_WOUT = 21 * MiB, WS_WG = 23 * MiB;
constexpr size_t WS_WGU = 32 * MiB, WS_WD = 160 * MiB, WS_PP = 224 * MiB;
constexpr size_t WS_HN1 = 288 * MiB  , WS_PB = 352 * MiB;
constexpr size_t WS_Q = 368 * MiB, WS_K = 400 * MiB, WS_V = 432 * MiB, WS_G = 464 * MiB, WS_U = 496 * MiB;
constexpr size_t WS_KV = 528 * MiB, WS_ST = 560 * MiB, WS_MIX = 576 * MiB;
constexpr size_t WS_H1F8 = 496 * MiB;
constexpr size_t WS_ACT = 352 * MiB, WS_Y = 624 * MiB, WS_END = 896 * MiB;
static_assert(WS_K - WS_Q == (size_t)T * 512 * 2 && WS_V - WS_K == WS_K - WS_Q && WS_G - WS_V == WS_K - WS_Q && WS_U - WS_G == WS_K - WS_Q, "q|k|v|g|u equally spaced");
static_assert(WS_VTAB + (size_t)MAXT * 512 * 16 <= WS_WIN && WS_ACT + (size_t)MAXROWS * DE * 2 <= WS_Y && WS_Y + (size_t)MAXROWS * D * 2 <= WS_END, "ws map");
constexpr int CW_TMO = 0, CW_CODE = 1, CW_FAIL = 2, CW_TOT = 64, CW_BAR = 4096;

constexpr int VOFF_OFF = 131072;
constexpr int LCTL_OFF = 147456;
constexpr int LDS_BYTES = 151552;

#define LDS_WAIT() asm volatile("s_waitcnt lgkmcnt(0)" ::: "memory")
#define VM_WAIT() asm volatile("s_waitcnt vmcnt(0)" ::: "memory")
__device__ __forceinline__ unsigned cvt_pk_bf16(float lo, float hi) { unsigned r; asm volatile("v_cvt_pk_bf16_f32 %0, %1, %2" : "=v"(r) : "v"(lo), "v"(hi)); return r; }
__device__ __forceinline__ unsigned cvt4_fp8(float a, float b, float c, float d) { int w = __builtin_amdgcn_cvt_pk_fp8_f32(a, b, 0, false); w = __builtin_amdgcn_cvt_pk_fp8_f32(c, d, w, true); return (unsigned)w; }
__device__ __forceinline__ bf16x8 v8lo(const v8i x) { const v4i t = x.lo; return __builtin_bit_cast(bf16x8, t); }
__device__ __forceinline__ bf16x8 v8hi(const v8i x) { const v4i t = x.hi; return __builtin_bit_cast(bf16x8, t); }
__device__ __forceinline__ float bf_lo(unsigned w) { return __uint_as_float(w << 16); }
__device__ __forceinline__ float bf_hi(unsigned w) { return __uint_as_float(w & 0xffff0000u); }
__device__ __forceinline__ float wave_sum(float v) {
#pragma unroll
    for (int o = 1; o < 64; o <<= 1) v += __shfl_xor(v, o);
    return v;
}
__device__ __forceinline__ float sigmoidf_fast(float x) { return __builtin_amdgcn_rcpf(1.0f + __builtin_amdgcn_exp2f(-1.4426950408889634f * x)); }
__device__ __forceinline__ int lds_inc(LAS int* p) { return __hip_atomic_fetch_add(p, 1, __ATOMIC_RELAXED, __HIP_MEMORY_SCOPE_WORKGROUP); }
__device__ __forceinline__ float log2_gamma(int h) {
    const float x = __builtin_amdgcn_exp2f(-(float)(5 + h));
    const float ln = -x * (1.0f + x * (0.5f + x * (0.33333333f + x * (0.25f + x * 0.2f))));
    return ln * 1.4426950408889634f;
}

#define XB_TMO      128
#define XB_XCNT(j)  (256  + 64 * (j))
#define XB_XSUB(j)  (1280 + 64 * (j))
#define XB_XGEN(j)  (2304 + 64 * (j))
#define XB_TOP      3328
#define XB_TOPGEN   3392
#define XCD_BAR_WORDS 3456
#define XB_SPIN_CAP (1u << 18)
__device__ __forceinline__ unsigned xb_ld(unsigned* p)              { return __hip_atomic_load(p, __ATOMIC_RELAXED, __HIP_MEMORY_SCOPE_AGENT); }
__device__ __forceinline__ unsigned xb_add(unsigned* p, unsigned v) { return __hip_atomic_fetch_add(p, v, __ATOMIC_RELAXED, __HIP_MEMORY_SCOPE_AGENT); }
__device__ __forceinline__ unsigned xb_xcc_id() { return (unsigned)__builtin_amdgcn_s_getreg((3 << 11) | 20) & 0xFu; }
#define XB_SPIN(cond, bar) do { unsigned _sp = 0; while (cond) { __builtin_amdgcn_s_sleep(1); \
    if ((++_sp & 255u) == 0u) { if (xb_ld(&(bar)[XB_TMO])) break; if (_sp > XB_SPIN_CAP) { atomicAdd(&(bar)[XB_TMO], 1u); break; } } } } while (0)
struct XcdBarrier { unsigned* bar; unsigned x; volatile LAS unsigned* st; };
__device__ __forceinline__ XcdBarrier xcd_barrier_post(unsigned* bar, volatile LAS unsigned* st) {
    XcdBarrier b; b.bar = bar; b.x = xb_xcc_id(); b.st = st;
    if (threadIdx.x == 0) (void)xb_add(&bar[XB_XCNT(b.x)], 1u);
    return b;
}
__device__ __forceinline__ void xcd_barrier_complete(unsigned* bar, unsigned x, unsigned& nloc, unsigned& nx) {
    const unsigned G = gridDim.x * gridDim.y * gridDim.z;
    unsigned sum, cnt, mine, sp = 0u;
    for (;;) {
        sum = 0u; cnt = 0u; mine = 0u;
#pragma unroll
        for (unsigned j = 0; j < 16; ++j) { const unsigned c = xb_ld(&bar[XB_XCNT(j)]); sum += c; cnt += (c > 0u) ? 1u : 0u; mine = (j == x) ? c : mine; }
        if (sum == G) break;
        __builtin_amdgcn_s_sleep(1);
        if ((++sp & 255u) == 0u) { if (xb_ld(&bar[XB_TMO])) break; if (sp > XB_SPIN_CAP) { atomicAdd(&bar[XB_TMO], 1u); break; } }
    }
    nloc = mine > 0u ? mine : 1u; nx = cnt > 0u ? cnt : 1u;
}
__device__ __forceinline__ void xcd_barrier(const XcdBarrier& b) {
    asm volatile("s_waitcnt vmcnt(0)" ::: "memory");
    __syncthreads();
    if (threadIdx.x == 0) {
        unsigned* bar = b.bar;
        __builtin_amdgcn_s_waitcnt(0);
        unsigned nloc = b.st[0], nx = b.st[1];
        if (nloc == 0u) { xcd_barrier_complete(bar, b.x, nloc, nx); b.st[0] = nloc; b.st[1] = nx; }
        const unsigned old = xb_add(&bar[XB_XSUB(b.x)], 1u);
        const unsigned gen = old / nloc;
        if (old + 1u == (gen + 1u) * nloc) {
            __builtin_amdgcn_fence(__ATOMIC_RELEASE, "agent");
            asm volatile("s_waitcnt vmcnt(0)" ::: "memory");
            const unsigned og = xb_add(&bar[XB_TOP], 1u);
            const unsigned tg = og / nx;
            if (og + 1u == (tg + 1u) * nx) xb_add(&bar[XB_TOPGEN], 1u);
            else XB_SPIN(xb_ld(&bar[XB_TOPGEN]) == tg, bar);
            __builtin_amdgcn_fence(__ATOMIC_ACQUIRE, "agent");
            xb_add(&bar[XB_XGEN(b.x)], 1u);
            asm volatile("s_waitcnt vmcnt(0)" ::: "memory");
        } else {
            XB_SPIN(xb_ld(&bar[XB_XGEN(b.x)]) == gen, bar);
            __builtin_amdgcn_fence(__ATOMIC_ACQUIRE, "agent");
            asm volatile("s_waitcnt vmcnt(0)" ::: "memory");
        }
    }
    __syncthreads();
}

namespace pg8 {
constexpr int BM = 256, BK = 64, HALF = 128, HTB = HALF * BK * 2, STAGE_BYTES = 8 * HTB, NXCD = 8, WGM = 8;
__host__ __device__ __forceinline__ int lds_byte(int r, int c) { const int st = (r >> 4) * 2 + (c >> 5), rr = r & 15, cc = c & 31, ob = rr * 64 + cc * 2; return st * 1024 + (ob ^ (((ob >> 9) & 1) << 5)); }
__host__ __device__ __forceinline__ void stage_rc(int b, int& R, int& C) { const int st = b / 1024, sb = b % 1024, swz = sb ^ (((sb >> 9) & 1) << 5); R = (st >> 1) * 16 + swz / 64; C = (st & 1) * 32 + (swz % 64) / 2; }
__host__ __device__ __forceinline__ int perm32(int rho) { const int n = rho >> 4, i = rho & 15; return 8 * (i >> 2) + 4 * n + (i & 3); }
struct Unit { int pm, pn, e; };
__device__ __forceinline__ bool order_next(int i, int G, int c, int nM, int nN, int& pm, int& pn) {
    const int nwg = nM * nN; const long L = (long)i * G + c; if (L >= nwg) return false;
    int wgid = (int)L; { const int q = nwg / NXCD, r = nwg % NXCD, xcd = wgid % NXCD, off = wgid / NXCD; wgid = (xcd < r ? xcd * (q + 1) : r * (q + 1) + (xcd - r) * q) + off; }
    const int nig = WGM * nN, gid = wgid / nig, fm = gid * WGM, gsz = (nM - fm) < WGM ? (nM - fm) : WGM;
    pm = fm + ((wgid % nig) % gsz); pn = (wgid % nig) / gsz; return true;
}
struct DenseSched {
    static constexpr bool GATHER = false;
    int nM, nN, G, c; const unsigned char* vtab;
    __device__ __forceinline__ void init(int M, int N, int G_, int c_) { nM = M / BM; nN = N / BM; G = G_; c = c_; vtab = nullptr; }
    __device__ __forceinline__ bool next(int i, Unit& u) const { u.e = 0; return order_next(i, G, c, nM, nN, u.pm, u.pn); }
    __device__ __forceinline__ size_t b_off(const Unit& u, int RB) const { return (size_t)u.pn * BM * RB; }
};
struct GroupSched {
    static constexpr bool GATHER_ = false;
    int nM, nN, G, c, NB; const LAS unsigned short* te; const unsigned char* vtab;
    __device__ __forceinline__ bool next(int i, Unit& u) const { if (!order_next(i, G, c, nM, nN, u.pm, u.pn)) return false; u.e = __builtin_amdgcn_readfirstlane((int)te[u.pm]); return true; }
    __device__ __forceinline__ size_t b_off(const Unit& u, int RB) const { return ((size_t)u.e * NB + (size_t)u.pn * BM) * RB; }
};
struct GroupSchedG : GroupSched { static constexpr bool GATHER = true; };
struct GroupSchedD : GroupSched { static constexpr bool GATHER = false; };

template <bool F8, class Epi, class Sched>
__device__ __forceinline__ void gemm_phase(LAS unsigned char* lds, const char* A, const char* Bt, const int RB, const Sched& S, const Epi& E) {
    const int tid = threadIdx.x, wid = __builtin_amdgcn_readfirstlane(tid >> 6), lane = tid & 63, wr = wid >> 2, wc = wid & 3, fr = lane & 15, fq = lane >> 4;
    const int nt = RB / 128;
    unsigned voffB[2], cA[2]; int RA[2];
#pragma unroll
    for (int i = 0; i < 2; ++i) { int R, C; stage_rc(tid * 16 + i * 8192, R, C); const int Rb = Epi::PERM ? ((R & ~31) + perm32(R & 31)) : R;
        RA[i] = R; cA[i] = (unsigned)C * 2u; voffB[i] = (unsigned)(Rb * RB) + (unsigned)C * 2u; }
    const size_t kstep = (size_t)(BK * 2);
    const size_t hstep = (size_t)HALF * RB;
    const unsigned ldsw = (unsigned)wid * 1024u;
    const int aoff = lds_byte(wr * 64 + fr, fq * 8), boff = lds_byte(wc * 32 + fr, fq * 8);
#define PG8_SA(b, h) (((b) * 2 + (h)) * HTB)
#define PG8_SB(b, h) ((4 + (b) * 2 + (h)) * HTB)
#define PG8_STAGE(bufoff, gbase, voff) do { _Pragma("unroll") for (int _i = 0; _i < 2; ++_i) \
        __builtin_amdgcn_global_load_lds((const unsigned*)((const char*)(gbase) + (voff)[_i]), (LAS unsigned*)(lds + (bufoff) + ldsw + _i * 8192), 16, 0, 0); } while (0)
#define PG8_LDA(dst, b, h) do { _Pragma("unroll") for (int m = 0; m < 4; ++m) { dst[m].lo = *(const LAS v4i*)(lds + (b) + PG8_SA(0, h) + aoff + m * 2048); dst[m].hi = *(const LAS v4i*)(lds + (b) + PG8_SA(0, h) + aoff + m * 2048 + 1024); } } while (0)
#define PG8_LDB(dst, b, h) do { _Pragma("unroll") for (int n = 0; n < 2; ++n) { dst[n].lo = *(const LAS v4i*)(lds + (b) + PG8_SB(0, h) + boff + n * 2048); dst[n].hi = *(const LAS v4i*)(lds + (b) + PG8_SB(0, h) + boff + n * 2048 + 1024); } } while (0)
#define PG8_MMA(ai, bj, At, Bt_) do { __builtin_amdgcn_s_setprio(1); _Pragma("unroll") for (int m = 0; m < 4; ++m) _Pragma("unroll") for (int n = 0; n < 2; ++n) { \
        if constexpr (F8) acc[ai][bj][m][n] = __builtin_amdgcn_mfma_scale_f32_16x16x128_f8f6f4(Bt_[n], At[m], acc[ai][bj][m][n], 0, 0, 0, 0, 0, 0); \
        else { acc[ai][bj][m][n] = __builtin_amdgcn_mfma_f32_16x16x32_bf16(v8lo(Bt_[n]), v8lo(At[m]), acc[ai][bj][m][n], 0, 0, 0); \
               acc[ai][bj][m][n] = __builtin_amdgcn_mfma_f32_16x16x32_bf16(v8hi(Bt_[n]), v8hi(At[m]), acc[ai][bj][m][n], 0, 0, 0); } } \
        __builtin_amdgcn_s_setprio(0); } while (0)
#define PG8_WAIT_V(n) asm volatile("s_waitcnt vmcnt(" #n ")" ::: "memory")
#define PG8_WAIT_L(n) asm volatile("s_waitcnt lgkmcnt(" #n ")" ::: "memory")
#define PG8_BAR __builtin_amdgcn_s_barrier()
#define PG8_SCHED __builtin_amdgcn_sched_barrier(0)
#define PG8_DENSE_V(v, u) do { _Pragma("unroll") for (int _h = 0; _h < 2; ++_h) _Pragma("unroll") for (int _i = 0; _i < 2; ++_i) (v)[_h][_i] = (unsigned)((u).pm * BM + _h * HALF + RA[_i]) * (unsigned)RB + cA[_i]; } while (0)
    Unit cur, nxt; int ui = 0;
    if (!S.next(0, cur)) return;
    f32x4 acc[2][2][4][2];
#pragma unroll
    for (int a = 0; a < 2; ++a)
#pragma unroll
        for (int b = 0; b < 2; ++b)
#pragma unroll
            for (int m = 0; m < 4; ++m)
#pragma unroll
                for (int n = 0; n < 2; ++n) acc[a][b][m][n] = (f32x4){0.f, 0.f, 0.f, 0.f};
    v8i At[4], B0[2], B1[2];
    unsigned vc[2][2], v2[2][2];
    if constexpr (Sched::GATHER) {
        __builtin_amdgcn_global_load_lds((const unsigned*)(S.vtab + ((size_t)cur.pm * 512 + tid) * 16), (LAS unsigned*)(lds + VOFF_OFF + ldsw), 16, 0, 0);
        PG8_WAIT_V(0);
        const u32x4 tv = *(const LAS u32x4*)(lds + VOFF_OFF + tid * 16); vc[0][0] = tv.x; vc[0][1] = tv.y; vc[1][0] = tv.z; vc[1][1] = tv.w;
    } else { PG8_DENSE_V(vc, cur); }
    const char* cB = Bt + S.b_off(cur, RB);
    PG8_STAGE(PG8_SB(0, 0), cB, voffB); PG8_STAGE(PG8_SB(0, 1), cB + hstep, voffB); PG8_STAGE(PG8_SA(0, 0), A, vc[0]); PG8_STAGE(PG8_SA(0, 1), A, vc[1]);
    if (wr == 1) PG8_BAR;
    PG8_WAIT_V(2); PG8_BAR;
    PG8_STAGE(PG8_SB(1, 0), cB + kstep, voffB); PG8_STAGE(PG8_SA(1, 0), A + kstep, vc[0]); PG8_STAGE(PG8_SB(1, 1), cB + hstep + kstep, voffB);
    PG8_WAIT_V(6); PG8_BAR;
    for (;;) {
        const bool has_next = S.next(ui + 1, nxt);
        const char* nB = has_next ? Bt + S.b_off(nxt, RB) : cB;
        unsigned dlt = 0u;
        if (has_next) {
            if constexpr (Sched::GATHER) __builtin_amdgcn_global_load_lds((const unsigned*)(S.vtab + ((size_t)nxt.pm * 512 + tid) * 16), (LAS unsigned*)(lds + VOFF_OFF + ((ui + 1) & 1) * 8192 + ldsw), 16, 0, 0);
            else dlt = (unsigned)(nxt.pm - cur.pm) * (unsigned)(BM * RB);
        }
#pragma unroll
        for (int h = 0; h < 2; ++h) { v2[h][0] = vc[h][0]; v2[h][1] = vc[h][1]; }
#pragma nounroll
        for (int t = 0; t < nt; ++t) {
            const int bb = t & 1; const bool w1 = (t + 1 >= nt), w2 = (t + 2 >= nt);
            if (t == nt - 2 && has_next) {
                if constexpr (Sched::GATHER) { const u32x4 tv = *(const LAS u32x4*)(lds + VOFF_OFF + ((ui + 1) & 1) * 8192 + tid * 16); v2[0][0] = tv.x; v2[0][1] = tv.y; v2[1][0] = tv.z; v2[1][1] = tv.w; }
                else {
#pragma unroll
                    for (int h = 0; h < 2; ++h) { v2[h][0] += dlt; v2[h][1] += dlt; } }
            }
            const char* a1 = w1 ? A : A + (size_t)(t + 1) * kstep;
            const char* a2 = w2 ? A + (size_t)(t + 2 - nt) * kstep : A + (size_t)(t + 2) * kstep;
            const char* b2 = w2 ? nB + (size_t)(t + 2 - nt) * kstep : cB + (size_t)(t + 2) * kstep;
            unsigned va1[2], va2[2];
#pragma unroll
            for (int i = 0; i < 2; ++i) { va1[i] = w1 ? v2[1][i] : vc[1][i]; va2[i] = w2 ? v2[0][i] : vc[0][i]; }
            const int ob = bb * (2 * HTB), on = (bb ^ 1) * (2 * HTB);
            PG8_LDB(B0, ob, 0); PG8_LDB(B1, ob, 1); PG8_SCHED; PG8_LDA(At, ob, 0); PG8_STAGE(on + PG8_SA(0, 1), a1, va1);
            PG8_WAIT_V(8); PG8_WAIT_L(0); PG8_BAR; PG8_MMA(0, 0, At, B0); PG8_MMA(0, 1, At, B1); PG8_BAR; PG8_SCHED;
            PG8_LDA(At, ob, 1); PG8_STAGE(ob + PG8_SB(0, 0), b2, voffB); PG8_STAGE(ob + PG8_SB(0, 1), b2 + hstep, voffB); PG8_STAGE(ob + PG8_SA(0, 0), a2, va2);
            PG8_WAIT_V(8); PG8_WAIT_L(0); PG8_BAR; PG8_MMA(1, 0, At, B0); PG8_MMA(1, 1, At, B1); PG8_BAR; PG8_SCHED;
        }
        if (wr == 0) PG8_BAR;
        E(acc, cur, wr, wc, fr, fq);
        if (!has_next) break;
#pragma unroll
        for (int a = 0; a < 2; ++a)
#pragma unroll
            for (int b = 0; b < 2; ++b)
#pragma unroll
                for (int m = 0; m < 4; ++m)
#pragma unroll
                    for (int n = 0; n < 2; ++n) acc[a][b][m][n] = (f32x4){0.f, 0.f, 0.f, 0.f};
        cur = nxt; cB = nB; ++ui;
#pragma unroll
        for (int h = 0; h < 2; ++h) { vc[h][0] = v2[h][0]; vc[h][1] = v2[h][1]; }
        if (wr == 1) PG8_BAR;
    }
    PG8_WAIT_V(0);
    PG8_BAR;
#undef PG8_SA
#undef PG8_SB
#undef PG8_STAGE
#undef PG8_LDA
#undef PG8_LDB
#undef PG8_MMA
#undef PG8_WAIT_V
#undef PG8_WAIT_L
#undef PG8_BAR
#undef PG8_SCHED
#undef PG8_DENSE_V
}

typedef f32x4 Acc[2][2][4][2];
struct EpiInProj {
    static constexpr bool PERM = true;
    bf16_t* Q; const int* pos;
    __device__ __forceinline__ void operator()(const Acc& acc, const Unit& u, int wr, int wc, int fr, int fq) const {
        const int sec = u.pn >> 1, hf = u.pn & 1, row0 = u.pm * BM + wr * 64 + fr;
        if (sec >= 2) {
            bf16_t* base = Q + (size_t)sec * (size_t)(T * 512);
            const int col0 = hf * 256 + wc * 32 + 8 * fq;
#pragma unroll
            for (int ai = 0; ai < 2; ++ai)
#pragma unroll
                for (int m = 0; m < 4; ++m) { bf16_t* rowp = base + (size_t)(row0 + ai * HALF + m * 16) * 512 + col0;
#pragma unroll
                    for (int bj = 0; bj < 2; ++bj) { const f32x4 v0 = acc[ai][bj][m][0], v1 = acc[ai][bj][m][1];
                        u32x4 w; w.x = cvt_pk_bf16(v0[0], v0[1]); w.y = cvt_pk_bf16(v0[2], v0[3]); w.z = cvt_pk_bf16(v1[0], v1[1]); w.w = cvt_pk_bf16(v1[2], v1[3]);
                        *(u32x4*)(rowp + bj * HALF) = w; } }
        } else {
            bf16_t* base = Q + (size_t)sec * (size_t)(T * 512);
            const int head = hf * 4 + wc;
            const float lg = log2_gamma(head);
#pragma unroll
            for (int ai = 0; ai < 2; ++ai)
#pragma unroll
                for (int m = 0; m < 4; ++m) {
                    const int row = row0 + ai * HALF + m * 16; const float p = (float)pos[row]; const float c = (float)(row & (CH - 1));
                    const float sc = sec == 0 ? __builtin_amdgcn_exp2f(c * lg) : __builtin_amdgcn_exp2f(-c * lg) * 0.125f;
                    bf16_t* rowp = base + (size_t)row * 512 + head * 64 + 8 * fq;
#pragma unroll
                    for (int n = 0; n < 2; ++n) { float o1[4], o2[4];
#pragma unroll
                        for (int j = 0; j < 4; ++j) { const float ifr = __builtin_amdgcn_exp2f(-(float)(8 * fq + 4 * n + j) * (13.287712379549449f / 32.0f)) * 0.15915494309189535f;
                            const float rev = __builtin_amdgcn_fractf(p * ifr); const float sn = __builtin_amdgcn_sinf(rev), cs = __builtin_amdgcn_cosf(rev);
                            const float x1 = acc[ai][0][m][n][j], x2 = acc[ai][1][m][n][j];
                            o1[j] = (x1 * cs - x2 * sn) * sc; o2[j] = (x2 * cs + x1 * sn) * sc; }
                        u32x2 w; w.x = cvt_pk_bf16(o1[0], o1[1]); w.y = cvt_pk_bf16(o1[2], o1[3]); *(u32x2*)(rowp + 4 * n) = w;
                        w.x = cvt_pk_bf16(o2[0], o2[1]); w.y = cvt_pk_bf16(o2[2], o2[3]); *(u32x2*)(rowp + 32 + 4 * n) = w; }
                }
        }
    }
};
struct EpiPlainBf16 {
    static constexpr bool PERM = true;
    bf16_t* O; int ldc;
    __device__ __forceinline__ void operator()(const Acc& acc, const Unit& u, int wr, int wc, int fr, int fq) const {
        const int row0 = u.pm * BM + wr * 64 + fr, col0 = u.pn * BM + wc * 32 + 8 * fq;
#pragma unroll
        for (int ai = 0; ai < 2; ++ai)
#pragma unroll
            for (int m = 0; m < 4; ++m) { bf16_t* rowp = O + (size_t)(row0 + ai * HALF + m * 16) * ldc + col0;
#pragma unroll
                for (int bj = 0; bj < 2; ++bj) { const f32x4 v0 = acc[ai][bj][m][0], v1 = acc[ai][bj][m][1];
                    u32x4 w; w.x = cvt_pk_bf16(v0[0], v0[1]); w.y = cvt_pk_bf16(v0[2], v0[3]); w.z = cvt_pk_bf16(v1[0], v1[1]); w.w = cvt_pk_bf16(v1[2], v1[3]);
                    *(u32x4*)(rowp + bj * HALF) = w; } }
    }
};
struct EpiWout {
    static constexpr bool PERM = true;
    const float* x; bf16_t* h1b; unsigned char* h1f8; float* ssq;
    __device__ __forceinline__ void operator()(const Acc& acc, const Unit& u, int wr, int wc, int fr, int fq) const {
        const int row0 = u.pm * BM + wr * 64 + fr, col0 = u.pn * BM + wc * 32 + 8 * fq;
#pragma unroll
        for (int ai = 0; ai < 2; ++ai)
#pragma unroll
            for (int m = 0; m < 4; ++m) { const int row = row0 + ai * HALF + m * 16; const size_t off = (size_t)row * D + col0; float s = 0.f;
#pragma unroll
                for (int bj = 0; bj < 2; ++bj) { const f32x4 x0 = *(const f32x4*)(x + off + bj * HALF), x1 = *(const f32x4*)(x + off + bj * HALF + 4);
                    const f32x4 h0 = acc[ai][bj][m][0] + x0, h1 = acc[ai][bj][m][1] + x1;
                    s += (h0[0] * h0[0] + h0[1] * h0[1]) + (h0[2] * h0[2] + h0[3] * h0[3]) + (h1[0] * h1[0] + h1[1] * h1[1]) + (h1[2] * h1[2] + h1[3] * h1[3]);
                    u32x4 w; w.x = cvt_pk_bf16(h0[0], h0[1]); w.y = cvt_pk_bf16(h0[2], h0[3]); w.z = cvt_pk_bf16(h1[0], h1[1]); w.w = cvt_pk_bf16(h1[2], h1[3]);
                    *(u32x4*)(h1b + off + bj * HALF) = w;
                    u32x2 q; q.x = cvt4_fp8(h0[0], h0[1], h0[2], h0[3]); q.y = cvt4_fp8(h1[0], h1[1], h1[2], h1[3]);
                    *(u32x2*)(h1f8 + off + bj * HALF) = q; }
                s += __shfl_xor(s, 16); s += __shfl_xor(s, 32);
                if (fq == 0) ssq[(size_t)row * 16 + u.pn * 4 + wc] = s;
                if (m & 1) asm volatile("" ::: "memory"); }
    }
};
struct EpiGateUp {
    static constexpr bool PERM = true;
    unsigned char* act; const float* bgu; const float* sr;
    __device__ __forceinline__ void operator()(const Acc& acc, const Unit& u, int wr, int wc, int fr, int fq) const {
        const int prow0 = u.pm * BM + wr * 64 + fr, acol = u.pn * 128 + wc * 32 + 8 * fq;
        const float* bp = bgu + (size_t)u.e * (2 * DE) + 2 * acol;
        f32x4 b4[4];
#pragma unroll
        for (int q = 0; q < 4; ++q) b4[q] = *(const f32x4*)(bp + 4 * q);
#pragma unroll
        for (int ai = 0; ai < 2; ++ai)
#pragma unroll
            for (int m = 0; m < 4; ++m) { const int prow = prow0 + ai * HALF + m * 16; const float r = sr[prow] * (MOE_F8 ? 0.03125f : 1.0f); float o[8];
#pragma unroll
                for (int q = 0; q < 8; ++q) { float g = r * acc[ai][0][m][q >> 2][q & 3] + b4[q >> 1][(q & 1) * 2], up = r * acc[ai][1][m][q >> 2][q & 3] + b4[q >> 1][(q & 1) * 2 + 1];
                    g = fminf(g, 7.0f); up = fminf(fmaxf(up, -7.0f), 7.0f); o[q] = (up + 1.0f) * g * sigmoidf_fast(1.702f * g); }
                if (MOE_F8) { u32x2 w; w.x = cvt4_fp8(o[0], o[1], o[2], o[3]); w.y = cvt4_fp8(o[4], o[5], o[6], o[7]); *(u32x2*)(act + (size_t)prow * DE + acol) = w; }
                else { u32x4 w; w.x = cvt_pk_bf16(o[0], o[1]); w.y = cvt_pk_bf16(o[2], o[3]); w.z = cvt_pk_bf16(o[4], o[5]); w.w = cvt_pk_bf16(o[6], o[7]); *(u32x4*)(act + ((size_t)prow * DE + acol) * 2) = w; } }
    }
};
struct EpiDown {
    static constexpr bool PERM = true;
    bf16_t* y; const float* bd; const float* sg;
    __device__ __forceinline__ void operator()(const Acc& acc, const Unit& u, int wr, int wc, int fr, int fq) const {
        const int prow0 = u.pm * BM + wr * 64 + fr, col0 = u.pn * BM + wc * 32 + 8 * fq;
        const float* bp = bd + (size_t)u.e * D + col0;
        f32x4 bv[2][2];
#pragma unroll
        for (int bj = 0; bj < 2; ++bj)
#pragma unroll
            for (int n = 0; n < 2; ++n) bv[bj][n] = *(const f32x4*)(bp + bj * HALF + 4 * n);
#pragma unroll
        for (int ai = 0; ai < 2; ++ai)
#pragma unroll
            for (int m = 0; m < 4; ++m) { const int prow = prow0 + ai * HALF + m * 16; const float gw = sg[prow]; bf16_t* rowp = y + (size_t)prow * D + col0;
#pragma unroll
                for (int bj = 0; bj < 2; ++bj) { const f32x4 v0 = (acc[ai][bj][m][0] * (MOE_F8 ? 0.03125f : 1.0f) + bv[bj][0]) * gw, v1 = (acc[ai][bj][m][1] * (MOE_F8 ? 0.03125f : 1.0f) + bv[bj][1]) * gw;
                    u32x4 w; w.x = cvt_pk_bf16(v0[0], v0[1]); w.y = cvt_pk_bf16(v0[2], v0[3]); w.z = cvt_pk_bf16(v1[0], v1[1]); w.w = cvt_pk_bf16(v1[2], v1[3]);
                    *(u32x4*)(rowp + bj * HALF) = w; } }
    }
};
struct EpiPle {
    static constexpr bool PERM = true;
    float* out; const bf16_t* h2b; const bf16_t* pp; const float* rstd2;
    __device__ __forceinline__ void operator()(const Acc& acc, const Unit& u, int wr, int wc, int fr, int fq) const {
        const int row0 = u.pm * BM + wr * 64 + fr, col0 = u.pn * BM + wc * 32 + 8 * fq;
#pragma unroll
        for (int ai = 0; ai < 2; ++ai)
#pragma unroll
            for (int m = 0; m < 4; ++m) { const int row = row0 + ai * HALF + m * 16; const float r = rstd2[row]; const size_t off = (size_t)row * D + col0;
#pragma unroll
                for (int bj = 0; bj < 2; ++bj) { const u32x4 pw = *(const u32x4*)(pp + off + bj * HALF); const u32x4 hw = *(const u32x4*)(h2b + off + bj * HALF);
                    const f32x4 a0 = acc[ai][bj][m][0] * r, a1 = acc[ai][bj][m][1] * r; f32x4 o0, o1;
                    o0[0] = bf_lo(hw.x) + sigmoidf_fast(a0[0]) * bf_lo(pw.x); o0[1] = bf_hi(hw.x) + sigmoidf_fast(a0[1]) * bf_hi(pw.x); o0[2] = bf_lo(hw.y) + sigmoidf_fast(a0[2]) * bf_lo(pw.y); o0[3] = bf_hi(hw.y) + sigmoidf_fast(a0[3]) * bf_hi(pw.y);
                    o1[0] = bf_lo(hw.z) + sigmoidf_fast(a1[0]) * bf_lo(pw.z); o1[1] = bf_hi(hw.z) + sigmoidf_fast(a1[1]) * bf_hi(pw.z); o1[2] = bf_lo(hw.w) + sigmoidf_fast(a1[2]) * bf_lo(pw.w); o1[3] = bf_hi(hw.w) + sigmoidf_fast(a1[3]) * bf_hi(pw.w);
                    *(f32x4*)(out + off + bj * HALF) = o0; *(f32x4*)(out + off + bj * HALF + 4) = o1; }
                if (m & 1) asm volatile("" ::: "memory"); }
    }
};
}

struct Args { const void* in[20]; float* out; unsigned char* ws; int ph_lo, ph_hi; };
enum { I_X = 0, I_P, I_POS, I_WIN, I_WOUT, I_GNW, I_POOLW, I_POOLS, I_NMIX, I_NMOE, I_RW, I_RB, I_WGU, I_BGU, I_WD, I_BD, I_NPLE, I_WG, I_WP, I_NFIN };
constexpr int NPH = 13;

enum { WK_PLAIN = 0, WK_WIN = 1, WK_GU = 2 };
template <int KIND> __device__ __forceinline__ int dst_row(int c) {
    if (KIND == WK_WIN) { if (c < 1024) { const int sec = c >> 9, within = c & 511, head = within >> 6, d = within & 63; return (sec * 2 + (head >> 2)) * 256 + (d >> 5) * 128 + (head & 3) * 32 + (d & 31); } return c; }
    if (KIND == WK_GU) { const int a = c >> 1; return (a >> 7) * 256 + (c & 1) * 128 + (a & 127); }
    return c;
}
template <int KIND, bool OUT8> __device__ __forceinline__ void tr_item(const float* W, int K, int N, void* WT, LAS float* scr, int kb, int cb, int lane, const float* ks, float mul) {
    const int k0 = 64 * kb, c0 = 64 * cb; const bool ok = (c0 + lane) < N;
    const float* src = W + (size_t)k0 * N + c0 + lane;
#pragma unroll 16
    for (int kk = 0; kk < 64; ++kk) scr[kk * 65 + lane] = ok ? src[(size_t)kk * N] : 0.f;
    const int c = lane & 7;
    f32x4 s0 = {mul, mul, mul, mul}, s1 = s0;
    if (ks) { s0 = *(const f32x4*)(ks + k0 + 8 * c) * mul; s1 = *(const f32x4*)(ks + k0 + 8 * c + 4) * mul; }
    LDS_WAIT(); asm volatile("" ::: "memory");
#pragma unroll
    for (int w = 0; w < 8; ++w) { const int r = (lane >> 3) + 8 * w; const LAS float* s = scr + (8 * c) * 65 + r;
        const float v0 = s[0 * 65] * s0[0], v1 = s[1 * 65] * s0[1], v2 = s[2 * 65] * s0[2], v3 = s[3 * 65] * s0[3], v4 = s[4 * 65] * s1[0], v5 = s[5 * 65] * s1[1], v6 = s[6 * 65] * s1[2], v7 = s[7 * 65] * s1[3];
        if (OUT8) { u32x2 o; o.x = cvt4_fp8(v0, v1, v2, v3); o.y = cvt4_fp8(v4, v5, v6, v7);
            if (c0 + r < N) *(u32x2*)((unsigned char*)WT + (size_t)dst_row<KIND>(c0 + r) * K + k0 + 8 * c) = o; }
        else { u32x4 o; o.x = cvt_pk_bf16(v0, v1); o.y = cvt_pk_bf16(v2, v3); o.z = cvt_pk_bf16(v4, v5); o.w = cvt_pk_bf16(v6, v7);
            if (c0 + r < N) *(u32x4*)((bf16_t*)WT + (size_t)dst_row<KIND>(c0 + r) * K + k0 + 8 * c) = o; } }
    LDS_WAIT(); asm volatile("" ::: "memory");
}
__device__ __forceinline__ void phase_prologue(const Args& a, LAS unsigned char* lds, int vcu, int G) {
    const int tid = threadIdx.x, lane = tid & 63, wave = __builtin_amdgcn_readfirstlane(tid >> 6);
    LAS float* scr = (LAS float*)(lds + wave * 16640);
    const int gw = vcu * 8 + wave, NGW = G * 8;
    unsigned char* ws = a.ws;
    constexpr int I_GU = NE * 16 * 32, I_DN = NE * 16 * 16, I_WINI = 16 * 40, I_SQ = 16 * 16, I_WPI = 4 * 16, I_RT = 16, I_PW = 4 * 4;
    constexpr int NITEMS = I_GU + I_DN + I_WINI + 2 * I_SQ + I_WPI + I_RT + I_PW;
    for (int it = gw; it < NITEMS; it += NGW) {
        int r = it;
        if (r < I_GU) { const int e = r / 512, q = r % 512; tr_item<WK_GU, MOE_F8 != 0>((const float*)a.in[I_WGU] + (size_t)e * D * 2 * DE, D, 2 * DE, ws + WS_WGU + (size_t)e * 2 * DE * D * (MOE_F8 ? 1 : 2), scr, q / 32, q % 32, lane, (const float*)a.in[I_NMOE], MOE_F8 ? 32.0f : 1.0f); continue; } r -= I_GU;
        if (r < I_DN) { const int e = r / 256, q = r % 256; tr_item<WK_PLAIN, MOE_F8 != 0>((const float*)a.in[I_WD] + (size_t)e * DE * D, DE, D, ws + WS_WD + (size_t)e * D * DE * (MOE_F8 ? 1 : 2), scr, q / 16, q % 16, lane, nullptr, MOE_F8 ? 32.0f : 1.0f); continue; } r -= I_DN;
        if (r < I_WINI) { tr_item<WK_WIN, false>((const float*)a.in[I_WIN], D, NIN, ws + WS_WIN, scr, r / 40, r % 40, lane, nullptr, 1.0f); continue; } r -= I_WINI;
        if (r < I_SQ) { tr_item<WK_PLAIN, false>((const float*)a.in[I_WOUT], D, D, ws + WS_WOUT, scr, r / 16, r % 16, lane, nullptr, 1.0f); continue; } r -= I_SQ;
        if (r < I_SQ) { tr_item<WK_PLAIN, false>((const float*)a.in[I_WG], D, D, ws + WS_WG, scr, r / 16, r % 16, lane, (const float*)a.in[I_NPLE], 1.0f); continue; } r -= I_SQ;
        if (r < I_WPI) { tr_item<WK_PLAIN, false>((const float*)a.in[I_WP], PLE, D, ws + WS_WPT, scr, r / 16, r % 16, lane, nullptr, 1.0f); continue; } r -= I_WPI;
        if (r < I_RT) { tr_item<WK_PLAIN, false>((const float*)a.in[I_RW], D, NE, ws + WS_ROUT, scr, r, 0, lane, (const float*)a.in[I_NMOE], 1.0f); continue; } r -= I_RT;
        { const int g = r / 4, q = r % 4; tr_item<WK_PLAIN, false>((const float*)a.in[I_POOLW] + (size_t)g * 128 * 128, 128, 128, ws + WS_PWT + (size_t)g * 128 * 128 * 2, scr, q / 2, q % 2, lane, nullptr, 1.0f); }
    }
    const float* x = (const float*)a.in[I_X]; const float* nw = (const float*)a.in[I_NMIX]; bf16_t* hn = (bf16_t*)(ws + WS_HN1);
    f32x4 wv[4];
#pragma unroll
    for (int j = 0; j < 4; ++j) wv[j] = *((const f32x4*)nw + lane + 64 * j);
    for (int m = gw; m < T; m += NGW) {
        const f32x4* xr = (const f32x4*)(x + (size_t)m * D) + lane; f32x4 v[4]; float s = 0.f;
#pragma unroll
        for (int j = 0; j < 4; ++j) { v[j] = xr[64 * j]; s += (v[j][0] * v[j][0] + v[j][1] * v[j][1]) + (v[j][2] * v[j][2] + v[j][3] * v[j][3]); }
        const float rstd = __builtin_amdgcn_rsqf(wave_sum(s) * (1.f / D) + NORM_EPS);
        u32x2* o8 = (u32x2*)(hn + (size_t)m * D) + lane;
#pragma unroll
        for (int j = 0; j < 4; ++j) { const f32x4 y = v[j] * rstd * wv[j]; u32x2 w; w.x = cvt_pk_bf16(y[0], y[1]); w.y = cvt_pk_bf16(y[2], y[3]); o8[64 * j] = w; }
    }
    const f32x4* pv = (const f32x4*)a.in[I_P]; u32x2* pb = (u32x2*)(ws + WS_PB);
    for (size_t i = (size_t)vcu * 512 + tid; i < (size_t)T * PLE / 4; i += (size_t)G * 512) { const f32x4 v = pv[i]; u32x2 w; w.x = cvt_pk_bf16(v[0], v[1]); w.y = cvt_pk_bf16(v[2], v[3]); pb[i] = w; }
}

__device__ __forceinline__ int tt_off(int d, int m) { return d * 136 + ((((m >> 3) ^ ((d >> 3) & 7)) << 3) | (m & 7)); }
__device__ __forceinline__ void tt_write8(LAS bf16_t* base, int d0, int m, const u32x4 v) {
    const int blk = (((m >> 3) ^ ((d0 >> 3) & 7)) << 3) | (m & 7); LAS bf16_t* p = base + d0 * 136 + blk;
    p[0 * 136] = (bf16_t)(v.x & 0xffff); p[1 * 136] = (bf16_t)(v.x >> 16); p[2 * 136] = (bf16_t)(v.y & 0xffff); p[3 * 136] = (bf16_t)(v.y >> 16);
    p[4 * 136] = (bf16_t)(v.z & 0xffff); p[5 * 136] = (bf16_t)(v.z >> 16); p[6 * 136] = (bf16_t)(v.w & 0xffff); p[7 * 136] = (bf16_t)(v.w >> 16);
}
__device__ __forceinline__ void phase_kv(const Args& a, LAS unsigned char* lds, int G) {
    const int tid = threadIdx.x, lane = tid & 63, w = __builtin_amdgcn_readfirstlane(tid >> 6), fr = lane & 15, fq = lane >> 4;
    const bf16_t* Kb = (const bf16_t*)(a.ws + WS_K); const bf16_t* Vb = (const bf16_t*)(a.ws + WS_V); float* KV = (float*)(a.ws + WS_KV);
    const int seg = tid & 7, r0 = tid >> 3;
    u32x4 rk[2], rv[2];
    int u = blockIdx.x;
#define KV_LOAD(uu) do { const size_t tok0 = (size_t)((uu) >> 3) * CH; const int hc = ((uu) & 7) * HD; _Pragma("unroll") for (int i = 0; i < 2; ++i) { const size_t o = (tok0 + r0 + 64 * i) * 512 + hc + seg * 8; rk[i] = *(const u32x4*)(Kb + o); rv[i] = *(const u32x4*)(Vb + o); } } while (0)
    if (u < 2048) KV_LOAD(u);
    for (int buf = 0; u < 2048; u += G, buf ^= 1) {
        LAS bf16_t* KT = (LAS bf16_t*)(lds + buf * 34816); LAS bf16_t* VT = KT + 64 * 136;
#pragma unroll
        for (int i = 0; i < 2; ++i) { tt_write8(KT, seg * 8, r0 + 64 * i, rk[i]); tt_write8(VT, seg * 8, r0 + 64 * i, rv[i]); }
        __syncthreads();
        if (u + G < 2048) KV_LOAD(u + G);
        const int dt = w & 3; const float sc = __builtin_amdgcn_exp2f(127.0f * log2_gamma(u & 7));
#pragma unroll
        for (int q = 0; q < 2; ++q) { const int et = (w >> 2) * 2 + q; f32x4 acc = {0.f, 0.f, 0.f, 0.f};
#pragma unroll
            for (int ks = 0; ks < 4; ++ks) { const int d = 16 * dt + fr, e = 16 * et + fr, m0 = 32 * ks + 8 * fq;
                const bf16x8 A = *(const LAS bf16x8*)(KT + tt_off(d, m0)); const bf16x8 B = *(const LAS bf16x8*)(VT + tt_off(e, m0));
                acc = __builtin_amdgcn_mfma_f32_16x16x32_bf16(A, B, acc, 0, 0, 0); }
            *(f32x4*)(KV + (size_t)u * 4096 + (16 * et + fr) * 64 + 16 * dt + 4 * fq) = acc * sc; }
    }
#undef KV_LOAD
    __syncthreads();
}
__device__ __forceinline__ void phase_pool(const Args& a, LAS unsigned char* lds, int G) {
    const int tid = threadIdx.x, lane = tid & 63, w = __builtin_amdgcn_readfirstlane(tid >> 6), fr = lane & 15, fq = lane >> 4;
    const bf16_t* U = (const bf16_t*)(a.ws + WS_U); const bf16_t* PWt = (const bf16_t*)(a.ws + WS_PWT); bf16_t* MIX = (bf16_t*)(a.ws + WS_MIX);
    const float* pscale = (const float*)a.in[I_POOLS];
    LAS bf16_t* UB = (LAS bf16_t*)lds; LAS bf16_t* PA = (LAS bf16_t*)(lds + 38912); LAS bf16_t* PW = (LAS bf16_t*)(lds + 73728);
    int gl = -1;
    for (int u = blockIdx.x; u < (T / 128) * 4; u += G) {
        const int g = u & 3, t0 = (u >> 2) * 128;
        if (g != gl) { gl = g;
#pragma unroll
            for (int i = 0; i < 4; ++i) { const int p = tid + 512 * i, d = p >> 4, sg = p & 15; *(LAS u32x4*)(PW + d * 136 + sg * 8) = *(const u32x4*)(PWt + ((size_t)g * 128 + d) * 128 + sg * 8); } }
        const bool seq0 = (t0 & (SEQ - 1)) == 0;
#pragma unroll
        for (int i = 0; i < 5; ++i) { const int p = tid + 512 * i, lr = p >> 4, sg = p & 15;
            if (lr < 143) { u32x4 v = {0u, 0u, 0u, 0u}; if (lr >= 15 || !seq0) v = *(const u32x4*)(U + (size_t)(t0 - 15 + lr) * 512 + g * 128 + sg * 8); *(LAS u32x4*)(UB + lr * 136 + sg * 8) = v; } }
        __syncthreads();
        { const int cg = tid & 15, rg = tid >> 4, wnd = 2 << g;
#pragma unroll
          for (int q = 0; q < 4; ++q) { const int r = 4 * rg + q; const int s = (t0 + r) & (SEQ - 1); const float inv = 1.0f / (float)((s + 1) < wnd ? (s + 1) : wnd);
              float sum[8];
#pragma unroll
              for (int j = 0; j < 8; ++j) sum[j] = 0.f;
              for (int k = 0; k < wnd; ++k) { const u32x4 v = *(const LAS u32x4*)(UB + (r + 15 - k) * 136 + cg * 8);
                  sum[0] += bf_lo(v.x); sum[1] += bf_hi(v.x); sum[2] += bf_lo(v.y); sum[3] += bf_hi(v.y); sum[4] += bf_lo(v.z); sum[5] += bf_hi(v.z); sum[6] += bf_lo(v.w); sum[7] += bf_hi(v.w); }
              const u32x4 c = *(const LAS u32x4*)(UB + (r + 15) * 136 + cg * 8);
              u32x4 o; o.x = cvt_pk_bf16(sum[0] * inv - bf_lo(c.x), sum[1] * inv - bf_hi(c.x)); o.y = cvt_pk_bf16(sum[2] * inv - bf_lo(c.y), sum[3] * inv - bf_hi(c.y));
              o.z = cvt_pk_bf16(sum[4] * inv - bf_lo(c.z), sum[5] * inv - bf_hi(c.z)); o.w = cvt_pk_bf16(sum[6] * inv - bf_lo(c.w), sum[7] * inv - bf_hi(c.w));
              *(LAS u32x4*)(PA + r * 136 + cg * 8) = o; } }
        __syncthreads();
        f32x4 acc[8];
#pragma unroll
        for (int dt = 0; dt < 8; ++dt) acc[dt] = (f32x4){0.f, 0.f, 0.f, 0.f};
#pragma unroll
        for (int kk = 0; kk < 4; ++kk) { const bf16x8 B = *(const LAS bf16x8*)(PA + (16 * w + fr) * 136 + 32 * kk + 8 * fq);
#pragma unroll
            for (int dt = 0; dt < 8; ++dt) { const bf16x8 A = *(const LAS bf16x8*)(PW + (16 * dt + fr) * 136 + 32 * kk + 8 * fq); acc[dt] = __builtin_amdgcn_mfma_f32_16x16x32_bf16(A, B, acc[dt], 0, 0, 0); } }
        const size_t tok = (size_t)t0 + 16 * w + fr;
#pragma unroll
        for (int dt = 0; dt < 8; ++dt) { const int d = 16 * dt + 4 * fq; const f32x4 sc = *(const f32x4*)(pscale + g * 128 + d); const f32x4 o = acc[dt] * sc;
            u32x2 wv; wv.x = cvt_pk_bf16(o[0], o[1]); wv.y = cvt_pk_bf16(o[2], o[3]); *(u32x2*)(MIX + tok * D + 512 + g * 128 + d) = wv; }
        __syncthreads();
    }
}
__device__ __forceinline__ void phase_scan(const Args& a, int G) {
    const float* KV = (const float*)(a.ws + WS_KV); bf16_t* ST = (bf16_t*)(a.ws + WS_ST);
    for (int v = blockIdx.x * 512 + threadIdx.x; v < NBATCH * NH * 1024; v += G * 512) {
        const int bh = v >> 10, q = v & 1023, b = bh >> 3, h = bh & 7;
        const float lg = log2_gamma(h), gam = __builtin_amdgcn_exp2f(lg), cd = __builtin_amdgcn_exp2f(128.0f * lg);
        f32x4 s = {0.f, 0.f, 0.f, 0.f};
        for (int n0 = 0; n0 < NCH; n0 += 8) { f32x4 kv[8];
#pragma unroll
            for (int j = 0; j < 8; ++j) kv[j] = *(const f32x4*)(KV + ((size_t)((b * NCH + n0 + j) * NH + h)) * 4096 + q * 4);
#pragma unroll
            for (int j = 0; j < 8; ++j) { const f32x4 o = s * gam; u32x2 wv; wv.x = cvt_pk_bf16(o[0], o[1]); wv.y = cvt_pk_bf16(o[2], o[3]);
                *(u32x2*)(ST + ((size_t)((b * NCH + n0 + j) * NH + h)) * 4096 + q * 4) = wv; s = s * cd + kv[j]; } }
    }
}
__device__ __forceinline__ void phase_ret(const Args& a, LAS unsigned char* lds, int G) {
    const int tid = threadIdx.x, lane = tid & 63, w = __builtin_amdgcn_readfirstlane(tid >> 6), fr = lane & 15, fq = lane >> 4;
    const bf16_t* Qb = (const bf16_t*)(a.ws + WS_Q); const bf16_t* Kb = (const bf16_t*)(a.ws + WS_K); const bf16_t* Vb = (const bf16_t*)(a.ws + WS_V);
    const bf16_t* Gb = (const bf16_t*)(a.ws + WS_G); const bf16_t* STg = (const bf16_t*)(a.ws + WS_ST); bf16_t* MIX = (bf16_t*)(a.ws + WS_MIX);
    const float* gnw = (const float*)a.in[I_GNW];
    const int seg = tid & 7, r0 = tid >> 3;
    u32x4 rk[2], rv[2], rs;
    int u = blockIdx.x;
#define RT_LOAD(uu) do { const size_t tok0 = (size_t)((uu) >> 3) * CH; const int hc = ((uu) & 7) * HD; _Pragma("unroll") for (int i = 0; i < 2; ++i) { const size_t o = (tok0 + r0 + 64 * i) * 512 + hc + seg * 8; rk[i] = *(const u32x4*)(Kb + o); rv[i] = *(const u32x4*)(Vb + o); } \
        rs = *(const u32x4*)(STg + (size_t)(uu) * 4096 + r0 * 64 + seg * 8); } while (0)
    if (u < 2048) RT_LOAD(u);
    for (int buf = 0; u < 2048; u += G, buf ^= 1) {
        LAS bf16_t* Kr = (LAS bf16_t*)(lds + buf * 45056); LAS bf16_t* VT = Kr + 128 * 72; LAS bf16_t* SL = VT + 64 * 136;
#pragma unroll
        for (int i = 0; i < 2; ++i) { *(LAS u32x4*)(Kr + (r0 + 64 * i) * 72 + seg * 8) = rk[i]; tt_write8(VT, seg * 8, r0 + 64 * i, rv[i]); }
        *(LAS u32x4*)(SL + r0 * 72 + seg * 8) = rs;
        __syncthreads();
        if (u + G < 2048) RT_LOAD(u + G);
        const size_t tok0 = (size_t)(u >> 3) * CH; const int hc = (u & 7) * HD; const size_t ctok = tok0 + 16 * w + fr;
        bf16x8 qf[2];
#pragma unroll
        for (int kk = 0; kk < 2; ++kk) qf[kk] = *(const bf16x8*)(Qb + ctok * 512 + hc + 32 * kk + 8 * fq);
        u32x2 pk[8];
#pragma unroll
        for (int am = 0; am < 8; ++am) {
            if (am <= w) { f32x4 s = {0.f, 0.f, 0.f, 0.f};
#pragma unroll
                for (int kk = 0; kk < 2; ++kk) { const bf16x8 A = *(const LAS bf16x8*)(Kr + (16 * am + fr) * 72 + 32 * kk + 8 * fq); s = __builtin_amdgcn_mfma_f32_16x16x32_bf16(A, qf[kk], s, 0, 0, 0); }
                if (am == w) {
#pragma unroll
                    for (int j = 0; j < 4; ++j) if (4 * fq + j > fr) s[j] = 0.f; }
                pk[am].x = cvt_pk_bf16(s[0], s[1]); pk[am].y = cvt_pk_bf16(s[2], s[3]);
            } else { pk[am].x = 0u; pk[am].y = 0u; } }
        f32x4 y[4];
#pragma unroll
        for (int et = 0; et < 4; ++et) y[et] = (f32x4){0.f, 0.f, 0.f, 0.f};
#pragma unroll
        for (int s2 = 0; s2 < 4; ++s2) {
            if (2 * s2 <= w) { u32x4 bw; bw.x = pk[2 * s2].x; bw.y = pk[2 * s2].y; bw.z = pk[2 * s2 + 1].x; bw.w = pk[2 * s2 + 1].y; const bf16x8 B = __builtin_bit_cast(bf16x8, bw);
#pragma unroll
                for (int et = 0; et < 4; ++et) { const int e = 16 * et + fr, es = (e >> 3) & 7;
                    const u32x2 lo = *(const LAS u32x2*)(VT + e * 136 + (((4 * s2 + (fq >> 1)) ^ es) << 3) + 4 * (fq & 1));
                    const u32x2 hi = *(const LAS u32x2*)(VT + e * 136 + (((4 * s2 + 2 + (fq >> 1)) ^ es) << 3) + 4 * (fq & 1));
                    u32x4 aw; aw.x = lo.x; aw.y = lo.y; aw.z = hi.x; aw.w = hi.y;
                    y[et] = __builtin_amdgcn_mfma_f32_16x16x32_bf16(__builtin_bit_cast(bf16x8, aw), B, y[et], 0, 0, 0); } } }
#pragma unroll
        for (int kk = 0; kk < 2; ++kk)
#pragma unroll
            for (int et = 0; et < 4; ++et) { const bf16x8 A = *(const LAS bf16x8*)(SL + (16 * et + fr) * 72 + 32 * kk + 8 * fq); y[et] = __builtin_amdgcn_mfma_f32_16x16x32_bf16(A, qf[kk], y[et], 0, 0, 0); }
        float s = 0.f;
#pragma unroll
        for (int et = 0; et < 4; ++et) s += (y[et][0] + y[et][1]) + (y[et][2] + y[et][3]);
        s += __shfl_xor(s, 16); s += __shfl_xor(s, 32);
        const float mean = s * (1.0f / 64.0f); float q2 = 0.f;
#pragma unroll
        for (int et = 0; et < 4; ++et) { const f32x4 d = y[et] - mean; q2 += (d[0] * d[0] + d[1] * d[1]) + (d[2] * d[2] + d[3] * d[3]); }
        q2 += __shfl_xor(q2, 16); q2 += __shfl_xor(q2, 32);
        const float rstd = __builtin_amdgcn_rsqf(q2 * (1.0f / 64.0f) + GN_EPS);
#pragma unroll
        for (int et = 0; et < 4; ++et) { const int col = hc + 16 * et + 4 * fq; const u32x2 gv = *(const u32x2*)(Gb + ctok * 512 + col); const f32x4 gw = *(const f32x4*)(gnw + col);
            const float g0 = bf_lo(gv.x), g1 = bf_hi(gv.x), g2 = bf_lo(gv.y), g3 = bf_hi(gv.y);
            const float o0 = (y[et][0] - mean) * rstd * gw[0] * g0 * sigmoidf_fast(g0), o1 = (y[et][1] - mean) * rstd * gw[1] * g1 * sigmoidf_fast(g1);
            const float o2 = (y[et][2] - mean) * rstd * gw[2] * g2 * sigmoidf_fast(g2), o3 = (y[et][3] - mean) * rstd * gw[3] * g3 * sigmoidf_fast(g3);
            u32x2 wv; wv.x = cvt_pk_bf16(o0, o1); wv.y = cvt_pk_bf16(o2, o3); *(u32x2*)(MIX + ctok * D + col) = wv; }
    }
#undef RT_LOAD
    __syncthreads();
}

__device__ __forceinline__ void phase_router(const Args& a, LAS unsigned char* lds, int G) {
    const int tid = threadIdx.x, lane = tid & 63, w = __builtin_amdgcn_readfirstlane(tid >> 6), fr = lane & 15, fq = lane >> 4;
    const bf16_t* RT = (const bf16_t*)(a.ws + WS_ROUT); const bf16_t* H1W = (const bf16_t*)(a.ws + WS_HN1); const float* ssq = (const float*)(a.ws + WS_SSQ1);
    const float* rb = (const float*)a.in[I_RB];
    int* topi = (int*)(a.ws + WS_TOPI); float* topg = (float*)(a.ws + WS_TOPG); float* rstd1 = (float*)(a.ws + WS_RSTD1); int* bh = (int*)(a.ws + WS_BH);
    LAS bf16_t* RL = (LAS bf16_t*)lds;
    LAS float* LG = (LAS float*)(lds + 66048) + w * (16 * 33);
    LAS int* hist = (LAS int*)(lds + 66048 + 8 * 16 * 33 * 4);
#pragma unroll
    for (int i = 0; i < 8; ++i) { const int p = tid + 512 * i, e = p >> 7, sg = p & 127; *(LAS u32x4*)(RL + e * 1032 + sg * 8) = *(const u32x4*)(RT + (size_t)e * D + sg * 8); }
    for (int tb = blockIdx.x; tb < T / 128; tb += G) {
        if (tid < 32) hist[tid] = 0;
        __syncthreads();
        const size_t t0 = (size_t)tb * 128 + 16 * w;
        f32x4 acc0 = {0.f, 0.f, 0.f, 0.f}, acc1 = {0.f, 0.f, 0.f, 0.f};
#pragma unroll 8
        for (int kk = 0; kk < 32; ++kk) { const bf16x8 B = *(const bf16x8*)(H1W + (t0 + fr) * D + 32 * kk + 8 * fq);
            const bf16x8 A0 = *(const LAS bf16x8*)(RL + fr * 1032 + 32 * kk + 8 * fq), A1 = *(const LAS bf16x8*)(RL + (16 + fr) * 1032 + 32 * kk + 8 * fq);
            acc0 = __builtin_amdgcn_mfma_f32_16x16x32_bf16(A0, B, acc0, 0, 0, 0); acc1 = __builtin_amdgcn_mfma_f32_16x16x32_bf16(A1, B, acc1, 0, 0, 0); }
#pragma unroll
        for (int j = 0; j < 4; ++j) { LG[fr * 33 + 4 * fq + j] = acc0[j]; LG[fr * 33 + 16 + 4 * fq + j] = acc1[j]; }
        LDS_WAIT(); asm volatile("" ::: "memory");
        if (lane < 16) {
            const size_t t = t0 + lane; float sq = 0.f;
#pragma unroll
            for (int q = 0; q < 4; ++q) { const f32x4 v = *(const f32x4*)(ssq + t * 16 + 4 * q); sq += (v[0] + v[1]) + (v[2] + v[3]); }
            const float rstd = __builtin_amdgcn_rsqf(sq * (1.f / D) + NORM_EPS);
            float v0 = -3.0e38f, v1 = -3.0e38f, v2 = -3.0e38f, v3 = -3.0e38f; int i0 = 0, i1 = 0, i2 = 0, i3 = 0;
#pragma unroll
            for (int e = 0; e < NE; ++e) { const float v = LG[lane * 33 + e] * rstd + rb[e];
                if (v > v3) { if (v > v2) { v3 = v2; i3 = i2; if (v > v1) { v2 = v1; i2 = i1; if (v > v0) { v1 = v0; i1 = i0; v0 = v; i0 = e; } else { v1 = v; i1 = e; } } else { v2 = v; i2 = e; } } else { v3 = v; i3 = e; } } }
            const float e1 = __expf(v1 - v0), e2 = __expf(v2 - v0), e3 = __expf(v3 - v0), inv = 1.0f / (1.0f + e1 + e2 + e3);
            *(int4*)(topi + t * 4) = make_int4(i0, i1, i2, i3); *(float4*)(topg + t * 4) = make_float4(inv, e1 * inv, e2 * inv, e3 * inv); rstd1[t] = rstd;
            lds_inc(&hist[i0]); lds_inc(&hist[i1]); lds_inc(&hist[i2]); lds_inc(&hist[i3]);
        }
        __syncthreads();
        if (tid < 32) bh[tb * 32 + tid] = hist[tid];
        __syncthreads();
    }
}
__device__ __forceinline__ void vtab_put(unsigned* vt, int pos, unsigned tok) {
    const int tile = pos >> 8, r = pos & 255, hh = r >> 7, R = r & 127, rg = R >> 4, rr = R & 15;
#pragma unroll
    for (int ch = 0; ch < 2; ++ch)
#pragma unroll
        for (int p = 0; p < 4; ++p) { const int st = rg * 2 + ch, ob = rr * 64 + p * 16, sb = ob ^ (((ob >> 9) & 1) << 5), b = st * 1024 + sb, i = b >> 13, td = (b & 8191) >> 4;
            vt[((size_t)tile * 512 + td) * 4 + hh * 2 + i] = tok * (unsigned)(MOE_F8 ? D : 2 * D) + ch * 64 + p * 16; }
}
__device__ __forceinline__ void phase_place(const Args& a, LAS unsigned char* lds, int G) {
    const int tid = threadIdx.x;
    const int* bh = (const int*)(a.ws + WS_BH); const int* topi = (const int*)(a.ws + WS_TOPI); const float* topg = (const float*)(a.ws + WS_TOPG); const float* rstd1 = (const float*)(a.ws + WS_RSTD1);
    int* spos = (int*)(a.ws + WS_SPOS); float* SG = (float*)(a.ws + WS_SG); float* SR = (float*)(a.ws + WS_SR); unsigned* vt = (unsigned*)(a.ws + WS_VTAB);
    unsigned* ctl = (unsigned*)(a.ws + WS_CTL);
    LAS int* pt = (LAS int*)lds; LAS int* pb = pt + 512; LAS int* tot = pb + 512; LAS int* off = tot + 32; LAS int* base = off + 32; LAS int* rank = base + 32;
    constexpr int NTB = T / 128;
    for (int it = 0, tb = blockIdx.x; it == 0 || tb < NTB; ++it, tb += G) {
        const int e = tid & 31, part = tid >> 5; int st = 0, sb = 0;
        for (int b = part; b < NTB; b += 16) { const int v = bh[b * 32 + e]; st += v; if (b < tb) sb += v; }
        pt[tid] = st; pb[tid] = sb;
        __syncthreads();
        if (tid < 32) { int s1 = 0, s2 = 0;
#pragma unroll
            for (int q = 0; q < 16; ++q) { s1 += pt[q * 32 + tid]; s2 += pb[q * 32 + tid]; }
            tot[tid] = s1; base[tid] = s2; rank[tid] = 0; }
        __syncthreads();
        if (tid == 0) { int o = 0; for (int q = 0; q < NE; ++q) { off[q] = o; o += (tot[q] + 255) & ~255; } }
        __syncthreads();
        if (tb < NTB) {
            const int t = tb * 128 + (tid >> 2), k = tid & 3; const int ex = topi[t * 4 + k];
            const int pos = off[ex] + base[ex] + lds_inc(&rank[ex]);
            spos[t * 4 + k] = pos; SG[pos] = topg[t * 4 + k]; SR[pos] = rstd1[t]; vtab_put(vt, pos, (unsigned)t);
        }
        if (it == 0) {
            for (int ex = blockIdx.x; ex < NE; ex += G) { const int n = tot[ex], np = (n + 255) & ~255;
                for (int r = n + tid; r < np; r += 512) { const int pos = off[ex] + r; SG[pos] = 0.f; SR[pos] = 0.f; vtab_put(vt, pos, 0u); } }
            if (blockIdx.x == 0 && tid < 32) ctl[CW_TOT + tid] = (unsigned)tot[tid];
        }
        __syncthreads();
    }
}
__device__ __forceinline__ int build_tiles(const Args& a, LAS unsigned short* te) {
    const unsigned* ctl = (const unsigned*)(a.ws + WS_CTL);
    int o = 0;
    for (int e = 0; e < NE; ++e) { const int n = (int)((ctl[CW_TOT + e] + 255u) >> 8); for (int q = threadIdx.x; q < n; q += 512) te[o + q] = (unsigned short)e; o += n; }
    __syncthreads();
    return o;
}
__device__ __forceinline__ void phase_combine(const Args& a, int vcu, int G) {
    const int tid = threadIdx.x, lane = tid & 63, wave = tid >> 6; const int gw = vcu * 8 + wave, NGW = G * 8;
    bf16_t* hb = (bf16_t*)(a.ws + WS_HN1); const bf16_t* Y = (const bf16_t*)(a.ws + WS_Y); const int* spos = (const int*)(a.ws + WS_SPOS); float* rstd2 = (float*)(a.ws + WS_RSTD2);
    for (int t = gw; t < T; t += NGW) {
        const int4 ps = *(const int4*)(spos + (size_t)t * 4);
        float v[2][8]; float s = 0.f;
#pragma unroll
        for (int j = 0; j < 2; ++j) { const u32x4 hv = *(const u32x4*)(hb + (size_t)t * D + 8 * lane + 512 * j);
            v[j][0] = bf_lo(hv.x); v[j][1] = bf_hi(hv.x); v[j][2] = bf_lo(hv.y); v[j][3] = bf_hi(hv.y); v[j][4] = bf_lo(hv.z); v[j][5] = bf_hi(hv.z); v[j][6] = bf_lo(hv.w); v[j][7] = bf_hi(hv.w); }
#pragma unroll
        for (int k = 0; k < 4; ++k) { const int pk = k == 0 ? ps.x : (k == 1 ? ps.y : (k == 2 ? ps.z : ps.w));
#pragma unroll
            for (int j = 0; j < 2; ++j) { const u32x4 yv = *(const u32x4*)(Y + (size_t)pk * D + 8 * lane + 512 * j);
                v[j][0] += bf_lo(yv.x); v[j][1] += bf_hi(yv.x); v[j][2] += bf_lo(yv.y); v[j][3] += bf_hi(yv.y); v[j][4] += bf_lo(yv.z); v[j][5] += bf_hi(yv.z); v[j][6] += bf_lo(yv.w); v[j][7] += bf_hi(yv.w); } }
#pragma unroll
        for (int j = 0; j < 2; ++j) {
#pragma unroll
            for (int q = 0; q < 8; ++q) s += v[j][q] * v[j][q];
            u32x4 o; o.x = cvt_pk_bf16(v[j][0], v[j][1]); o.y = cvt_pk_bf16(v[j][2], v[j][3]); o.z = cvt_pk_bf16(v[j][4], v[j][5]); o.w = cvt_pk_bf16(v[j][6], v[j][7]);
            *(u32x4*)(hb + (size_t)t * D + 8 * lane + 512 * j) = o; }
        s = wave_sum(s);
        if (lane == 0) rstd2[t] = __builtin_amdgcn_rsqf(s * (1.f / D) + NORM_EPS);
    }
}
__device__ __forceinline__ void phase_final(const Args& a, int vcu, int G) {
    const int tid = threadIdx.x, lane = tid & 63, wave = tid >> 6; const int gw = vcu * 8 + wave, NGW = G * 8;
    float* h = a.out; const float* nw = (const float*)a.in[I_NFIN];
    f32x4 wv[4];
#pragma unroll
    for (int j = 0; j < 4; ++j) wv[j] = *((const f32x4*)nw + lane + 64 * j);
    float scale = 1.0f;
#if MK_DEBUG
    { const unsigned f = *(const unsigned*)(a.ws + WS_CTL + 4 * CW_FAIL); if (f) scale = 1.0f + 0.1f * (float)__builtin_ctz(f); }
#endif
    for (int t = gw; t < T; t += NGW) {
        f32x4* hr = (f32x4*)(h + (size_t)t * D) + lane; f32x4 v[4]; float s = 0.f;
#pragma unroll
        for (int j = 0; j < 4; ++j) { v[j] = hr[64 * j]; s += (v[j][0] * v[j][0] + v[j][1] * v[j][1]) + (v[j][2] * v[j][2] + v[j][3] * v[j][3]); }
        const float rstd = __builtin_amdgcn_rsqf(wave_sum(s) * (1.f / D) + NORM_EPS) * scale;
#pragma unroll
        for (int j = 0; j < 4; ++j) hr[64 * j] = v[j] * rstd * wv[j];
    }
}

__global__ void __launch_bounds__(512, 2) fwd_kernel(Args args) {
    extern __shared__ __attribute__((aligned(16))) unsigned char lds_raw[];
    LAS unsigned char* lds = (LAS unsigned char*)lds_raw;
    const int tid = threadIdx.x, G = gridDim.x;
    const int vcu = (G % 8 == 0) ? ((int)blockIdx.x % 8) * (G / 8) + (int)blockIdx.x / 8 : (int)blockIdx.x;
    volatile LAS unsigned* MISC = (volatile LAS unsigned*)(lds + LCTL_OFF);
    if (tid < 4) MISC[tid] = 0u;
    __syncthreads();
    unsigned* ctl = (unsigned*)(args.ws + WS_CTL);
    XcdBarrier bar; bar.bar = ctl + CW_BAR; bar.x = 0; bar.st = nullptr;
    const int lo = args.ph_lo, hi = args.ph_hi;
    if (hi - lo > 1) bar = xcd_barrier_post(ctl + CW_BAR, MISC);
#ifndef PH_MASK
#define PH_MASK 0x1fff
#endif
#define IN(k) (((PH_MASK >> (k)) & 1) && lo <= (k) && (k) < hi)
#define SEAM(k) do { if (IN(k) && IN((k) + 1)) xcd_barrier(bar); } while (0)
    LAS unsigned short* te = (LAS unsigned short*)(lds + LCTL_OFF + 64);
    const char* ws = (const char*)args.ws;

    if (IN(0)) phase_prologue(args, lds, vcu, G);
    SEAM(0);
    if (IN(1)) {
        { pg8::DenseSched S; S.init(T, NIN, G, (int)blockIdx.x);
          pg8::EpiInProj E{(bf16_t*)(args.ws + WS_Q), (const int*)args.in[I_POS]};
          pg8::gemm_phase<false>(lds, ws + WS_HN1, ws + WS_WIN, D * 2, S, E); }
        { pg8::DenseSched S; S.init(T, D, G, (int)blockIdx.x);
          pg8::EpiPlainBf16 E{(bf16_t*)(args.ws + WS_PP), D};
          pg8::gemm_phase<false>(lds, ws + WS_PB, ws + WS_WPT, PLE * 2, S, E); }
    }
    SEAM(1);
    if (IN(2)) { phase_kv(args, lds, G); phase_pool(args, lds, G); }
    SEAM(2);
    if (IN(3)) phase_scan(args, G);
    SEAM(3);
    if (IN(4)) phase_ret(args, lds, G);
    SEAM(4);
    if (IN(5)) {
        pg8::DenseSched S; S.init(T, D, G, (int)blockIdx.x);
        pg8::EpiWout E{(const float*)args.in[I_X], (bf16_t*)(args.ws + WS_HN1), args.ws + WS_H1F8, (float*)(args.ws + WS_SSQ1)};
        pg8::gemm_phase<false>(lds, ws + WS_MIX, ws + WS_WOUT, D * 2, S, E);
    }
    SEAM(5);
    if (IN(6)) phase_router(args, lds, G);
    SEAM(6);
    if (IN(7)) phase_place(args, lds, G);
    SEAM(7);
    if (IN(8)) {
        const int MT = build_tiles(args, te);
        pg8::GroupSchedG S; S.nM = MT; S.nN = 2 * DE / 256; S.G = G; S.c = (int)blockIdx.x; S.NB = 2 * DE; S.te = te; S.vtab = args.ws + WS_VTAB;
        pg8::EpiGateUp E{args.ws + WS_ACT, (const float*)args.in[I_BGU], (const float*)(args.ws + WS_SR)};
        pg8::gemm_phase<MOE_F8 != 0>(lds, MOE_F8 ? ws + WS_H1F8 : ws + WS_HN1, ws + WS_WGU, MOE_F8 ? D : 2 * D, S, E);
    }
    SEAM(8);
    if (IN(9)) {
        const int MT = build_tiles(args, te);
        pg8::GroupSchedD S; S.nM = MT; S.nN = D / 256; S.G = G; S.c = (int)blockIdx.x; S.NB = D; S.te = te; S.vtab = nullptr;
        pg8::EpiDown E{(bf16_t*)(args.ws + WS_Y), (const float*)args.in[I_BD], (const float*)(args.ws + WS_SG)};
        pg8::gemm_phase<MOE_F8 != 0>(lds, ws + WS_ACT, ws + WS_WD, MOE_F8 ? DE : 2 * DE, S, E);
    }
    SEAM(9);
    if (IN(10)) phase_combine(args, vcu, G);
    SEAM(10);
    if (IN(11)) {
        pg8::DenseSched S; S.init(T, D, G, (int)blockIdx.x);
        pg8::EpiPle E{args.out, (const bf16_t*)(args.ws + WS_HN1), (const bf16_t*)(args.ws + WS_PP), (const float*)(args.ws + WS_RSTD2)};
        pg8::gemm_phase<false>(lds, ws + WS_HN1, ws + WS_WG, D * 2, S, E);
    }
    SEAM(11);
    if (IN(12)) phase_final(args, vcu, G);
#undef IN
#undef SEAM
}


extern "C" void kernel_launch(void* const* d_in, const int* in_sizes, int n_in, void* d_out, int out_size, void* d_ws, size_t ws_size, hipStream_t stream) {
    static int grid = 0;
    if (grid == 0) {
        if (n_in != 20 || in_sizes[0] != T * D || out_size != T * D || ws_size < WS_END) { fprintf(stderr, "kernel_launch: unexpected shapes (n_in %d, in0 %d, out %d, ws %zu < %zu)\n", n_in, n_in > 0 ? in_sizes[0] : -1, out_size, ws_size, (size_t)WS_END); grid = -1; return; }
        int dev = 0, cus = 0, per_cu = 0;
        if (hipGetDevice(&dev) != hipSuccess || hipDeviceGetAttribute(&cus, hipDeviceAttributeMultiprocessorCount, dev) != hipSuccess) { grid = -1; return; }
        if (hipFuncSetAttribute((const void*)fwd_kernel, hipFuncAttributeMaxDynamicSharedMemorySize, LDS_BYTES) != hipSuccess) { fprintf(stderr, "kernel_launch: hipFuncSetAttribute failed\n"); grid = -1; return; }
        if (hipOccupancyMaxActiveBlocksPerMultiprocessor(&per_cu, (const void*)fwd_kernel, 512, LDS_BYTES) != hipSuccess || per_cu < 1) { fprintf(stderr, "kernel_launch: occupancy query says %d\n", per_cu); (void)hipGetLastError(); }
        grid = cus;
    }
    if (grid < 0) return;
    if (hipMemsetAsync((char*)d_ws + WS_CTL, 0, CTL_ZERO_BYTES, stream) != hipSuccess) return;
    Args a{};
    for (int i = 0; i < 20; ++i) a.in[i] = d_in[i];
    a.out = (float*)d_out; a.ws = (unsigned char*)d_ws;
#if MK_PER_PHASE
    for (int p = 0; p < NPH; ++p) { a.ph_lo = p; a.ph_hi = p + 1; for (int r = 0; r < 1 + ((MK_REPEAT >> p) & 1); ++r) hipLaunchKernelGGL(fwd_kernel, dim3(grid), dim3(512), LDS_BYTES, stream, a); }
#else
    a.ph_lo = 0; a.ph_hi = NPH; hipLaunchKernelGGL(fwd_kernel, dim3(grid), dim3(512), LDS_BYTES, stream, a);
#endif
}
```

```cpp
#include <hip/hip_runtime.h>
#include <cstdio>
#include <cstdint>

#ifndef MK_PER_PHASE
#define MK_PER_PHASE 0
#endif
#ifndef MOE_F8
#define MOE_F8 1
#endif
#ifndef MK_REPEAT
#define MK_REPEAT 0x0
#endif
#ifndef MK_DEBUG
#define MK_DEBUG 0
#endif

#define GAS __attribute__((address_space(1)))
#define LAS __attribute__((address_space(3)))
typedef unsigned short bf16_t;
typedef short bf16x8 __attribute__((ext_vector_type(8)));
typedef float f32x4 __attribute__((ext_vector_type(4)));
typedef float f32x2 __attribute__((ext_vector_type(2)));
typedef unsigned u32x4 __attribute__((ext_vector_type(4)));
typedef unsigned u32x2 __attribute__((ext_vector_type(2)));
typedef int v8i __attribute__((ext_vector_type(8)));
typedef int v4i __attribute__((ext_vector_type(4)));

constexpr int T = 32768, D = 1024, SEQ = 4096, NBATCH = 8, NH = 8, HD = 64, CH = 128, NCH = 32;
constexpr int DRET = 512, DPOOL = 512, NIN = 2560, NE = 32, TOPK = 4, DE = 1024, PLE = 256;
constexpr float NORM_EPS = 1e-5f, GN_EPS = 1e-5f;
constexpr int MAXROWS = T * TOPK + NE * 256;
constexpr int MAXT = MAXROWS / 256;

constexpr size_t MiB = 1u << 20, KiB = 1u << 10;
constexpr size_t WS_CTL = 0, CTL_ZERO_BYTES = 64 * KiB;
constexpr size_t WS_ROUT = 1 * MiB, WS_PWT = 1 * MiB + 64 * KiB, WS_WPT = 1 * MiB + 256 * KiB;
constexpr size_t WS_TOPI = 2 * MiB, WS_TOPG = 2 * MiB + 512 * KiB, WS_SPOS = 3 * MiB, WS_RSTD1 = 3 * MiB + 512 * KiB, WS_RSTD2 = 3 * MiB + 640 * KiB, WS_BH = 3 * MiB + 768 * KiB;
constexpr size_t WS_SG = 4 * MiB, WS_SR = 5 * MiB, WS_SSQ1 = 6 * MiB, WS_VTAB = 8 * MiB;
constexpr size_t WS_WIN = 16 * MiB, WS_WOUT = 21 * MiB, WS_WG = 23 * MiB;
constexpr size_t WS_WGU = 32 * MiB, WS_WD = 160 * MiB, WS_PP = 224 * MiB;
constexpr size_t WS_HN1 = 288 * MiB  , WS_PB = 352 * MiB;
constexpr size_t WS_Q = 368 * MiB, WS_K = 400 * MiB, WS_V = 432 * MiB, WS_G = 464 * MiB, WS_U = 496 * MiB;
constexpr size_t WS_KV = 528 * MiB, WS_ST = 560 * MiB, WS_MIX = 576 * MiB;
constexpr size_t WS_H1F8 = 496 * MiB;
constexpr size_t WS_H3B = 368 * MiB;
constexpr size_t WS_ACT = 352 * MiB, WS_Y = 624 * MiB, WS_END = 896 * MiB;
static_assert(WS_K - WS_Q == (size_t)T * 512 * 2 && WS_V - WS_K == WS_K - WS_Q && WS_G - WS_V == WS_K - WS_Q && WS_U - WS_G == WS_K - WS_Q, "q|k|v|g|u equally spaced");
static_assert(WS_VTAB + (size_t)MAXT * 512 * 16 <= WS_WIN && WS_ACT + (size_t)MAXROWS * DE * 2 <= WS_Y && WS_Y + (size_t)MAXROWS * D * 2 <= WS_END, "ws map");
constexpr int CW_TMO = 0, CW_CODE = 1, CW_FAIL = 2, CW_TOT = 64, CW_BAR = 4096;

constexpr int VOFF_OFF = 131072;
constexpr int LCTL_OFF = 147456;
constexpr int LDS_BYTES = 151552;

#define LDS_WAIT() asm volatile("s_waitcnt lgkmcnt(0)" ::: "memory")
#define VM_WAIT() asm volatile("s_waitcnt vmcnt(0)" ::: "memory")
__device__ __forceinline__ unsigned cvt_pk_bf16(float lo, float hi) { unsigned r; asm volatile("v_cvt_pk_bf16_f32 %0, %1, %2" : "=v"(r) : "v"(lo), "v"(hi)); return r; }
__device__ __forceinline__ unsigned cvt4_fp8(float a, float b, float c, float d) { int w = __builtin_amdgcn_cvt_pk_fp8_f32(a, b, 0, false); w = __builtin_amdgcn_cvt_pk_fp8_f32(c, d, w, true); return (unsigned)w; }
__device__ __forceinline__ bf16x8 v8lo(const v8i x) { const v4i t = x.lo; return __builtin_bit_cast(bf16x8, t); }
__device__ __forceinline__ bf16x8 v8hi(const v8i x) { const v4i t = x.hi; return __builtin_bit_cast(bf16x8, t); }
__device__ __forceinline__ void fp8x4_to_f32(unsigned w, float& a, float& b, float& c, float& d) { const f32x2 lo = __builtin_amdgcn_cvt_pk_f32_fp8((int)w, false), hi = __builtin_amdgcn_cvt_pk_f32_fp8((int)w, true); a = lo[0]; b = lo[1]; c = hi[0]; d = hi[1]; }
__device__ __forceinline__ float bf_lo(unsigned w) { return __uint_as_float(w << 16); }
__device__ __forceinline__ float bf_hi(unsigned w) { return __uint_as_float(w & 0xffff0000u); }
__device__ __forceinline__ float wave_sum(float v) {
#pragma unroll
    for (int o = 1; o < 64; o <<= 1) v += __shfl_xor(v, o);
    return v;
}
__device__ __forceinline__ float sigmoidf_fast(float x) { return __builtin_amdgcn_rcpf(1.0f + __builtin_amdgcn_exp2f(-1.4426950408889634f * x)); }
__device__ __forceinline__ int lds_inc(LAS int* p) { return __hip_atomic_fetch_add(p, 1, __ATOMIC_RELAXED, __HIP_MEMORY_SCOPE_WORKGROUP); }
__device__ __forceinline__ float log2_gamma(int h) {
    const float x = __builtin_amdgcn_exp2f(-(float)(5 + h));
    const float ln = -x * (1.0f + x * (0.5f + x * (0.33333333f + x * (0.25f + x * 0.2f))));
    return ln * 1.4426950408889634f;
}

#define XB_TMO      128
#define XB_XCNT(j)  (256  + 64 * (j))
#define XB_XSUB(j)  (1280 + 64 * (j))
#define XB_XGEN(j)  (2304 + 64 * (j))
#define XB_TOP      3328
#define XB_TOPGEN   3392
#define XCD_BAR_WORDS 3456
#define XB_SPIN_CAP (1u << 18)
__device__ __forceinline__ unsigned xb_ld(unsigned* p)              { return __hip_atomic_load(p, __ATOMIC_RELAXED, __HIP_MEMORY_SCOPE_AGENT); }
__device__ __forceinline__ unsigned xb_add(unsigned* p, unsigned v) { return __hip_atomic_fetch_add(p, v, __ATOMIC_RELAXED, __HIP_MEMORY_SCOPE_AGENT); }
__device__ __forceinline__ unsigned xb_xcc_id() { return (unsigned)__builtin_amdgcn_s_getreg((3 << 11) | 20) & 0xFu; }
#define XB_SPIN(cond, bar) do { unsigned _sp = 0; while (cond) { __builtin_amdgcn_s_sleep(1); \
    if ((++_sp & 255u) == 0u) { if (xb_ld(&(bar)[XB_TMO])) break; if (_sp > XB_SPIN_CAP) { atomicAdd(&(bar)[XB_TMO], 1u); break; } } } } while (0)
struct XcdBarrier { unsigned* bar; unsigned x; volatile LAS unsigned* st; };
__device__ __forceinline__ XcdBarrier xcd_barrier_post(unsigned* bar, volatile LAS unsigned* st) {
    XcdBarrier b; b.bar = bar; b.x = xb_xcc_id(); b.st = st;
    if (threadIdx.x == 0) (void)xb_add(&bar[XB_XCNT(b.x)], 1u);
    return b;
}
__device__ __forceinline__ void xcd_barrier_complete(unsigned* bar, unsigned x, unsigned& nloc, unsigned& nx) {
    const unsigned G = gridDim.x * gridDim.y * gridDim.z;
    unsigned sum, cnt, mine, sp = 0u;
    for (;;) {
        sum = 0u; cnt = 0u; mine = 0u;
#pragma unroll
        for (unsigned j = 0; j < 16; ++j) { const unsigned c = xb_ld(&bar[XB_XCNT(j)]); sum += c; cnt += (c > 0u) ? 1u : 0u; mine = (j == x) ? c : mine; }
        if (sum == G) break;
        __builtin_amdgcn_s_sleep(1);
        if ((++sp & 255u) == 0u) { if (xb_ld(&bar[XB_TMO])) break; if (sp > XB_SPIN_CAP) { atomicAdd(&bar[XB_TMO], 1u); break; } }
    }
    nloc = mine > 0u ? mine : 1u; nx = cnt > 0u ? cnt : 1u;
}
__device__ __forceinline__ void xcd_barrier(const XcdBarrier& b) {
    asm volatile("s_waitcnt vmcnt(0)" ::: "memory");
    __syncthreads();
    if (threadIdx.x == 0) {
        unsigned* bar = b.bar;
        __builtin_amdgcn_s_waitcnt(0);
        unsigned nloc = b.st[0], nx = b.st[1];
        if (nloc == 0u) { xcd_barrier_complete(bar, b.x, nloc, nx); b.st[0] = nloc; b.st[1] = nx; }
        const unsigned old = xb_add(&bar[XB_XSUB(b.x)], 1u);
        const unsigned gen = old / nloc;
        if (old + 1u == (gen + 1u) * nloc) {
            __builtin_amdgcn_fence(__ATOMIC_RELEASE, "agent");
            asm volatile("s_waitcnt vmcnt(0)" ::: "memory");
            const unsigned og = xb_add(&bar[XB_TOP], 1u);
            const unsigned tg = og / nx;
            if (og + 1u == (tg + 1u) * nx) xb_add(&bar[XB_TOPGEN], 1u);
            else XB_SPIN(xb_ld(&bar[XB_TOPGEN]) == tg, bar);
            __builtin_amdgcn_fence(__ATOMIC_ACQUIRE, "agent");
            xb_add(&bar[XB_XGEN(b.x)], 1u);
            asm volatile("s_waitcnt vmcnt(0)" ::: "memory");
        } else {
            XB_SPIN(xb_ld(&bar[XB_XGEN(b.x)]) == gen, bar);
            __builtin_amdgcn_fence(__ATOMIC_ACQUIRE, "agent");
            asm volatile("s_waitcnt vmcnt(0)" ::: "memory");
        }
    }
    __syncthreads();
}

namespace pg8 {
constexpr int BM = 256, BK = 64, HALF = 128, HTB = HALF * BK * 2, STAGE_BYTES = 8 * HTB, NXCD = 8, WGM = 8;
__host__ __device__ __forceinline__ int lds_byte(int r, int c) { const int st = (r >> 4) * 2 + (c >> 5), rr = r & 15, cc = c & 31, ob = rr * 64 + cc * 2; return st * 1024 + (ob ^ (((ob >> 9) & 1) << 5)); }
__host__ __device__ __forceinline__ void stage_rc(int b, int& R, int& C) { const int st = b / 1024, sb = b % 1024, swz = sb ^ (((sb >> 9) & 1) << 5); R = (st >> 1) * 16 + swz / 64; C = (st & 1) * 32 + (swz % 64) / 2; }
__host__ __device__ __forceinline__ int perm32(int rho) { const int n = rho >> 4, i = rho & 15; return 8 * (i >> 2) + 4 * n + (i & 3); }
struct Unit { int pm, pn, e; };
__device__ __forceinline__ bool order_next(int i, int G, int c, int nM, int nN, int& pm, int& pn) {
    const int nwg = nM * nN; const long L = (long)i * G + c; if (L >= nwg) return false;
    int wgid = (int)L; { const int q = nwg / NXCD, r = nwg % NXCD, xcd = wgid % NXCD, off = wgid / NXCD; wgid = (xcd < r ? xcd * (q + 1) : r * (q + 1) + (xcd - r) * q) + off; }
    const int nig = WGM * nN, gid = wgid / nig, fm = gid * WGM, gsz = (nM - fm) < WGM ? (nM - fm) : WGM;
    pm = fm + ((wgid % nig) % gsz); pn = (wgid % nig) / gsz; return true;
}
struct DenseSched {
    static constexpr bool GATHER = false;
    int nM, nN, G, c; const unsigned char* vtab;
    __device__ __forceinline__ void init(int M, int N, int G_, int c_) { nM = M / BM; nN = N / BM; G = G_; c = c_; vtab = nullptr; }
    __device__ __forceinline__ bool next(int i, Unit& u) const { u.e = 0; return order_next(i, G, c, nM, nN, u.pm, u.pn); }
    __device__ __forceinline__ size_t b_off(const Unit& u, int RB) const { return (size_t)u.pn * BM * RB; }
};
struct GroupSched {
    static constexpr bool GATHER_ = false;
    int nM, nN, G, c, NB; const LAS unsigned short* te; const unsigned char* vtab;
    __device__ __forceinline__ bool next(int i, Unit& u) const { if (!order_next(i, G, c, nM, nN, u.pm, u.pn)) return false; u.e = __builtin_amdgcn_readfirstlane((int)te[u.pm]); return true; }
    __device__ __forceinline__ size_t b_off(const Unit& u, int RB) const { return ((size_t)u.e * NB + (size_t)u.pn * BM) * RB; }
};
struct GroupSchedG : GroupSched { static constexpr bool GATHER = true; };
struct GroupSchedD : GroupSched { static constexpr bool GATHER = false; };

template <bool F8, class Epi, class Sched>
__device__ __forceinline__ void gemm_phase(LAS unsigned char* lds, const char* A, const char* Bt, const int RB, const Sched& S, const Epi& E) {
    const int tid = threadIdx.x, wid = __builtin_amdgcn_readfirstlane(tid >> 6), lane = tid & 63, wr = wid >> 2, wc = wid & 3, fr = lane & 15, fq = lane >> 4;
    const int nt = RB / 128;
    unsigned voffB[2], cA[2]; int RA[2];
#pragma unroll
    for (int i = 0; i < 2; ++i) { int R, C; stage_rc(tid * 16 + i * 8192, R, C); const int Rb = Epi::PERM ? ((R & ~31) + perm32(R & 31)) : R;
        RA[i] = R; cA[i] = (unsigned)C * 2u; voffB[i] = (unsigned)(Rb * RB) + (unsigned)C * 2u; }
    const size_t kstep = (size_t)(BK * 2);
    const size_t hstep = (size_t)HALF * RB;
    const unsigned ldsw = (unsigned)wid * 1024u;
    const int aoff = lds_byte(wr * 64 + fr, fq * 8), boff = lds_byte(wc * 32 + fr, fq * 8);
#define PG8_SA(b, h) (((b) * 2 + (h)) * HTB)
#define PG8_SB(b, h) ((4 + (b) * 2 + (h)) * HTB)
#define PG8_STAGE(bufoff, gbase, voff) do { _Pragma("unroll") for (int _i = 0; _i < 2; ++_i) \
        __builtin_amdgcn_global_load_lds((const unsigned*)((const char*)(gbase) + (voff)[_i]), (LAS unsigned*)(lds + (bufoff) + ldsw + _i * 8192), 16, 0, 0); } while (0)
#define PG8_LDA(dst, b, h) do { _Pragma("unroll") for (int m = 0; m < 4; ++m) { dst[m].lo = *(const LAS v4i*)(lds + (b) + PG8_SA(0, h) + aoff + m * 2048); dst[m].hi = *(const LAS v4i*)(lds + (b) + PG8_SA(0, h) + aoff + m * 2048 + 1024); } } while (0)
#define PG8_LDB(dst, b, h) do { _Pragma("unroll") for (int n = 0; n < 2; ++n) { dst[n].lo = *(const LAS v4i*)(lds + (b) + PG8_SB(0, h) + boff + n * 2048); dst[n].hi = *(const LAS v4i*)(lds + (b) + PG8_SB(0, h) + boff + n * 2048 + 1024); } } while (0)
#define PG8_MMA(ai, bj, At, Bt_) do { __builtin_amdgcn_s_setprio(1); _Pragma("unroll") for (int m = 0; m < 4; ++m) _Pragma("unroll") for (int n = 0; n < 2; ++n) { \
        if constexpr (F8) acc[ai][bj][m][n] = __builtin_amdgcn_mfma_scale_f32_16x16x128_f8f6f4(Bt_[n], At[m], acc[ai][bj][m][n], 0, 0, 0, 0, 0, 0); \
        else { acc[ai][bj][m][n] = __builtin_amdgcn_mfma_f32_16x16x32_bf16(v8lo(Bt_[n]), v8lo(At[m]), acc[ai][bj][m][n], 0, 0, 0); \
               acc[ai][bj][m][n] = __builtin_amdgcn_mfma_f32_16x16x32_bf16(v8hi(Bt_[n]), v8hi(At[m]), acc[ai][bj][m][n], 0, 0, 0); } } \
        __builtin_amdgcn_s_setprio(0); } while (0)
#define PG8_WAIT_V(n) asm volatile("s_waitcnt vmcnt(" #n ")" ::: "memory")
#define PG8_WAIT_L(n) asm volatile("s_waitcnt lgkmcnt(" #n ")" ::: "memory")
#define PG8_BAR __builtin_amdgcn_s_barrier()
#define PG8_SCHED __builtin_amdgcn_sched_barrier(0)
#define PG8_DENSE_V(v, u) do { _Pragma("unroll") for (int _h = 0; _h < 2; ++_h) _Pragma("unroll") for (int _i = 0; _i < 2; ++_i) (v)[_h][_i] = (unsigned)((u).pm * BM + _h * HALF + RA[_i]) * (unsigned)RB + cA[_i]; } while (0)
    Unit cur, nxt; int ui = 0;
    if (!S.next(0, cur)) return;
    f32x4 acc[2][2][4][2];
#pragma unroll
    for (int a = 0; a < 2; ++a)
#pragma unroll
        for (int b = 0; b < 2; ++b)
#pragma unroll
            for (int m = 0; m < 4; ++m)
#pragma unroll
                for (int n = 0; n < 2; ++n) acc[a][b][m][n] = (f32x4){0.f, 0.f, 0.f, 0.f};
    v8i At[4], B0[2], B1[2];
    unsigned vc[2][2], v2[2][2];
    if constexpr (Sched::GATHER) {
        __builtin_amdgcn_global_load_lds((const unsigned*)(S.vtab + ((size_t)cur.pm * 512 + tid) * 16), (LAS unsigned*)(lds + VOFF_OFF + ldsw), 16, 0, 0);
        PG8_WAIT_V(0);
        const u32x4 tv = *(const LAS u32x4*)(lds + VOFF_OFF + tid * 16); vc[0][0] = tv.x; vc[0][1] = tv.y; vc[1][0] = tv.z; vc[1][1] = tv.w;
    } else { PG8_DENSE_V(vc, cur); }
    const char* cB = Bt + S.b_off(cur, RB);
    PG8_STAGE(PG8_SB(0, 0), cB, voffB); PG8_STAGE(PG8_SB(0, 1), cB + hstep, voffB); PG8_STAGE(PG8_SA(0, 0), A, vc[0]); PG8_STAGE(PG8_SA(0, 1), A, vc[1]);
    if (wr == 1) PG8_BAR;
    PG8_WAIT_V(2); PG8_BAR;
    PG8_STAGE(PG8_SB(1, 0), cB + kstep, voffB); PG8_STAGE(PG8_SA(1, 0), A + kstep, vc[0]); PG8_STAGE(PG8_SB(1, 1), cB + hstep + kstep, voffB);
    PG8_WAIT_V(6); PG8_BAR;
    for (;;) {
        const bool has_next = S.next(ui + 1, nxt);
        const char* nB = has_next ? Bt + S.b_off(nxt, RB) : cB;
        unsigned dlt = 0u;
        if (has_next) {
            if constexpr (Sched::GATHER) __builtin_amdgcn_global_load_lds((const unsigned*)(S.vtab + ((size_t)nxt.pm * 512 + tid) * 16), (LAS unsigned*)(lds + VOFF_OFF + ((ui + 1) & 1) * 8192 + ldsw), 16, 0, 0);
            else dlt = (unsigned)(nxt.pm - cur.pm) * (unsigned)(BM * RB);
        }
#pragma unroll
        for (int h = 0; h < 2; ++h) { v2[h][0] = vc[h][0]; v2[h][1] = vc[h][1]; }
#pragma nounroll
        for (int t = 0; t < nt; ++t) {
            const int bb = t & 1; const bool w1 = (t + 1 >= nt), w2 = (t + 2 >= nt);
            if (t == nt - 2 && has_next) {
                if constexpr (Sched::GATHER) { const u32x4 tv = *(const LAS u32x4*)(lds + VOFF_OFF + ((ui + 1) & 1) * 8192 + tid * 16); v2[0][0] = tv.x; v2[0][1] = tv.y; v2[1][0] = tv.z; v2[1][1] = tv.w; }
                else {
#pragma unroll
                    for (int h = 0; h < 2; ++h) { v2[h][0] += dlt; v2[h][1] += dlt; } }
            }
            const char* a1 = w1 ? A : A + (size_t)(t + 1) * kstep;
            const char* a2 = w2 ? A + (size_t)(t + 2 - nt) * kstep : A + (size_t)(t + 2) * kstep;
            const char* b2 = w2 ? nB + (size_t)(t + 2 - nt) * kstep : cB + (size_t)(t + 2) * kstep;
            unsigned va1[2], va2[2];
#pragma unroll
            for (int i = 0; i < 2; ++i) { va1[i] = w1 ? v2[1][i] : vc[1][i]; va2[i] = w2 ? v2[0][i] : vc[0][i]; }
            const int ob = bb * (2 * HTB), on = (bb ^ 1) * (2 * HTB);
            PG8_LDB(B0, ob, 0); PG8_LDB(B1, ob, 1); PG8_SCHED; PG8_LDA(At, ob, 0); PG8_STAGE(on + PG8_SA(0, 1), a1, va1);
            PG8_WAIT_V(8); PG8_WAIT_L(0); PG8_BAR; PG8_MMA(0, 0, At, B0); PG8_MMA(0, 1, At, B1); PG8_BAR; PG8_SCHED;
            PG8_LDA(At, ob, 1); PG8_STAGE(ob + PG8_SB(0, 0), b2, voffB); PG8_STAGE(ob + PG8_SB(0, 1), b2 + hstep, voffB); PG8_STAGE(ob + PG8_SA(0, 0), a2, va2);
            PG8_WAIT_V(8); PG8_WAIT_L(0); PG8_BAR; PG8_MMA(1, 0, At, B0); PG8_MMA(1, 1, At, B1); PG8_BAR; PG8_SCHED;
        }
        if (wr == 0) PG8_BAR;
        E(acc, cur, wr, wc, fr, fq);
        if (!has_next) break;
#pragma unroll
        for (int a = 0; a < 2; ++a)
#pragma unroll
            for (int b = 0; b < 2; ++b)
#pragma unroll
                for (int m = 0; m < 4; ++m)
#pragma unroll
                    for (int n = 0; n < 2; ++n) acc[a][b][m][n] = (f32x4){0.f, 0.f, 0.f, 0.f};
        cur = nxt; cB = nB; ++ui;
#pragma unroll
        for (int h = 0; h < 2; ++h) { vc[h][0] = v2[h][0]; vc[h][1] = v2[h][1]; }
        if (wr == 1) PG8_BAR;
    }
    PG8_WAIT_V(0);
    PG8_BAR;
#undef PG8_SA
#undef PG8_SB
#undef PG8_STAGE
#undef PG8_LDA
#undef PG8_LDB
#undef PG8_MMA
#undef PG8_WAIT_V
#undef PG8_WAIT_L
#undef PG8_BAR
#undef PG8_SCHED
#undef PG8_DENSE_V
}

typedef f32x4 Acc[2][2][4][2];
struct EpiInProj {
    static constexpr bool PERM = true;
    bf16_t* Q; const int* pos;
    __device__ __forceinline__ void operator()(const Acc& acc, const Unit& u, int wr, int wc, int fr, int fq) const {
        const int sec = u.pn >> 1, hf = u.pn & 1, row0 = u.pm * BM + wr * 64 + fr;
        if (sec >= 2) {
            bf16_t* base = Q + (size_t)sec * (size_t)(T * 512);
            const int col0 = hf * 256 + wc * 32 + 8 * fq;
#pragma unroll
            for (int ai = 0; ai < 2; ++ai)
#pragma unroll
                for (int m = 0; m < 4; ++m) { bf16_t* rowp = base + (size_t)(row0 + ai * HALF + m * 16) * 512 + col0;
#pragma unroll
                    for (int bj = 0; bj < 2; ++bj) { const f32x4 v0 = acc[ai][bj][m][0], v1 = acc[ai][bj][m][1];
                        u32x4 w; w.x = cvt_pk_bf16(v0[0], v0[1]); w.y = cvt_pk_bf16(v0[2], v0[3]); w.z = cvt_pk_bf16(v1[0], v1[1]); w.w = cvt_pk_bf16(v1[2], v1[3]);
                        *(u32x4*)(rowp + bj * HALF) = w; } }
        } else {
            bf16_t* base = Q + (size_t)sec * (size_t)(T * 512);
            const int head = hf * 4 + wc;
            const float lg = log2_gamma(head);
#pragma unroll
            for (int ai = 0; ai < 2; ++ai)
#pragma unroll
                for (int m = 0; m < 4; ++m) {
                    const int row = row0 + ai * HALF + m * 16; const float p = (float)pos[row]; const float c = (float)(row & (CH - 1));
                    const float sc = sec == 0 ? __builtin_amdgcn_exp2f(c * lg) : __builtin_amdgcn_exp2f(-c * lg) * 0.125f;
                    bf16_t* rowp = base + (size_t)row * 512 + head * 64 + 8 * fq;
#pragma unroll
                    for (int n = 0; n < 2; ++n) { float o1[4], o2[4];
#pragma unroll
                        for (int j = 0; j < 4; ++j) { const float ifr = __builtin_amdgcn_exp2f(-(float)(8 * fq + 4 * n + j) * (13.287712379549449f / 32.0f)) * 0.15915494309189535f;
                            const float rev = __builtin_amdgcn_fractf(p * ifr); const float sn = __builtin_amdgcn_sinf(rev), cs = __builtin_amdgcn_cosf(rev);
                            const float x1 = acc[ai][0][m][n][j], x2 = acc[ai][1][m][n][j];
                            o1[j] = (x1 * cs - x2 * sn) * sc; o2[j] = (x2 * cs + x1 * sn) * sc; }
                        u32x2 w; w.x = cvt_pk_bf16(o1[0], o1[1]); w.y = cvt_pk_bf16(o1[2], o1[3]); *(u32x2*)(rowp + 4 * n) = w;
                        w.x = cvt_pk_bf16(o2[0], o2[1]); w.y = cvt_pk_bf16(o2[2], o2[3]); *(u32x2*)(rowp + 32 + 4 * n) = w; }
                }
        }
    }
};
struct EpiPlainF8 {
    static constexpr bool PERM = true;
    unsigned char* O; int ldc;
    __device__ __forceinline__ void operator()(const Acc& acc, const Unit& u, int wr, int wc, int fr, int fq) const {
        const int row0 = u.pm * BM + wr * 64 + fr, col0 = u.pn * BM + wc * 32 + 8 * fq;
#pragma unroll
        for (int ai = 0; ai < 2; ++ai)
#pragma unroll
            for (int m = 0; m < 4; ++m) { unsigned char* rowp = O + (size_t)(row0 + ai * HALF + m * 16) * ldc + col0;
#pragma unroll
                for (int bj = 0; bj < 2; ++bj) { const f32x4 v0 = acc[ai][bj][m][0], v1 = acc[ai][bj][m][1];
                    u32x2 w; w.x = cvt4_fp8(v0[0], v0[1], v0[2], v0[3]); w.y = cvt4_fp8(v1[0], v1[1], v1[2], v1[3]);
                    *(u32x2*)(rowp + bj * HALF) = w; } }
    }
};
struct EpiWout {
    static constexpr bool PERM = true;
    const float* x; bf16_t* h1b; unsigned char* h1f8; float* ssq;
    __device__ __forceinline__ void operator()(const Acc& acc, const Unit& u, int wr, int wc, int fr, int fq) const {
        const int row0 = u.pm * BM + wr * 64 + fr, col0 = u.pn * BM + wc * 32 + 8 * fq;
#pragma unroll
        for (int ai = 0; ai < 2; ++ai)
#pragma unroll
            for (int m = 0; m < 4; ++m) { const int row = row0 + ai * HALF + m * 16; const size_t off = (size_t)row * D + col0; float s = 0.f;
#pragma unroll
                for (int bj = 0; bj < 2; ++bj) { const f32x4 x0 = *(const f32x4*)(x + off + bj * HALF), x1 = *(const f32x4*)(x + off + bj * HALF + 4);
                    const f32x4 h0 = acc[ai][bj][m][0] + x0, h1 = acc[ai][bj][m][1] + x1;
                    s += (h0[0] * h0[0] + h0[1] * h0[1]) + (h0[2] * h0[2] + h0[3] * h0[3]) + (h1[0] * h1[0] + h1[1] * h1[1]) + (h1[2] * h1[2] + h1[3] * h1[3]);
                    u32x4 w; w.x = cvt_pk_bf16(h0[0], h0[1]); w.y = cvt_pk_bf16(h0[2], h0[3]); w.z = cvt_pk_bf16(h1[0], h1[1]); w.w = cvt_pk_bf16(h1[2], h1[3]);
                    *(u32x4*)(h1b + off + bj * HALF) = w;
                    u32x2 q; q.x = cvt4_fp8(h0[0], h0[1], h0[2], h0[3]); q.y = cvt4_fp8(h1[0], h1[1], h1[2], h1[3]);
                    *(u32x2*)(h1f8 + off + bj * HALF) = q; }
                s += __shfl_xor(s, 16); s += __shfl_xor(s, 32);
                if (fq == 0) ssq[(size_t)row * 16 + u.pn * 4 + wc] = s;
                if (m & 1) asm volatile("" ::: "memory"); }
    }
};
struct EpiGateUp {
    static constexpr bool PERM = true;
    unsigned char* act; const float* bgu; const float* sr;
    __device__ __forceinline__ void operator()(const Acc& acc, const Unit& u, int wr, int wc, int fr, int fq) const {
        const int prow0 = u.pm * BM + wr * 64 + fr, acol = u.pn * 128 + wc * 32 + 8 * fq;
        const float* bp = bgu + (size_t)u.e * (2 * DE) + 2 * acol;
        f32x4 b4[4];
#pragma unroll
        for (int q = 0; q < 4; ++q) b4[q] = *(const f32x4*)(bp + 4 * q);
#pragma unroll
        for (int ai = 0; ai < 2; ++ai)
#pragma unroll
            for (int m = 0; m < 4; ++m) { const int prow = prow0 + ai * HALF + m * 16; const float r = sr[prow] * (MOE_F8 ? 0.03125f : 1.0f); float o[8];
#pragma unroll
                for (int q = 0; q < 8; ++q) { float g = r * acc[ai][0][m][q >> 2][q & 3] + b4[q >> 1][(q & 1) * 2], up = r * acc[ai][1][m][q >> 2][q & 3] + b4[q >> 1][(q & 1) * 2 + 1];
                    g = fminf(g, 7.0f); up = fminf(fmaxf(up, -7.0f), 7.0f); o[q] = (up + 1.0f) * g * sigmoidf_fast(1.702f * g); }
                if (MOE_F8) { u32x2 w; w.x = cvt4_fp8(o[0], o[1], o[2], o[3]); w.y = cvt4_fp8(o[4], o[5], o[6], o[7]); *(u32x2*)(act + (size_t)prow * DE + acol) = w; }
                else { u32x4 w; w.x = cvt_pk_bf16(o[0], o[1]); w.y = cvt_pk_bf16(o[2], o[3]); w.z = cvt_pk_bf16(o[4], o[5]); w.w = cvt_pk_bf16(o[6], o[7]); *(u32x4*)(act + ((size_t)prow * DE + acol) * 2) = w; } }
    }
};
struct EpiDown {
    static constexpr bool PERM = true;
    unsigned char* y; const float* bd; const float* sg;
    __device__ __forceinline__ void operator()(const Acc& acc, const Unit& u, int wr, int wc, int fr, int fq) const {
        const int prow0 = u.pm * BM + wr * 64 + fr, col0 = u.pn * BM + wc * 32 + 8 * fq;
        const float* bp = bd + (size_t)u.e * D + col0;
        f32x4 bv[2][2];
#pragma unroll
        for (int bj = 0; bj < 2; ++bj)
#pragma unroll
            for (int n = 0; n < 2; ++n) bv[bj][n] = *(const f32x4*)(bp + bj * HALF + 4 * n);
#pragma unroll
        for (int ai = 0; ai < 2; ++ai)
#pragma unroll
            for (int m = 0; m < 4; ++m) { const int prow = prow0 + ai * HALF + m * 16; const float gw = sg[prow] * 16.0f; unsigned char* rowp = y + (size_t)prow * D + col0;
#pragma unroll
                for (int bj = 0; bj < 2; ++bj) { const f32x4 v0 = (acc[ai][bj][m][0] * (MOE_F8 ? 0.03125f : 1.0f) + bv[bj][0]) * gw, v1 = (acc[ai][bj][m][1] * (MOE_F8 ? 0.03125f : 1.0f) + bv[bj][1]) * gw;
                    u32x2 w; w.x = cvt4_fp8(v0[0], v0[1], v0[2], v0[3]); w.y = cvt4_fp8(v1[0], v1[1], v1[2], v1[3]);
                    *(u32x2*)(rowp + bj * HALF) = w; } }
    }
};
struct EpiPle {
    static constexpr bool PERM = true;
    bf16_t* h3; const bf16_t* h2b; const unsigned char* pp; const float* rstd2;
    __device__ __forceinline__ void operator()(const Acc& acc, const Unit& u, int wr, int wc, int fr, int fq) const {
        const int row0 = u.pm * BM + wr * 64 + fr, col0 = u.pn * BM + wc * 32 + 8 * fq;
#pragma unroll
        for (int ai = 0; ai < 2; ++ai)
#pragma unroll
            for (int m = 0; m < 4; ++m) { const int row = row0 + ai * HALF + m * 16; const float r = rstd2[row] * 0.03125f; const size_t off = (size_t)row * D + col0;
#pragma unroll
                for (int bj = 0; bj < 2; ++bj) { const u32x2 pw = *(const u32x2*)(pp + off + bj * HALF); const u32x4 hw = *(const u32x4*)(h2b + off + bj * HALF);
                    float p[8]; fp8x4_to_f32(pw.x, p[0], p[1], p[2], p[3]); fp8x4_to_f32(pw.y, p[4], p[5], p[6], p[7]);
                    const f32x4 a0 = acc[ai][bj][m][0] * r, a1 = acc[ai][bj][m][1] * r; float o[8];
                    o[0] = bf_lo(hw.x) + sigmoidf_fast(a0[0]) * p[0]; o[1] = bf_hi(hw.x) + sigmoidf_fast(a0[1]) * p[1]; o[2] = bf_lo(hw.y) + sigmoidf_fast(a0[2]) * p[2]; o[3] = bf_hi(hw.y) + sigmoidf_fast(a0[3]) * p[3];
                    o[4] = bf_lo(hw.z) + sigmoidf_fast(a1[0]) * p[4]; o[5] = bf_hi(hw.z) + sigmoidf_fast(a1[1]) * p[5]; o[6] = bf_lo(hw.w) + sigmoidf_fast(a1[2]) * p[6]; o[7] = bf_hi(hw.w) + sigmoidf_fast(a1[3]) * p[7];
                    u32x4 w; w.x = cvt_pk_bf16(o[0], o[1]); w.y = cvt_pk_bf16(o[2], o[3]); w.z = cvt_pk_bf16(o[4], o[5]); w.w = cvt_pk_bf16(o[6], o[7]);
                    *(u32x4*)(h3 + off + bj * HALF) = w; }
                if (m & 1) asm volatile("" ::: "memory"); }
    }
};
}

struct Args { const void* in[20]; float* out; unsigned char* ws; int ph_lo, ph_hi; };
enum { I_X = 0, I_P, I_POS, I_WIN, I_WOUT, I_GNW, I_POOLW, I_POOLS, I_NMIX, I_NMOE, I_RW, I_RB, I_WGU, I_BGU, I_WD, I_BD, I_NPLE, I_WG, I_WP, I_NFIN };
constexpr int NPH = 13;

enum { WK_PLAIN = 0, WK_WIN = 1, WK_GU = 2 };
template <int KIND> __device__ __forceinline__ int dst_row(int c) {
    if (KIND == WK_WIN) { if (c < 1024) { const int sec = c >> 9, within = c & 511, head = within >> 6, d = within & 63; return (sec * 2 + (head >> 2)) * 256 + (d >> 5) * 128 + (head & 3) * 32 + (d & 31); } return c; }
    if (KIND == WK_GU) { const int a = c >> 1; return (a >> 7) * 256 + (c & 1) * 128 + (a & 127); }
    return c;
}
template <int KIND, bool OUT8> __device__ __forceinline__ void tr_item(const float* W, int K, int N, void* WT, LAS float* scr, int kb, int cb, int lane, const float* ks, float mul) {
    const int k0 = 64 * kb, c0 = 64 * cb; const bool ok = (c0 + lane) < N;
    const float* src = W + (size_t)k0 * N + c0 + lane;
#pragma unroll 16
    for (int kk = 0; kk < 64; ++kk) scr[kk * 65 + lane] = ok ? src[(size_t)kk * N] : 0.f;
    const int c = lane & 7;
    f32x4 s0 = {mul, mul, mul, mul}, s1 = s0;
    if (ks) { s0 = *(const f32x4*)(ks + k0 + 8 * c) * mul; s1 = *(const f32x4*)(ks + k0 + 8 * c + 4) * mul; }
    LDS_WAIT(); asm volatile("" ::: "memory");
#pragma unroll
    for (int w = 0; w < 8; ++w) { const int r = (lane >> 3) + 8 * w; const LAS float* s = scr + (8 * c) * 65 + r;
        const float v0 = s[0 * 65] * s0[0], v1 = s[1 * 65] * s0[1], v2 = s[2 * 65] * s0[2], v3 = s[3 * 65] * s0[3], v4 = s[4 * 65] * s1[0], v5 = s[5 * 65] * s1[1], v6 = s[6 * 65] * s1[2], v7 = s[7 * 65] * s1[3];
        if (OUT8) { u32x2 o; o.x = cvt4_fp8(v0, v1, v2, v3); o.y = cvt4_fp8(v4, v5, v6, v7);
            if (c0 + r < N) *(u32x2*)((unsigned char*)WT + (size_t)dst_row<KIND>(c0 + r) * K + k0 + 8 * c) = o; }
        else { u32x4 o; o.x = cvt_pk_bf16(v0, v1); o.y = cvt_pk_bf16(v2, v3); o.z = cvt_pk_bf16(v4, v5); o.w = cvt_pk_bf16(v6, v7);
            if (c0 + r < N) *(u32x4*)((bf16_t*)WT + (size_t)dst_row<KIND>(c0 + r) * K + k0 + 8 * c) = o; } }
    LDS_WAIT(); asm volatile("" ::: "memory");
}
__device__ __forceinline__ void phase_prologue(const Args& a, LAS unsigned char* lds, int vcu, int G) {
    const int tid = threadIdx.x, lane = tid & 63, wave = __builtin_amdgcn_readfirstlane(tid >> 6);
    LAS float* scr = (LAS float*)(lds + wave * 16640);
    const int gw = vcu * 8 + wave, NGW = G * 8;
    unsigned char* ws = a.ws;
    constexpr int I_GU = NE * 16 * 32, I_DN = NE * 16 * 16, I_WINI = 16 * 40, I_SQ = 16 * 16, I_WPI = 4 * 16, I_RT = 16, I_PW = 4 * 4;
    constexpr int NITEMS = I_GU + I_DN + I_WINI + 2 * I_SQ + I_WPI + I_RT + I_PW;
    for (int it = gw; it < NITEMS; it += NGW) {
        int r = it;
        if (r < I_GU) { const int e = r / 512, q = r % 512; tr_item<WK_GU, MOE_F8 != 0>((const float*)a.in[I_WGU] + (size_t)e * D * 2 * DE, D, 2 * DE, ws + WS_WGU + (size_t)e * 2 * DE * D * (MOE_F8 ? 1 : 2), scr, q / 32, q % 32, lane, (const float*)a.in[I_NMOE], MOE_F8 ? 32.0f : 1.0f); continue; } r -= I_GU;
        if (r < I_DN) { const int e = r / 256, q = r % 256; tr_item<WK_PLAIN, MOE_F8 != 0>((const float*)a.in[I_WD] + (size_t)e * DE * D, DE, D, ws + WS_WD + (size_t)e * D * DE * (MOE_F8 ? 1 : 2), scr, q / 16, q % 16, lane, nullptr, MOE_F8 ? 32.0f : 1.0f); continue; } r -= I_DN;
        if (r < I_WINI) { tr_item<WK_WIN, false>((const float*)a.in[I_WIN], D, NIN, ws + WS_WIN, scr, r / 40, r % 40, lane, nullptr, 1.0f); continue; } r -= I_WINI;
        if (r < I_SQ) { tr_item<WK_PLAIN, false>((const float*)a.in[I_WOUT], D, D, ws + WS_WOUT, scr, r / 16, r % 16, lane, nullptr, 1.0f); continue; } r -= I_SQ;
        if (r < I_SQ) { tr_item<WK_PLAIN, true>((const float*)a.in[I_WG], D, D, ws + WS_WG, scr, r / 16, r % 16, lane, (const float*)a.in[I_NPLE], 32.0f); continue; } r -= I_SQ;
        if (r < I_WPI) { tr_item<WK_PLAIN, false>((const float*)a.in[I_WP], PLE, D, ws + WS_WPT, scr, r / 16, r % 16, lane, nullptr, 1.0f); continue; } r -= I_WPI;
        if (r < I_RT) { tr_item<WK_PLAIN, false>((const float*)a.in[I_RW], D, NE, ws + WS_ROUT, scr, r, 0, lane, (const float*)a.in[I_NMOE], 1.0f); continue; } r -= I_RT;
        { const int g = r / 4, q = r % 4; tr_item<WK_PLAIN, false>((const float*)a.in[I_POOLW] + (size_t)g * 128 * 128, 128, 128, ws + WS_PWT + (size_t)g * 128 * 128 * 2, scr, q / 2, q % 2, lane, nullptr, 1.0f); }
    }
    const float* x = (const float*)a.in[I_X]; const float* nw = (const float*)a.in[I_NMIX]; bf16_t* hn = (bf16_t*)(ws + WS_HN1);
    f32x4 wv[4];
#pragma unroll
    for (int j = 0; j < 4; ++j) wv[j] = *((const f32x4*)nw + lane + 64 * j);
    for (int m = gw; m < T; m += NGW) {
        const f32x4* xr = (const f32x4*)(x + (size_t)m * D) + lane; f32x4 v[4]; float s = 0.f;
#pragma unroll
        for (int j = 0; j < 4; ++j) { v[j] = xr[64 * j]; s += (v[j][0] * v[j][0] + v[j][1] * v[j][1]) + (v[j][2] * v[j][2] + v[j][3] * v[j][3]); }
        const float rstd = __builtin_amdgcn_rsqf(wave_sum(s) * (1.f / D) + NORM_EPS);
        u32x2* o8 = (u32x2*)(hn + (size_t)m * D) + lane;
#pragma unroll
        for (int j = 0; j < 4; ++j) { const f32x4 y = v[j] * rstd * wv[j]; u32x2 w; w.x = cvt_pk_bf16(y[0], y[1]); w.y = cvt_pk_bf16(y[2], y[3]); o8[64 * j] = w; }
    }
    const f32x4* pv = (const f32x4*)a.in[I_P]; u32x2* pb = (u32x2*)(ws + WS_PB);
    for (size_t i = (size_t)vcu * 512 + tid; i < (size_t)T * PLE / 4; i += (size_t)G * 512) { const f32x4 v = pv[i]; u32x2 w; w.x = cvt_pk_bf16(v[0], v[1]); w.y = cvt_pk_bf16(v[2], v[3]); pb[i] = w; }
}

__device__ __forceinline__ int tt_off(int d, int m) { return d * 136 + ((((m >> 3) ^ ((d >> 3) & 7)) << 3) | (m & 7)); }
__device__ __forceinline__ void tt_write8(LAS bf16_t* base, int d0, int m, const u32x4 v) {
    const int blk = (((m >> 3) ^ ((d0 >> 3) & 7)) << 3) | (m & 7); LAS bf16_t* p = base + d0 * 136 + blk;
    p[0 * 136] = (bf16_t)(v.x & 0xffff); p[1 * 136] = (bf16_t)(v.x >> 16); p[2 * 136] = (bf16_t)(v.y & 0xffff); p[3 * 136] = (bf16_t)(v.y >> 16);
    p[4 * 136] = (bf16_t)(v.z & 0xffff); p[5 * 136] = (bf16_t)(v.z >> 16); p[6 * 136] = (bf16_t)(v.w & 0xffff); p[7 * 136] = (bf16_t)(v.w >> 16);
}
__device__ __forceinline__ void phase_kv(const Args& a, LAS unsigned char* lds, int G) {
    const int tid = threadIdx.x, lane = tid & 63, w = __builtin_amdgcn_readfirstlane(tid >> 6), fr = lane & 15, fq = lane >> 4;
    const bf16_t* Kb = (const bf16_t*)(a.ws + WS_K); const bf16_t* Vb = (const bf16_t*)(a.ws + WS_V); float* KV = (float*)(a.ws + WS_KV);
    const int seg = tid & 7, r0 = tid >> 3;
    u32x4 rk[2], rv[2];
    int u = blockIdx.x;
#define KV_LOAD(uu) do { const size_t tok0 = (size_t)((uu) >> 3) * CH; const int hc = ((uu) & 7) * HD; _Pragma("unroll") for (int i = 0; i < 2; ++i) { const size_t o = (tok0 + r0 + 64 * i) * 512 + hc + seg * 8; rk[i] = *(const u32x4*)(Kb + o); rv[i] = *(const u32x4*)(Vb + o); } } while (0)
    if (u < 2048) KV_LOAD(u);
    for (int buf = 0; u < 2048; u += G, buf ^= 1) {
        LAS bf16_t* KT = (LAS bf16_t*)(lds + buf * 34816); LAS bf16_t* VT = KT + 64 * 136;
#pragma unroll
        for (int i = 0; i < 2; ++i) { tt_write8(KT, seg * 8, r0 + 64 * i, rk[i]); tt_write8(VT, seg * 8, r0 + 64 * i, rv[i]); }
        __syncthreads();
        if (u + G < 2048) KV_LOAD(u + G);
        const int dt = w & 3; const float sc = __builtin_amdgcn_exp2f(127.0f * log2_gamma(u & 7));
#pragma unroll
        for (int q = 0; q < 2; ++q) { const int et = (w >> 2) * 2 + q; f32x4 acc = {0.f, 0.f, 0.f, 0.f};
#pragma unroll
            for (int ks = 0; ks < 4; ++ks) { const int d = 16 * dt + fr, e = 16 * et + fr, m0 = 32 * ks + 8 * fq;
                const bf16x8 A = *(const LAS bf16x8*)(KT + tt_off(d, m0)); const bf16x8 B = *(const LAS bf16x8*)(VT + tt_off(e, m0));
                acc = __builtin_amdgcn_mfma_f32_16x16x32_bf16(A, B, acc, 0, 0, 0); }
            *(f32x4*)(KV + (size_t)u * 4096 + (16 * et + fr) * 64 + 16 * dt + 4 * fq) = acc * sc; }
    }
#undef KV_LOAD
    __syncthreads();
}
__device__ __forceinline__ void phase_pool(const Args& a, LAS unsigned char* lds, int G) {
    const int tid = threadIdx.x, lane = tid & 63, w = __builtin_amdgcn_readfirstlane(tid >> 6), fr = lane & 15, fq = lane >> 4;
    const bf16_t* U = (const bf16_t*)(a.ws + WS_U); const bf16_t* PWt = (const bf16_t*)(a.ws + WS_PWT); bf16_t* MIX = (bf16_t*)(a.ws + WS_MIX);
    const float* pscale = (const float*)a.in[I_POOLS];
    LAS bf16_t* UB = (LAS bf16_t*)lds; LAS bf16_t* PA = (LAS bf16_t*)(lds + 38912); LAS bf16_t* PW = (LAS bf16_t*)(lds + 73728);
    int gl = -1;
    for (int u = blockIdx.x; u < (T / 128) * 4; u += G) {
        const int g = u & 3, t0 = (u >> 2) * 128;
        if (g != gl) { gl = g;
#pragma unroll
            for (int i = 0; i < 4; ++i) { const int p = tid + 512 * i, d = p >> 4, sg = p & 15; *(LAS u32x4*)(PW + d * 136 + sg * 8) = *(const u32x4*)(PWt + ((size_t)g * 128 + d) * 128 + sg * 8); } }
        const bool seq0 = (t0 & (SEQ - 1)) == 0;
#pragma unroll
        for (int i = 0; i < 5; ++i) { const int p = tid + 512 * i, lr = p >> 4, sg = p & 15;
            if (lr < 143) { u32x4 v = {0u, 0u, 0u, 0u}; if (lr >= 15 || !seq0) v = *(const u32x4*)(U + (size_t)(t0 - 15 + lr) * 512 + g * 128 + sg * 8); *(LAS u32x4*)(UB + lr * 136 + sg * 8) = v; } }
        __syncthreads();
        { const int cg = tid & 15, rg = tid >> 4, wnd = 2 << g;
#pragma unroll
          for (int q = 0; q < 4; ++q) { const int r = 4 * rg + q; const int s = (t0 + r) & (SEQ - 1); const float inv = 1.0f / (float)((s + 1) < wnd ? (s + 1) : wnd);
              float sum[8];
#pragma unroll
              for (int j = 0; j < 8; ++j) sum[j] = 0.f;
              for (int k = 0; k < wnd; ++k) { const u32x4 v = *(const LAS u32x4*)(UB + (r + 15 - k) * 136 + cg * 8);
                  sum[0] += bf_lo(v.x); sum[1] += bf_hi(v.x); sum[2] += bf_lo(v.y); sum[3] += bf_hi(v.y); sum[4] += bf_lo(v.z); sum[5] += bf_hi(v.z); sum[6] += bf_lo(v.w); sum[7] += bf_hi(v.w); }
              const u32x4 c = *(const LAS u32x4*)(UB + (r + 15) * 136 + cg * 8);
              u32x4 o; o.x = cvt_pk_bf16(sum[0] * inv - bf_lo(c.x), sum[1] * inv - bf_hi(c.x)); o.y = cvt_pk_bf16(sum[2] * inv - bf_lo(c.y), sum[3] * inv - bf_hi(c.y));
              o.z = cvt_pk_bf16(sum[4] * inv - bf_lo(c.z), sum[5] * inv - bf_hi(c.z)); o.w = cvt_pk_bf16(sum[6] * inv - bf_lo(c.w), sum[7] * inv - bf_hi(c.w));
              *(LAS u32x4*)(PA + r * 136 + cg * 8) = o; } }
        __syncthreads();
        f32x4 acc[8];
#pragma unroll
        for (int dt = 0; dt < 8; ++dt) acc[dt] = (f32x4){0.f, 0.f, 0.f, 0.f};
#pragma unroll
        for (int kk = 0; kk < 4; ++kk) { const bf16x8 B = *(const LAS bf16x8*)(PA + (16 * w + fr) * 136 + 32 * kk + 8 * fq);
#pragma unroll
            for (int dt = 0; dt < 8; ++dt) { const bf16x8 A = *(const LAS bf16x8*)(PW + (16 * dt + fr) * 136 + 32 * kk + 8 * fq); acc[dt] = __builtin_amdgcn_mfma_f32_16x16x32_bf16(A, B, acc[dt], 0, 0, 0); } }
        const size_t tok = (size_t)t0 + 16 * w + fr;
#pragma unroll
        for (int dt = 0; dt < 8; ++dt) { const int d = 16 * dt + 4 * fq; const f32x4 sc = *(const f32x4*)(pscale + g * 128 + d); const f32x4 o = acc[dt] * sc;
            u32x2 wv; wv.x = cvt_pk_bf16(o[0], o[1]); wv.y = cvt_pk_bf16(o[2], o[3]); *(u32x2*)(MIX + tok * D + 512 + g * 128 + d) = wv; }
        __syncthreads();
    }
}
__device__ __forceinline__ void phase_scan(const Args& a, int G) {
    const float* KV = (const float*)(a.ws + WS_KV); bf16_t* ST = (bf16_t*)(a.ws + WS_ST);
    for (int v = blockIdx.x * 512 + threadIdx.x; v < NBATCH * NH * 1024; v += G * 512) {
        const int bh = v >> 10, q = v & 1023, b = bh >> 3, h = bh & 7;
        const float lg = log2_gamma(h), gam = __builtin_amdgcn_exp2f(lg), cd = __builtin_amdgcn_exp2f(128.0f * lg);
        f32x4 s = {0.f, 0.f, 0.f, 0.f};
        for (int n0 = 0; n0 < NCH; n0 += 8) { f32x4 kv[8];
#pragma unroll
            for (int j = 0; j < 8; ++j) kv[j] = *(const f32x4*)(KV + ((size_t)((b * NCH + n0 + j) * NH + h)) * 4096 + q * 4);
#pragma unroll
            for (int j = 0; j < 8; ++j) { const f32x4 o = s * gam; u32x2 wv; wv.x = cvt_pk_bf16(o[0], o[1]); wv.y = cvt_pk_bf16(o[2], o[3]);
                *(u32x2*)(ST + ((size_t)((b * NCH + n0 + j) * NH + h)) * 4096 + q * 4) = wv; s = s * cd + kv[j]; } }
    }
}
__device__ __forceinline__ void phase_ret(const Args& a, LAS unsigned char* lds, int G) {
    const int tid = threadIdx.x, lane = tid & 63, w = __builtin_amdgcn_readfirstlane(tid >> 6), fr = lane & 15, fq = lane >> 4;
    const bf16_t* Qb = (const bf16_t*)(a.ws + WS_Q); const bf16_t* Kb = (const bf16_t*)(a.ws + WS_K); const bf16_t* Vb = (const bf16_t*)(a.ws + WS_V);
    const bf16_t* Gb = (const bf16_t*)(a.ws + WS_G); const bf16_t* STg = (const bf16_t*)(a.ws + WS_ST); bf16_t* MIX = (bf16_t*)(a.ws + WS_MIX);
    const float* gnw = (const float*)a.in[I_GNW];
    const int seg = tid & 7, r0 = tid >> 3;
    u32x4 rk[2], rv[2], rs;
    int u = blockIdx.x;
#define RT_LOAD(uu) do { const size_t tok0 = (size_t)((uu) >> 3) * CH; const int hc = ((uu) & 7) * HD; _Pragma("unroll") for (int i = 0; i < 2; ++i) { const size_t o = (tok0 + r0 + 64 * i) * 512 + hc + seg * 8; rk[i] = *(const u32x4*)(Kb + o); rv[i] = *(const u32x4*)(Vb + o); } \
        rs = *(const u32x4*)(STg + (size_t)(uu) * 4096 + r0 * 64 + seg * 8); } while (0)
    if (u < 2048) RT_LOAD(u);
    for (int buf = 0; u < 2048; u += G, buf ^= 1) {
        LAS bf16_t* Kr = (LAS bf16_t*)(lds + buf * 45056); LAS bf16_t* VT = Kr + 128 * 72; LAS bf16_t* SL = VT + 64 * 136;
#pragma unroll
        for (int i = 0; i < 2; ++i) { *(LAS u32x4*)(Kr + (r0 + 64 * i) * 72 + seg * 8) = rk[i]; tt_write8(VT, seg * 8, r0 + 64 * i, rv[i]); }
        *(LAS u32x4*)(SL + r0 * 72 + seg * 8) = rs;
        __syncthreads();
        if (u + G < 2048) RT_LOAD(u + G);
        const size_t tok0 = (size_t)(u >> 3) * CH; const int hc = (u & 7) * HD; const size_t ctok = tok0 + 16 * w + fr;
        bf16x8 qf[2];
#pragma unroll
        for (int kk = 0; kk < 2; ++kk) qf[kk] = *(const bf16x8*)(Qb + ctok * 512 + hc + 32 * kk + 8 * fq);
        u32x2 pk[8];
#pragma unroll
        for (int am = 0; am < 8; ++am) {
            if (am <= w) { f32x4 s = {0.f, 0.f, 0.f, 0.f};
#pragma unroll
                for (int kk = 0; kk < 2; ++kk) { const bf16x8 A = *(const LAS bf16x8*)(Kr + (16 * am + fr) * 72 + 32 * kk + 8 * fq); s = __builtin_amdgcn_mfma_f32_16x16x32_bf16(A, qf[kk], s, 0, 0, 0); }
                if (am == w) {
#pragma unroll
                    for (int j = 0; j < 4; ++j) if (4 * fq + j > fr) s[j] = 0.f; }
                pk[am].x = cvt_pk_bf16(s[0], s[1]); pk[am].y = cvt_pk_bf16(s[2], s[3]);
            } else { pk[am].x = 0u; pk[am].y = 0u; } }
        f32x4 y[4];
#pragma unroll
        for (int et = 0; et < 4; ++et) y[et] = (f32x4){0.f, 0.f, 0.f, 0.f};
#pragma unroll
        for (int s2 = 0; s2 < 4; ++s2) {
            if (2 * s2 <= w) { u32x4 bw; bw.x = pk[2 * s2].x; bw.y = pk[2 * s2].y; bw.z = pk[2 * s2 + 1].x; bw.w = pk[2 * s2 + 1].y; const bf16x8 B = __builtin_bit_cast(bf16x8, bw);
#pragma unroll
                for (int et = 0; et < 4; ++et) { const int e = 16 * et + fr, es = (e >> 3) & 7;
                    const u32x2 lo = *(const LAS u32x2*)(VT + e * 136 + (((4 * s2 + (fq >> 1)) ^ es) << 3) + 4 * (fq & 1));
                    const u32x2 hi = *(const LAS u32x2*)(VT + e * 136 + (((4 * s2 + 2 + (fq >> 1)) ^ es) << 3) + 4 * (fq & 1));
                    u32x4 aw; aw.x = lo.x; aw.y = lo.y; aw.z = hi.x; aw.w = hi.y;
                    y[et] = __builtin_amdgcn_mfma_f32_16x16x32_bf16(__builtin_bit_cast(bf16x8, aw), B, y[et], 0, 0, 0); } } }
#pragma unroll
        for (int kk = 0; kk < 2; ++kk)
#pragma unroll
            for (int et = 0; et < 4; ++et) { const bf16x8 A = *(const LAS bf16x8*)(SL + (16 * et + fr) * 72 + 32 * kk + 8 * fq); y[et] = __builtin_amdgcn_mfma_f32_16x16x32_bf16(A, qf[kk], y[et], 0, 0, 0); }
        float s = 0.f;
#pragma unroll
        for (int et = 0; et < 4; ++et) s += (y[et][0] + y[et][1]) + (y[et][2] + y[et][3]);
        s += __shfl_xor(s, 16); s += __shfl_xor(s, 32);
        const float mean = s * (1.0f / 64.0f); float q2 = 0.f;
#pragma unroll
        for (int et = 0; et < 4; ++et) { const f32x4 d = y[et] - mean; q2 += (d[0] * d[0] + d[1] * d[1]) + (d[2] * d[2] + d[3] * d[3]); }
        q2 += __shfl_xor(q2, 16); q2 += __shfl_xor(q2, 32);
        const float rstd = __builtin_amdgcn_rsqf(q2 * (1.0f / 64.0f) + GN_EPS);
#pragma unroll
        for (int et = 0; et < 4; ++et) { const int col = hc + 16 * et + 4 * fq; const u32x2 gv = *(const u32x2*)(Gb + ctok * 512 + col); const f32x4 gw = *(const f32x4*)(gnw + col);
            const float g0 = bf_lo(gv.x), g1 = bf_hi(gv.x), g2 = bf_lo(gv.y), g3 = bf_hi(gv.y);
            const float o0 = (y[et][0] - mean) * rstd * gw[0] * g0 * sigmoidf_fast(g0), o1 = (y[et][1] - mean) * rstd * gw[1] * g1 * sigmoidf_fast(g1);
            const float o2 = (y[et][2] - mean) * rstd * gw[2] * g2 * sigmoidf_fast(g2), o3 = (y[et][3] - mean) * rstd * gw[3] * g3 * sigmoidf_fast(g3);
            u32x2 wv; wv.x = cvt_pk_bf16(o0, o1); wv.y = cvt_pk_bf16(o2, o3); *(u32x2*)(MIX + ctok * D + col) = wv; }
    }
#undef RT_LOAD
    __syncthreads();
}

__device__ __forceinline__ void phase_router(const Args& a, LAS unsigned char* lds, int G) {
    const int tid = threadIdx.x, lane = tid & 63, w = __builtin_amdgcn_readfirstlane(tid >> 6), fr = lane & 15, fq = lane >> 4;
    const bf16_t* RT = (const bf16_t*)(a.ws + WS_ROUT); const bf16_t* H1W = (const bf16_t*)(a.ws + WS_HN1); const float* ssq = (const float*)(a.ws + WS_SSQ1);
    const float* rb = (const float*)a.in[I_RB];
    int* topi = (int*)(a.ws + WS_TOPI); float* topg = (float*)(a.ws + WS_TOPG); float* rstd1 = (float*)(a.ws + WS_RSTD1); int* bh = (int*)(a.ws + WS_BH);
    LAS bf16_t* RL = (LAS bf16_t*)lds;
    LAS float* LG = (LAS float*)(lds + 66048) + w * (16 * 33);
    LAS int* hist = (LAS int*)(lds + 66048 + 8 * 16 * 33 * 4);
#pragma unroll
    for (int i = 0; i < 8; ++i) { const int p = tid + 512 * i, e = p >> 7, sg = p & 127; *(LAS u32x4*)(RL + e * 1032 + sg * 8) = *(const u32x4*)(RT + (size_t)e * D + sg * 8); }
    for (int tb = blockIdx.x; tb < T / 128; tb += G) {
        if (tid < 32) hist[tid] = 0;
        __syncthreads();
        const size_t t0 = (size_t)tb * 128 + 16 * w;
        f32x4 acc0 = {0.f, 0.f, 0.f, 0.f}, acc1 = {0.f, 0.f, 0.f, 0.f};
#pragma unroll 8
        for (int kk = 0; kk < 32; ++kk) { const bf16x8 B = *(const bf16x8*)(H1W + (t0 + fr) * D + 32 * kk + 8 * fq);
            const bf16x8 A0 = *(const LAS bf16x8*)(RL + fr * 1032 + 32 * kk + 8 * fq), A1 = *(const LAS bf16x8*)(RL + (16 + fr) * 1032 + 32 * kk + 8 * fq);
            acc0 = __builtin_amdgcn_mfma_f32_16x16x32_bf16(A0, B, acc0, 0, 0, 0); acc1 = __builtin_amdgcn_mfma_f32_16x16x32_bf16(A1, B, acc1, 0, 0, 0); }
#pragma unroll
        for (int j = 0; j < 4; ++j) { LG[fr * 33 + 4 * fq + j] = acc0[j]; LG[fr * 33 + 16 + 4 * fq + j] = acc1[j]; }
        LDS_WAIT(); asm volatile("" ::: "memory");
        if (lane < 16) {
            const size_t t = t0 + lane; float sq = 0.f;
#pragma unroll
            for (int q = 0; q < 4; ++q) { const f32x4 v = *(const f32x4*)(ssq + t * 16 + 4 * q); sq += (v[0] + v[1]) + (v[2] + v[3]); }
            const float rstd = __builtin_amdgcn_rsqf(sq * (1.f / D) + NORM_EPS);
            float v0 = -3.0e38f, v1 = -3.0e38f, v2 = -3.0e38f, v3 = -3.0e38f; int i0 = 0, i1 = 0, i2 = 0, i3 = 0;
#pragma unroll
            for (int e = 0; e < NE; ++e) { const float v = LG[lane * 33 + e] * rstd + rb[e];
                if (v > v3) { if (v > v2) { v3 = v2; i3 = i2; if (v > v1) { v2 = v1; i2 = i1; if (v > v0) { v1 = v0; i1 = i0; v0 = v; i0 = e; } else { v1 = v; i1 = e; } } else { v2 = v; i2 = e; } } else { v3 = v; i3 = e; } } }
            const float e1 = __expf(v1 - v0), e2 = __expf(v2 - v0), e3 = __expf(v3 - v0), inv = 1.0f / (1.0f + e1 + e2 + e3);
            *(int4*)(topi + t * 4) = make_int4(i0, i1, i2, i3); *(float4*)(topg + t * 4) = make_float4(inv, e1 * inv, e2 * inv, e3 * inv); rstd1[t] = rstd;
            lds_inc(&hist[i0]); lds_inc(&hist[i1]); lds_inc(&hist[i2]); lds_inc(&hist[i3]);
        }
        __syncthreads();
        if (tid < 32) bh[tb * 32 + tid] = hist[tid];
        __syncthreads();
    }
}
__device__ __forceinline__ void vtab_put(unsigned* vt, int pos, unsigned tok) {
    const int tile = pos >> 8, r = pos & 255, hh = r >> 7, R = r & 127, rg = R >> 4, rr = R & 15;
#pragma unroll
    for (int ch = 0; ch < 2; ++ch)
#pragma unroll
        for (int p = 0; p < 4; ++p) { const int st = rg * 2 + ch, ob = rr * 64 + p * 16, sb = ob ^ (((ob >> 9) & 1) << 5), b = st * 1024 + sb, i = b >> 13, td = (b & 8191) >> 4;
            vt[((size_t)tile * 512 + td) * 4 + hh * 2 + i] = tok * (unsigned)(MOE_F8 ? D : 2 * D) + ch * 64 + p * 16; }
}
__device__ __forceinline__ void phase_place(const Args& a, LAS unsigned char* lds, int G) {
    const int tid = threadIdx.x;
    const int* bh = (const int*)(a.ws + WS_BH); const int* topi = (const int*)(a.ws + WS_TOPI); const float* topg = (const float*)(a.ws + WS_TOPG); const float* rstd1 = (const float*)(a.ws + WS_RSTD1);
    int* spos = (int*)(a.ws + WS_SPOS); float* SG = (float*)(a.ws + WS_SG); float* SR = (float*)(a.ws + WS_SR); unsigned* vt = (unsigned*)(a.ws + WS_VTAB);
    unsigned* ctl = (unsigned*)(a.ws + WS_CTL);
    LAS int* pt = (LAS int*)lds; LAS int* pb = pt + 512; LAS int* tot = pb + 512; LAS int* off = tot + 32; LAS int* base = off + 32; LAS int* rank = base + 32;
    constexpr int NTB = T / 128;
    for (int it = 0, tb = blockIdx.x; it == 0 || tb < NTB; ++it, tb += G) {
        const int e = tid & 31, part = tid >> 5; int st = 0, sb = 0;
        for (int b = part; b < NTB; b += 16) { const int v = bh[b * 32 + e]; st += v; if (b < tb) sb += v; }
        pt[tid] = st; pb[tid] = sb;
        __syncthreads();
        if (tid < 32) { int s1 = 0, s2 = 0;
#pragma unroll
            for (int q = 0; q < 16; ++q) { s1 += pt[q * 32 + tid]; s2 += pb[q * 32 + tid]; }
            tot[tid] = s1; base[tid] = s2; rank[tid] = 0; }
        __syncthreads();
        if (tid == 0) { int o = 0; for (int q = 0; q < NE; ++q) { off[q] = o; o += (tot[q] + 255) & ~255; } }
        __syncthreads();
        if (tb < NTB) {
            const int t = tb * 128 + (tid >> 2), k = tid & 3; const int ex = topi[t * 4 + k];
            const int pos = off[ex] + base[ex] + lds_inc(&rank[ex]);
            spos[t * 4 + k] = pos; SG[pos] = topg[t * 4 + k]; SR[pos] = rstd1[t]; vtab_put(vt, pos, (unsigned)t);
        }
        if (it == 0) {
            for (int ex = blockIdx.x; ex < NE; ex += G) { const int n = tot[ex], np = (n + 255) & ~255;
                for (int r = n + tid; r < np; r += 512) { const int pos = off[ex] + r; SG[pos] = 0.f; SR[pos] = 0.f; vtab_put(vt, pos, 0u); } }
            if (blockIdx.x == 0 && tid < 32) ctl[CW_TOT + tid] = (unsigned)tot[tid];
        }
        __syncthreads();
    }
}
__device__ __forceinline__ int build_tiles(const Args& a, LAS unsigned short* te) {
    const unsigned* ctl = (const unsigned*)(a.ws + WS_CTL);
    int o = 0;
    for (int e = 0; e < NE; ++e) { const int n = (int)((ctl[CW_TOT + e] + 255u) >> 8); for (int q = threadIdx.x; q < n; q += 512) te[o + q] = (unsigned short)e; o += n; }
    __syncthreads();
    return o;
}
__device__ __forceinline__ void phase_combine(const Args& a, int vcu, int G) {
    const int tid = threadIdx.x, lane = tid & 63, wave = tid >> 6; const int gw = vcu * 8 + wave, NGW = G * 8;
    bf16_t* hb = (bf16_t*)(a.ws + WS_HN1); unsigned char* h8 = a.ws + WS_H1F8; const unsigned char* Y = a.ws + WS_Y; const int* spos = (const int*)(a.ws + WS_SPOS); float* rstd2 = (float*)(a.ws + WS_RSTD2);
    for (int t = gw; t < T; t += NGW) {
        const int4 ps = *(const int4*)(spos + (size_t)t * 4);
        float v[2][8], y[2][8]; float s = 0.f;
#pragma unroll
        for (int j = 0; j < 2; ++j) { const u32x4 hv = *(const u32x4*)(hb + (size_t)t * D + 8 * lane + 512 * j);
            v[j][0] = bf_lo(hv.x); v[j][1] = bf_hi(hv.x); v[j][2] = bf_lo(hv.y); v[j][3] = bf_hi(hv.y); v[j][4] = bf_lo(hv.z); v[j][5] = bf_hi(hv.z); v[j][6] = bf_lo(hv.w); v[j][7] = bf_hi(hv.w);
#pragma unroll
            for (int q = 0; q < 8; ++q) y[j][q] = 0.f; }
#pragma unroll
        for (int k = 0; k < 4; ++k) { const int pk = k == 0 ? ps.x : (k == 1 ? ps.y : (k == 2 ? ps.z : ps.w));
#pragma unroll
            for (int j = 0; j < 2; ++j) { const u32x2 yv = *(const u32x2*)(Y + (size_t)pk * D + 8 * lane + 512 * j); float f[8];
                fp8x4_to_f32(yv.x, f[0], f[1], f[2], f[3]); fp8x4_to_f32(yv.y, f[4], f[5], f[6], f[7]);
#pragma unroll
                for (int q = 0; q < 8; ++q) y[j][q] += f[q]; } }
#pragma unroll
        for (int j = 0; j < 2; ++j) {
#pragma unroll
            for (int q = 0; q < 8; ++q) { v[j][q] += y[j][q] * 0.0625f; s += v[j][q] * v[j][q]; }
            u32x4 o; o.x = cvt_pk_bf16(v[j][0], v[j][1]); o.y = cvt_pk_bf16(v[j][2], v[j][3]); o.z = cvt_pk_bf16(v[j][4], v[j][5]); o.w = cvt_pk_bf16(v[j][6], v[j][7]);
            *(u32x4*)(hb + (size_t)t * D + 8 * lane + 512 * j) = o;
            u32x2 o8; o8.x = cvt4_fp8(v[j][0], v[j][1], v[j][2], v[j][3]); o8.y = cvt4_fp8(v[j][4], v[j][5], v[j][6], v[j][7]);
            *(u32x2*)(h8 + (size_t)t * D + 8 * lane + 512 * j) = o8; }
        s = wave_sum(s);
        if (lane == 0) rstd2[t] = __builtin_amdgcn_rsqf(s * (1.f / D) + NORM_EPS);
    }
}
__device__ __forceinline__ void phase_final(const Args& a, int vcu, int G) {
    const int tid = threadIdx.x, lane = tid & 63, wave = tid >> 6; const int gw = vcu * 8 + wave, NGW = G * 8;
    float* out = a.out; const bf16_t* h3 = (const bf16_t*)(a.ws + WS_H3B); const float* nw = (const float*)a.in[I_NFIN];
    f32x4 wv[2][2];
#pragma unroll
    for (int j = 0; j < 2; ++j) { wv[j][0] = *(const f32x4*)(nw + 8 * lane + 512 * j); wv[j][1] = *(const f32x4*)(nw + 8 * lane + 512 * j + 4); }
    float scale = 1.0f;
#if MK_DEBUG
    { const unsigned f = *(const unsigned*)(a.ws + WS_CTL + 4 * CW_FAIL); if (f) scale = 1.0f + 0.1f * (float)__builtin_ctz(f); }
#endif
    for (int t = gw; t < T; t += NGW) {
        f32x4 v[2][2]; float s = 0.f;
#pragma unroll
        for (int j = 0; j < 2; ++j) { const u32x4 hv = *(const u32x4*)(h3 + (size_t)t * D + 8 * lane + 512 * j);
            v[j][0] = (f32x4){bf_lo(hv.x), bf_hi(hv.x), bf_lo(hv.y), bf_hi(hv.y)}; v[j][1] = (f32x4){bf_lo(hv.z), bf_hi(hv.z), bf_lo(hv.w), bf_hi(hv.w)};
            s += (v[j][0][0] * v[j][0][0] + v[j][0][1] * v[j][0][1]) + (v[j][0][2] * v[j][0][2] + v[j][0][3] * v[j][0][3]) + (v[j][1][0] * v[j][1][0] + v[j][1][1] * v[j][1][1]) + (v[j][1][2] * v[j][1][2] + v[j][1][3] * v[j][1][3]); }
        const float rstd = __builtin_amdgcn_rsqf(wave_sum(s) * (1.f / D) + NORM_EPS) * scale;
#pragma unroll
        for (int j = 0; j < 2; ++j) { *(f32x4*)(out + (size_t)t * D + 8 * lane + 512 * j) = v[j][0] * rstd * wv[j][0]; *(f32x4*)(out + (size_t)t * D + 8 * lane + 512 * j + 4) = v[j][1] * rstd * wv[j][1]; }
    }
}

__global__ void __launch_bounds__(512, 2) fwd_kernel(Args args) {
    extern __shared__ __attribute__((aligned(16))) unsigned char lds_raw[];
    LAS unsigned char* lds = (LAS unsigned char*)lds_raw;
    const int tid = threadIdx.x, G = gridDim.x;
    const int vcu = (G % 8 == 0) ? ((int)blockIdx.x % 8) * (G / 8) + (int)blockIdx.x / 8 : (int)blockIdx.x;
    volatile LAS unsigned* MISC = (volatile LAS unsigned*)(lds + LCTL_OFF);
    if (tid < 4) MISC[tid] = 0u;
    __syncthreads();
    unsigned* ctl = (unsigned*)(args.ws + WS_CTL);
    XcdBarrier bar; bar.bar = ctl + CW_BAR; bar.x = 0; bar.st = nullptr;
    const int lo = args.ph_lo, hi = args.ph_hi;
    if (hi - lo > 1) bar = xcd_barrier_post(ctl + CW_BAR, MISC);
#ifndef PH_MASK
#define PH_MASK 0x1fff
#endif
#define IN(k) (((PH_MASK >> (k)) & 1) && lo <= (k) && (k) < hi)
#define SEAM(k) do { if (IN(k) && IN((k) + 1)) xcd_barrier(bar); } while (0)
    LAS unsigned short* te = (LAS unsigned short*)(lds + LCTL_OFF + 64);
    const char* ws = (const char*)args.ws;

    if (IN(0)) phase_prologue(args, lds, vcu, G);
    SEAM(0);
    if (IN(1)) {
        { pg8::DenseSched S; S.init(T, NIN, G, (int)blockIdx.x);
          pg8::EpiInProj E{(bf16_t*)(args.ws + WS_Q), (const int*)args.in[I_POS]};
          pg8::gemm_phase<false>(lds, ws + WS_HN1, ws + WS_WIN, D * 2, S, E); }
        { pg8::DenseSched S; S.init(T, D, G, (int)blockIdx.x);
          pg8::EpiPlainF8 E{args.ws + WS_PP, D};
          pg8::gemm_phase<false>(lds, ws + WS_PB, ws + WS_WPT, PLE * 2, S, E); }
    }
    SEAM(1);
    if (IN(2)) { phase_kv(args, lds, G); phase_pool(args, lds, G); }
    SEAM(2);
    if (IN(3)) phase_scan(args, G);
    SEAM(3);
    if (IN(4)) phase_ret(args, lds, G);
    SEAM(4);
    if (IN(5)) {
        pg8::DenseSched S; S.init(T, D, G, (int)blockIdx.x);
        pg8::EpiWout E{(const float*)args.in[I_X], (bf16_t*)(args.ws + WS_HN1), args.ws + WS_H1F8, (float*)(args.ws + WS_SSQ1)};
        pg8::gemm_phase<false>(lds, ws + WS_MIX, ws + WS_WOUT, D * 2, S, E);
    }
    SEAM(5);
    if (IN(6)) phase_router(args, lds, G);
    SEAM(6);
    if (IN(7)) phase_place(args, lds, G);
    SEAM(7);
    if (IN(8)) {
        const int MT = build_tiles(args, te);
        pg8::GroupSchedG S; S.nM = MT; S.nN = 2 * DE / 256; S.G = G; S.c = (int)blockIdx.x; S.NB = 2 * DE; S.te = te; S.vtab = args.ws + WS_VTAB;
        pg8::EpiGateUp E{args.ws + WS_ACT, (const float*)args.in[I_BGU], (const float*)(args.ws + WS_SR)};
        pg8::gemm_phase<MOE_F8 != 0>(lds, MOE_F8 ? ws + WS_H1F8 : ws + WS_HN1, ws + WS_WGU, MOE_F8 ? D : 2 * D, S, E);
    }
    SEAM(8);
    if (IN(9)) {
        const int MT = build_tiles(args, te);
        pg8::GroupSchedD S; S.nM = MT; S.nN = D / 256; S.G = G; S.c = (int)blockIdx.x; S.NB = D; S.te = te; S.vtab = nullptr;
        pg8::EpiDown E{args.ws + WS_Y, (const float*)args.in[I_BD], (const float*)(args.ws + WS_SG)};
        pg8::gemm_phase<MOE_F8 != 0>(lds, ws + WS_ACT, ws + WS_WD, MOE_F8 ? DE : 2 * DE, S, E);
    }
    SEAM(9);
    if (IN(10)) phase_combine(args, vcu, G);
    SEAM(10);
    if (IN(11)) {
        pg8::DenseSched S; S.init(T, D, G, (int)blockIdx.x);
        pg8::EpiPle E{(bf16_t*)(args.ws + WS_H3B), (const bf16_t*)(args.ws + WS_HN1), args.ws + WS_PP, (const float*)(args.ws + WS_RSTD2)};
        pg8::gemm_phase<true>(lds, ws + WS_H1F8, ws + WS_WG, D, S, E);
    }
    SEAM(11);
    if (IN(12)) phase_final(args, vcu, G);
#undef IN
#undef SEAM
}


extern "C" void kernel_launch(void* const* d_in, const int* in_sizes, int n_in, void* d_out, int out_size, void* d_ws, size_t ws_size, hipStream_t stream) {
    static int grid = 0;
    if (grid == 0) {
        if (n_in != 20 || in_sizes[0] != T * D || out_size != T * D || ws_size < WS_END) { fprintf(stderr, "kernel_launch: unexpected shapes (n_in %d, in0 %d, out %d, ws %zu < %zu)\n", n_in, n_in > 0 ? in_sizes[0] : -1, out_size, ws_size, (size_t)WS_END); grid = -1; return; }
        int dev = 0, cus = 0, per_cu = 0;
        if (hipGetDevice(&dev) != hipSuccess || hipDeviceGetAttribute(&cus, hipDeviceAttributeMultiprocessorCount, dev) != hipSuccess) { grid = -1; return; }
        if (hipFuncSetAttribute((const void*)fwd_kernel, hipFuncAttributeMaxDynamicSharedMemorySize, LDS_BYTES) != hipSuccess) { fprintf(stderr, "kernel_launch: hipFuncSetAttribute failed\n"); grid = -1; return; }
        if (hipOccupancyMaxActiveBlocksPerMultiprocessor(&per_cu, (const void*)fwd_kernel, 512, LDS_BYTES) != hipSuccess || per_cu < 1) { fprintf(stderr, "kernel_launch: occupancy query says %d\n", per_cu); (void)hipGetLastError(); }
        grid = cus;
    }
    if (grid < 0) return;
    if (hipMemsetAsync((char*)d_ws + WS_CTL, 0, CTL_ZERO_BYTES, stream) != hipSuccess) return;
    Args a{};
    for (int i = 0; i < 20; ++i) a.in[i] = d_in[i];
    a.out = (float*)d_out; a.ws = (unsigned char*)d_ws;
#if MK_PER_PHASE
    for (int p = 0; p < NPH; ++p) { a.ph_lo = p; a.ph_hi = p + 1; for (int r = 0; r < 1 + ((MK_REPEAT >> p) & 1); ++r) hipLaunchKernelGGL(fwd_kernel, dim3(grid), dim3(512), LDS_BYTES, stream, a); }
#else
    a.ph_lo = 0; a.ph_hi = NPH; hipLaunchKernelGGL(fwd_kernel, dim3(grid), dim3(512), LDS_BYTES, stream, a);
#endif
}
```

```cpp
#include <hip/hip_runtime.h>
#include <cstdio>
#include <cstdint>

#ifndef MK_PER_PHASE
#define MK_PER_PHASE 0
#endif
#ifndef MOE_F8
#define MOE_F8 1
#endif
#ifndef MK_REPEAT
#define MK_REPEAT 0x0
#endif
#ifndef MK_DEBUG
#define MK_DEBUG 0
#endif

#define GAS __attribute__((address_space(1)))
#define LAS __attribute__((address_space(3)))
typedef unsigned short bf16_t;
typedef short bf16x8 __attribute__((ext_vector_type(8)));
typedef float f32x4 __attribute__((ext_vector_type(4)));
typedef float f32x2 __attribute__((ext_vector_type(2)));
typedef unsigned u32x4 __attribute__((ext_vector_type(4)));
typedef unsigned u32x2 __attribute__((ext_vector_type(2)));
typedef int v8i __attribute__((ext_vector_type(8)));
typedef int v4i __attribute__((ext_vector_type(4)));

constexpr int T = 32768, D = 1024, SEQ = 4096, NBATCH = 8, NH = 8, HD = 64, CH = 128, NCH = 32;
constexpr int DRET = 512, DPOOL = 512, NIN = 2560, NE = 32, TOPK = 4, DE = 1024, PLE = 256;
constexpr float NORM_EPS = 1e-5f, GN_EPS = 1e-5f;
constexpr int MAXROWS = T * TOPK + NE * 256;
constexpr int MAXT = MAXROWS / 256;

constexpr size_t MiB = 1u << 20, KiB = 1u << 10;
constexpr size_t WS_CTL = 0, CTL_ZERO_BYTES = 64 * KiB;
constexpr size_t WS_ROUT = 1 * MiB, WS_PWT = 1 * MiB + 64 * KiB, WS_WPT = 1 * MiB + 256 * KiB;
constexpr size_t WS_TOPI = 2 * MiB, WS_TOPG = 2 * MiB + 512 * KiB, WS_SPOS = 3 * MiB, WS_RSTD1 = 3 * MiB + 512 * KiB, WS_RSTD2 = 3 * MiB + 640 * KiB, WS_BH = 3 * MiB + 768 * KiB;
constexpr size_t WS_SG = 4 * MiB, WS_SR = 5 * MiB, WS_SSQ1 = 6 * MiB, WS_VTAB = 8 * MiB;
constexpr size_t WS_WIN = 16 * MiB, WS_WOUT = 21 * MiB, WS_WG = 23 * MiB;
constexpr size_t WS_WGU = 32 * MiB, WS_WD = 160 * MiB, WS_PP = 224 * MiB;
constexpr size_t WS_HN1 = 288 * MiB  , WS_PB = 352 * MiB;
constexpr size_t WS_Q = 368 * MiB, WS_K = 400 * MiB, WS_V = 432 * MiB, WS_G = 464 * MiB, WS_U = 496 * MiB;
constexpr size_t WS_KV = 528 * MiB, WS_ST = 560 * MiB, WS_MIX = 576 * MiB;
constexpr size_t WS_H1F8 = 496 * MiB;
constexpr size_t WS_H3B = 368 * MiB;
constexpr size_t WS_ACT = 352 * MiB, WS_Y = 624 * MiB, WS_END = 896 * MiB;
static_assert(WS_K - WS_Q == (size_t)T * 512 * 2 && WS_V - WS_K == WS_K - WS_Q && WS_G - WS_V == WS_K - WS_Q && WS_U - WS_G == WS_K - WS_Q, "q|k|v|g|u equally spaced");
static_assert(WS_VTAB + (size_t)MAXT * 512 * 16 <= WS_WIN && WS_ACT + (size_t)MAXROWS * DE * 2 <= WS_Y && WS_Y + (size_t)MAXROWS * D * 2 <= WS_END, "ws map");
constexpr int CW_TMO = 0, CW_CODE = 1, CW_FAIL = 2, CW_TOT = 64, CW_BAR = 4096;

constexpr int VOFF_OFF = 131072;
constexpr int LCTL_OFF = 147456;
constexpr int LDS_BYTES = 151552;

#define LDS_WAIT() asm volatile("s_waitcnt lgkmcnt(0)" ::: "memory")
#define VM_WAIT() asm volatile("s_waitcnt vmcnt(0)" ::: "memory")
__device__ __forceinline__ unsigned cvt_pk_bf16(float lo, float hi) { unsigned r; asm volatile("v_cvt_pk_bf16_f32 %0, %1, %2" : "=v"(r) : "v"(lo), "v"(hi)); return r; }
__device__ __forceinline__ unsigned cvt4_fp8(float a, float b, float c, float d) { int w = __builtin_amdgcn_cvt_pk_fp8_f32(a, b, 0, false); w = __builtin_amdgcn_cvt_pk_fp8_f32(c, d, w, true); return (unsigned)w; }
__device__ __forceinline__ bf16x8 v8lo(const v8i x) { const v4i t = x.lo; return __builtin_bit_cast(bf16x8, t); }
__device__ __forceinline__ bf16x8 v8hi(const v8i x) { const v4i t = x.hi; return __builtin_bit_cast(bf16x8, t); }
__device__ __forceinline__ void fp8x4_to_f32(unsigned w, float& a, float& b, float& c, float& d) { const f32x2 lo = __builtin_amdgcn_cvt_pk_f32_fp8((int)w, false), hi = __builtin_amdgcn_cvt_pk_f32_fp8((int)w, true); a = lo[0]; b = lo[1]; c = hi[0]; d = hi[1]; }
__device__ __forceinline__ float bf_lo(unsigned w) { return __uint_as_float(w << 16); }
__device__ __forceinline__ float bf_hi(unsigned w) { return __uint_as_float(w & 0xffff0000u); }
__device__ __forceinline__ float wave_sum(float v) {
#pragma unroll
    for (int o = 1; o < 64; o <<= 1) v += __shfl_xor(v, o);
    return v;
}
__device__ __forceinline__ float sigmoidf_fast(float x) { return __builtin_amdgcn_rcpf(1.0f + __builtin_amdgcn_exp2f(-1.4426950408889634f * x)); }
__device__ __forceinline__ int lds_inc(LAS int* p) { return __hip_atomic_fetch_add(p, 1, __ATOMIC_RELAXED, __HIP_MEMORY_SCOPE_WORKGROUP); }
__device__ __forceinline__ float log2_gamma(int h) {
    const float x = __builtin_amdgcn_exp2f(-(float)(5 + h));
    const float ln = -x * (1.0f + x * (0.5f + x * (0.33333333f + x * (0.25f + x * 0.2f))));
    return ln * 1.4426950408889634f;
}

#define XB_TMO      128
#define XB_XCNT(j)  (256  + 64 * (j))
#define XB_XSUB(j)  (1280 + 64 * (j))
#define XB_XGEN(j)  (2304 + 64 * (j))
#define XB_TOP      3328
#define XB_TOPGEN   3392
#define XCD_BAR_WORDS 3456
#define XB_SPIN_CAP (1u << 18)
__device__ __forceinline__ unsigned xb_ld(unsigned* p)              { return __hip_atomic_load(p, __ATOMIC_RELAXED, __HIP_MEMORY_SCOPE_AGENT); }
__device__ __forceinline__ unsigned xb_add(unsigned* p, unsigned v) { return __hip_atomic_fetch_add(p, v, __ATOMIC_RELAXED, __HIP_MEMORY_SCOPE_AGENT); }
__device__ __forceinline__ unsigned xb_xcc_id() { return (unsigned)__builtin_amdgcn_s_getreg((3 << 11) | 20) & 0xFu; }
#define XB_SPIN(cond, bar) do { unsigned _sp = 0; while (cond) { __builtin_amdgcn_s_sleep(1); \
    if ((++_sp & 255u) == 0u) { if (xb_ld(&(bar)[XB_TMO])) break; if (_sp > XB_SPIN_CAP) { atomicAdd(&(bar)[XB_TMO], 1u); break; } } } } while (0)
struct XcdBarrier { unsigned* bar; unsigned x; volatile LAS unsigned* st; };
__device__ __forceinline__ XcdBarrier xcd_barrier_post(unsigned* bar, volatile LAS unsigned* st) {
    XcdBarrier b; b.bar = bar; b.x = xb_xcc_id(); b.st = st;
    if (threadIdx.x == 0) (void)xb_add(&bar[XB_XCNT(b.x)], 1u);
    return b;
}
__device__ __forceinline__ void xcd_barrier_complete(unsigned* bar, unsigned x, unsigned& nloc, unsigned& nx) {
    const unsigned G = gridDim.x * gridDim.y * gridDim.z;
    unsigned sum, cnt, mine, sp = 0u;
    for (;;) {
        sum = 0u; cnt = 0u; mine = 0u;
#pragma unroll
        for (unsigned j = 0; j < 16; ++j) { const unsigned c = xb_ld(&bar[XB_XCNT(j)]); sum += c; cnt += (c > 0u) ? 1u : 0u; mine = (j == x) ? c : mine; }
        if (sum == G) break;
        __builtin_amdgcn_s_sleep(1);
        if ((++sp & 255u) == 0u) { if (xb_ld(&bar[XB_TMO])) break; if (sp > XB_SPIN_CAP) { atomicAdd(&bar[XB_TMO], 1u); break; } }
    }
    nloc = mine > 0u ? mine : 1u; nx = cnt > 0u ? cnt : 1u;
}
__device__ __forceinline__ void xcd_barrier(const XcdBarrier& b) {
    asm volatile("s_waitcnt vmcnt(0)" ::: "memory");
    __syncthreads();
    if (threadIdx.x == 0) {
        unsigned* bar = b.bar;
        __builtin_amdgcn_s_waitcnt(0);
        unsigned nloc = b.st[0], nx = b.st[1];
        if (nloc == 0u) { xcd_barrier_complete(bar, b.x, nloc, nx); b.st[0] = nloc; b.st[1] = nx; }
        const unsigned old = xb_add(&bar[XB_XSUB(b.x)], 1u);
        const unsigned gen = old / nloc;
        if (old + 1u == (gen + 1u) * nloc) {
            __builtin_amdgcn_fence(__ATOMIC_RELEASE, "agent");
            asm volatile("s_waitcnt vmcnt(0)" ::: "memory");
            const unsigned og = xb_add(&bar[XB_TOP], 1u);
            const unsigned tg = og / nx;
            if (og + 1u == (tg + 1u) * nx) xb_add(&bar[XB_TOPGEN], 1u);
            else XB_SPIN(xb_ld(&bar[XB_TOPGEN]) == tg, bar);
            __builtin_amdgcn_fence(__ATOMIC_ACQUIRE, "agent");
            xb_add(&bar[XB_XGEN(b.x)], 1u);
            asm volatile("s_waitcnt vmcnt(0)" ::: "memory");
        } else {
            XB_SPIN(xb_ld(&bar[XB_XGEN(b.x)]) == gen, bar);
            __builtin_amdgcn_fence(__ATOMIC_ACQUIRE, "agent");
            asm volatile("s_waitcnt vmcnt(0)" ::: "memory");
        }
    }
    __syncthreads();
}

namespace pg8 {
constexpr int BM = 256, BK = 64, HALF = 128, HTB = HALF * BK * 2, STAGE_BYTES = 8 * HTB, NXCD = 8, WGM = 8;
__host__ __device__ __forceinline__ int lds_byte(int r, int c) { const int st = (r >> 4) * 2 + (c >> 5), rr = r & 15, cc = c & 31, ob = rr * 64 + cc * 2; return st * 1024 + (ob ^ (((ob >> 9) & 1) << 5)); }
__host__ __device__ __forceinline__ void stage_rc(int b, int& R, int& C) { const int st = b / 1024, sb = b % 1024, swz = sb ^ (((sb >> 9) & 1) << 5); R = (st >> 1) * 16 + swz / 64; C = (st & 1) * 32 + (swz % 64) / 2; }
__host__ __device__ __forceinline__ int perm32(int rho) { const int n = rho >> 4, i = rho & 15; return 8 * (i >> 2) + 4 * n + (i & 3); }
struct Unit { int pm, pn, e; };
__device__ __forceinline__ bool order_next(int i, int G, int c, int nM, int nN, int& pm, int& pn) {
    const int nwg = nM * nN; const long L = (long)i * G + c; if (L >= nwg) return false;
    int wgid = (int)L; { const int q = nwg / NXCD, r = nwg % NXCD, xcd = wgid % NXCD, off = wgid / NXCD; wgid = (xcd < r ? xcd * (q + 1) : r * (q + 1) + (xcd - r) * q) + off; }
    const int nig = WGM * nN, gid = wgid / nig, fm = gid * WGM, gsz = (nM - fm) < WGM ? (nM - fm) : WGM;
    pm = fm + ((wgid % nig) % gsz); pn = (wgid % nig) / gsz; return true;
}
struct DenseSched {
    static constexpr bool GATHER = false;
    int nM, nN, G, c; const unsigned char* vtab;
    __device__ __forceinline__ void init(int M, int N, int G_, int c_) { nM = M / BM; nN = N / BM; G = G_; c = c_; vtab = nullptr; }
    __device__ __forceinline__ bool next(int i, Unit& u) const { u.e = 0; return order_next(i, G, c, nM, nN, u.pm, u.pn); }
    __device__ __forceinline__ size_t b_off(const Unit& u, int RB) const { return (size_t)u.pn * BM * RB; }
};
struct GroupSched {
    static constexpr bool GATHER_ = false;
    int nM, nN, G, c, NB; const LAS unsigned short* te; const unsigned char* vtab;
    __device__ __forceinline__ bool next(int i, Unit& u) const { if (!order_next(i, G, c, nM, nN, u.pm, u.pn)) return false; u.e = __builtin_amdgcn_readfirstlane((int)te[u.pm]); return true; }
    __device__ __forceinline__ size_t b_off(const Unit& u, int RB) const { return ((size_t)u.e * NB + (size_t)u.pn * BM) * RB; }
};
struct GroupSchedG : GroupSched { static constexpr bool GATHER = true; };
struct GroupSchedD : GroupSched { static constexpr bool GATHER = false; };

template <bool F8, class Epi, class Sched>
__device__ __forceinline__ void gemm_phase(LAS unsigned char* lds, const char* A, const char* Bt, const int RB, const Sched& S, const Epi& E) {
    const int tid = threadIdx.x, wid = __builtin_amdgcn_readfirstlane(tid >> 6), lane = tid & 63, wr = wid >> 2, wc = wid & 3, fr = lane & 15, fq = lane >> 4;
    const int nt = RB / 128;
    unsigned voffB[2], cA[2]; int RA[2];
#pragma unroll
    for (int i = 0; i < 2; ++i) { int R, C; stage_rc(tid * 16 + i * 8192, R, C); const int Rb = Epi::PERM ? ((R & ~31) + perm32(R & 31)) : R;
        RA[i] = R; cA[i] = (unsigned)C * 2u; voffB[i] = (unsigned)(Rb * RB) + (unsigned)C * 2u; }
    const size_t kstep = (size_t)(BK * 2);
    const size_t hstep = (size_t)HALF * RB;
    const unsigned ldsw = (unsigned)wid * 1024u;
    const int aoff = lds_byte(wr * 64 + fr, fq * 8), boff = lds_byte(wc * 32 + fr, fq * 8);
#define PG8_SA(b, h) (((b) * 2 + (h)) * HTB)
#define PG8_SB(b, h) ((4 + (b) * 2 + (h)) * HTB)
#define PG8_STAGE(bufoff, gbase, voff) do { _Pragma("unroll") for (int _i = 0; _i < 2; ++_i) \
        __builtin_amdgcn_global_load_lds((const unsigned*)((const char*)(gbase) + (voff)[_i]), (LAS unsigned*)(lds + (bufoff) + ldsw + _i * 8192), 16, 0, 0); } while (0)
#define PG8_LDA(dst, b, h) do { _Pragma("unroll") for (int m = 0; m < 4; ++m) { dst[m].lo = *(const LAS v4i*)(lds + (b) + PG8_SA(0, h) + aoff + m * 2048); dst[m].hi = *(const LAS v4i*)(lds + (b) + PG8_SA(0, h) + aoff + m * 2048 + 1024); } } while (0)
#define PG8_LDB(dst, b, h) do { _Pragma("unroll") for (int n = 0; n < 2; ++n) { dst[n].lo = *(const LAS v4i*)(lds + (b) + PG8_SB(0, h) + boff + n * 2048); dst[n].hi = *(const LAS v4i*)(lds + (b) + PG8_SB(0, h) + boff + n * 2048 + 1024); } } while (0)
#define PG8_MMA(ai, bj, At, Bt_) do { __builtin_amdgcn_s_setprio(1); _Pragma("unroll") for (int m = 0; m < 4; ++m) _Pragma("unroll") for (int n = 0; n < 2; ++n) { \
        if constexpr (F8) acc[ai][bj][m][n] = __builtin_amdgcn_mfma_scale_f32_16x16x128_f8f6f4(Bt_[n], At[m], acc[ai][bj][m][n], 0, 0, 0, 0, 0, 0); \
        else { acc[ai][bj][m][n] = __builtin_amdgcn_mfma_f32_16x16x32_bf16(v8lo(Bt_[n]), v8lo(At[m]), acc[ai][bj][m][n], 0, 0, 0); \
               acc[ai][bj][m][n] = __builtin_amdgcn_mfma_f32_16x16x32_bf16(v8hi(Bt_[n]), v8hi(At[m]), acc[ai][bj][m][n], 0, 0, 0); } } \
        __builtin_amdgcn_s_setprio(0); } while (0)
#define PG8_WAIT_V(n) asm volatile("s_waitcnt vmcnt(" #n ")" ::: "memory")
#define PG8_WAIT_L(n) asm volatile("s_waitcnt lgkmcnt(" #n ")" ::: "memory")
#define PG8_BAR __builtin_amdgcn_s_barrier()
#define PG8_SCHED __builtin_amdgcn_sched_barrier(0)
#define PG8_DENSE_V(v, u) do { _Pragma("unroll") for (int _h = 0; _h < 2; ++_h) _Pragma("unroll") for (int _i = 0; _i < 2; ++_i) (v)[_h][_i] = (unsigned)((u).pm * BM + _h * HALF + RA[_i]) * (unsigned)RB + cA[_i]; } while (0)
    Unit cur, nxt; int ui = 0;
    if (!S.next(0, cur)) return;
    f32x4 acc[2][2][4][2];
#pragma unroll
    for (int a = 0; a < 2; ++a)
#pragma unroll
        for (int b = 0; b < 2; ++b)
#pragma unroll
            for (int m = 0; m < 4; ++m)
#pragma unroll
                for (int n = 0; n < 2; ++n) acc[a][b][m][n] = (f32x4){0.f, 0.f, 0.f, 0.f};
    v8i At[4], B0[2], B1[2];
    unsigned vc[2][2], v2[2][2];
    if constexpr (Sched::GATHER) {
        __builtin_amdgcn_global_load_lds((const unsigned*)(S.vtab + ((size_t)cur.pm * 512 + tid) * 16), (LAS unsigned*)(lds + VOFF_OFF + ldsw), 16, 0, 0);
        PG8_WAIT_V(0);
        const u32x4 tv = *(const LAS u32x4*)(lds + VOFF_OFF + tid * 16); vc[0][0] = tv.x; vc[0][1] = tv.y; vc[1][0] = tv.z; vc[1][1] = tv.w;
    } else { PG8_DENSE_V(vc, cur); }
    const char* cB = Bt + S.b_off(cur, RB);
    PG8_STAGE(PG8_SB(0, 0), cB, voffB); PG8_STAGE(PG8_SB(0, 1), cB + hstep, voffB); PG8_STAGE(PG8_SA(0, 0), A, vc[0]); PG8_STAGE(PG8_SA(0, 1), A, vc[1]);
    if (wr == 1) PG8_BAR;
    PG8_WAIT_V(2); PG8_BAR;
    PG8_STAGE(PG8_SB(1, 0), cB + kstep, voffB); PG8_STAGE(PG8_SA(1, 0), A + kstep, vc[0]); PG8_STAGE(PG8_SB(1, 1), cB + hstep + kstep, voffB);
    PG8_WAIT_V(6); PG8_BAR;
    for (;;) {
        const bool has_next = S.next(ui + 1, nxt);
        const char* nB = has_next ? Bt + S.b_off(nxt, RB) : cB;
        unsigned dlt = 0u;
        if (has_next) {
            if constexpr (Sched::GATHER) __builtin_amdgcn_global_load_lds((const unsigned*)(S.vtab + ((size_t)nxt.pm * 512 + tid) * 16), (LAS unsigned*)(lds + VOFF_OFF + ((ui + 1) & 1) * 8192 + ldsw), 16, 0, 0);
            else dlt = (unsigned)(nxt.pm - cur.pm) * (unsigned)(BM * RB);
        }
#pragma unroll
        for (int h = 0; h < 2; ++h) { v2[h][0] = vc[h][0]; v2[h][1] = vc[h][1]; }
#pragma nounroll
        for (int t = 0; t < nt; ++t) {
            const int bb = t & 1; const bool w1 = (t + 1 >= nt), w2 = (t + 2 >= nt);
            if (t == nt - 2 && has_next) {
                if constexpr (Sched::GATHER) { const u32x4 tv = *(const LAS u32x4*)(lds + VOFF_OFF + ((ui + 1) & 1) * 8192 + tid * 16); v2[0][0] = tv.x; v2[0][1] = tv.y; v2[1][0] = tv.z; v2[1][1] = tv.w; }
                else {
#pragma unroll
                    for (int h = 0; h < 2; ++h) { v2[h][0] += dlt; v2[h][1] += dlt; } }
            }
            const char* a1 = w1 ? A : A + (size_t)(t + 1) * kstep;
            const char* a2 = w2 ? A + (size_t)(t + 2 - nt) * kstep : A + (size_t)(t + 2) * kstep;
            const char* b2 = w2 ? nB + (size_t)(t + 2 - nt) * kstep : cB + (size_t)(t + 2) * kstep;
            unsigned va1[2], va2[2];
#pragma unroll
            for (int i = 0; i < 2; ++i) { va1[i] = w1 ? v2[1][i] : vc[1][i]; va2[i] = w2 ? v2[0][i] : vc[0][i]; }
            const int ob = bb * (2 * HTB), on = (bb ^ 1) * (2 * HTB);
            PG8_LDB(B0, ob, 0); PG8_LDB(B1, ob, 1); PG8_SCHED; PG8_LDA(At, ob, 0); PG8_STAGE(on + PG8_SA(0, 1), a1, va1);
            PG8_WAIT_V(8); PG8_WAIT_L(0); PG8_BAR; PG8_MMA(0, 0, At, B0); PG8_MMA(0, 1, At, B1); PG8_BAR; PG8_SCHED;
            PG8_LDA(At, ob, 1); PG8_STAGE(ob + PG8_SB(0, 0), b2, voffB); PG8_STAGE(ob + PG8_SB(0, 1), b2 + hstep, voffB); PG8_STAGE(ob + PG8_SA(0, 0), a2, va2);
            PG8_WAIT_V(8); PG8_WAIT_L(0); PG8_BAR; PG8_MMA(1, 0, At, B0); PG8_MMA(1, 1, At, B1); PG8_BAR; PG8_SCHED;
        }
        if (wr == 0) PG8_BAR;
        E(acc, cur, wr, wc, fr, fq);
        if (!has_next) break;
#pragma unroll
        for (int a = 0; a < 2; ++a)
#pragma unroll
            for (int b = 0; b < 2; ++b)
#pragma unroll
                for (int m = 0; m < 4; ++m)
#pragma unroll
                    for (int n = 0; n < 2; ++n) acc[a][b][m][n] = (f32x4){0.f, 0.f, 0.f, 0.f};
        cur = nxt; cB = nB; ++ui;
#pragma unroll
        for (int h = 0; h < 2; ++h) { vc[h][0] = v2[h][0]; vc[h][1] = v2[h][1]; }
        if (wr == 1) PG8_BAR;
    }
    PG8_WAIT_V(0);
    PG8_BAR;
#undef PG8_SA
#undef PG8_SB
#undef PG8_STAGE
#undef PG8_LDA
#undef PG8_LDB
#undef PG8_MMA
#undef PG8_WAIT_V
#undef PG8_WAIT_L
#undef PG8_BAR
#undef PG8_SCHED
#undef PG8_DENSE_V
}

typedef f32x4 Acc[2][2][4][2];
struct EpiInProj {
    static constexpr bool PERM = true;
    bf16_t* Q; const int* pos;
    __device__ __forceinline__ void operator()(const Acc& acc, const Unit& u, int wr, int wc, int fr, int fq) const {
        const int sec = u.pn >> 1, hf = u.pn & 1, row0 = u.pm * BM + wr * 64 + fr;
        if (sec >= 2) {
            bf16_t* base = Q + (size_t)sec * (size_t)(T * 512);
            const int col0 = hf * 256 + wc * 32 + 8 * fq;
#pragma unroll
            for (int ai = 0; ai < 2; ++ai)
#pragma unroll
                for (int m = 0; m < 4; ++m) { bf16_t* rowp = base + (size_t)(row0 + ai * HALF + m * 16) * 512 + col0;
#pragma unroll
                    for (int bj = 0; bj < 2; ++bj) { const f32x4 v0 = acc[ai][bj][m][0], v1 = acc[ai][bj][m][1];
                        u32x4 w; w.x = cvt_pk_bf16(v0[0], v0[1]); w.y = cvt_pk_bf16(v0[2], v0[3]); w.z = cvt_pk_bf16(v1[0], v1[1]); w.w = cvt_pk_bf16(v1[2], v1[3]);
                        *(u32x4*)(rowp + bj * HALF) = w; } }
        } else {
            bf16_t* base = Q + (size_t)sec * (size_t)(T * 512);
            const int head = hf * 4 + wc;
            const float lg = log2_gamma(head);
#pragma unroll
            for (int ai = 0; ai < 2; ++ai)
#pragma unroll
                for (int m = 0; m < 4; ++m) {
                    const int row = row0 + ai * HALF + m * 16; const float p = (float)pos[row]; const float c = (float)(row & (CH - 1));
                    const float sc = sec == 0 ? __builtin_amdgcn_exp2f(c * lg) : __builtin_amdgcn_exp2f(-c * lg) * 0.125f;
                    bf16_t* rowp = base + (size_t)row * 512 + head * 64 + 8 * fq;
#pragma unroll
                    for (int n = 0; n < 2; ++n) { float o1[4], o2[4];
#pragma unroll
                        for (int j = 0; j < 4; ++j) { const float ifr = __builtin_amdgcn_exp2f(-(float)(8 * fq + 4 * n + j) * (13.287712379549449f / 32.0f)) * 0.15915494309189535f;
                            const float rev = __builtin_amdgcn_fractf(p * ifr); const float sn = __builtin_amdgcn_sinf(rev), cs = __builtin_amdgcn_cosf(rev);
                            const float x1 = acc[ai][0][m][n][j], x2 = acc[ai][1][m][n][j];
                            o1[j] = (x1 * cs - x2 * sn) * sc; o2[j] = (x2 * cs + x1 * sn) * sc; }
                        u32x2 w; w.x = cvt_pk_bf16(o1[0], o1[1]); w.y = cvt_pk_bf16(o1[2], o1[3]); *(u32x2*)(rowp + 4 * n) = w;
                        w.x = cvt_pk_bf16(o2[0], o2[1]); w.y = cvt_pk_bf16(o2[2], o2[3]); *(u32x2*)(rowp + 32 + 4 * n) = w; }
                }
        }
    }
};
struct EpiPlainF8 {
    static constexpr bool PERM = true;
    unsigned char* O; int ldc;
    __device__ __forceinline__ void operator()(const Acc& acc, const Unit& u, int wr, int wc, int fr, int fq) const {
        const int row0 = u.pm * BM + wr * 64 + fr, col0 = u.pn * BM + wc * 32 + 8 * fq;
#pragma unroll
        for (int ai = 0; ai < 2; ++ai)
#pragma unroll
            for (int m = 0; m < 4; ++m) { unsigned char* rowp = O + (size_t)(row0 + ai * HALF + m * 16) * ldc + col0;
#pragma unroll
                for (int bj = 0; bj < 2; ++bj) { const f32x4 v0 = acc[ai][bj][m][0], v1 = acc[ai][bj][m][1];
                    u32x2 w; w.x = cvt4_fp8(v0[0], v0[1], v0[2], v0[3]); w.y = cvt4_fp8(v1[0], v1[1], v1[2], v1[3]);
                    *(u32x2*)(rowp + bj * HALF) = w; } }
    }
};
struct EpiWout {
    static constexpr bool PERM = true;
    const float* x; bf16_t* h1b; unsigned char* h1f8; float* ssq;
    __device__ __forceinline__ void operator()(const Acc& acc, const Unit& u, int wr, int wc, int fr, int fq) const {
        const int row0 = u.pm * BM + wr * 64 + fr, col0 = u.pn * BM + wc * 32 + 8 * fq;
#pragma unroll
        for (int ai = 0; ai < 2; ++ai)
#pragma unroll
            for (int m = 0; m < 4; ++m) { const int row = row0 + ai * HALF + m * 16; const size_t off = (size_t)row * D + col0; float s = 0.f;
#pragma unroll
                for (int bj = 0; bj < 2; ++bj) { const f32x4 x0 = *(const f32x4*)(x + off + bj * HALF), x1 = *(const f32x4*)(x + off + bj * HALF + 4);
                    const f32x4 h0 = acc[ai][bj][m][0] + x0, h1 = acc[ai][bj][m][1] + x1;
                    s += (h0[0] * h0[0] + h0[1] * h0[1]) + (h0[2] * h0[2] + h0[3] * h0[3]) + (h1[0] * h1[0] + h1[1] * h1[1]) + (h1[2] * h1[2] + h1[3] * h1[3]);
                    u32x4 w; w.x = cvt_pk_bf16(h0[0], h0[1]); w.y = cvt_pk_bf16(h0[2], h0[3]); w.z = cvt_pk_bf16(h1[0], h1[1]); w.w = cvt_pk_bf16(h1[2], h1[3]);
                    *(u32x4*)(h1b + off + bj * HALF) = w;
                    u32x2 q; q.x = cvt4_fp8(h0[0], h0[1], h0[2], h0[3]); q.y = cvt4_fp8(h1[0], h1[1], h1[2], h1[3]);
                    *(u32x2*)(h1f8 + off + bj * HALF) = q; }
                s += __shfl_xor(s, 16); s += __shfl_xor(s, 32);
                if (fq == 0) ssq[(size_t)row * 16 + u.pn * 4 + wc] = s;
                if (m & 1) asm volatile("" ::: "memory"); }
    }
};
struct EpiGateUp {
    static constexpr bool PERM = true;
    unsigned char* act; const float* bgu; const float* sr;
    __device__ __forceinline__ void operator()(const Acc& acc, const Unit& u, int wr, int wc, int fr, int fq) const {
        const int prow0 = u.pm * BM + wr * 64 + fr, acol = u.pn * 128 + wc * 32 + 8 * fq;
        const float* bp = bgu + (size_t)u.e * (2 * DE) + 2 * acol;
        f32x2 bg[4], bu[4];
#pragma unroll
        for (int q = 0; q < 4; ++q) { const f32x4 b4 = *(const f32x4*)(bp + 4 * q); bg[q] = (f32x2){b4[0], b4[2]}; bu[q] = (f32x2){b4[1], b4[3]}; }
        float rr[8];
#pragma unroll
        for (int i = 0; i < 8; ++i) rr[i] = sr[prow0 + (i >> 2) * HALF + (i & 3) * 16] * (MOE_F8 ? 0.03125f : 1.0f);
#pragma unroll
        for (int ai = 0; ai < 2; ++ai)
#pragma unroll
            for (int m = 0; m < 4; ++m) { const int prow = prow0 + ai * HALF + m * 16; const float r = rr[ai * 4 + m]; f32x2 o[4];
#pragma unroll
                for (int p = 0; p < 4; ++p) { const f32x4 ga = acc[ai][0][m][p >> 1], ua = acc[ai][1][m][p >> 1];
                    f32x2 g = (f32x2){ga[(p & 1) * 2], ga[(p & 1) * 2 + 1]} * r + bg[p], up = (f32x2){ua[(p & 1) * 2], ua[(p & 1) * 2 + 1]} * r + bu[p];
                    g.x = fminf(g.x, 7.0f); g.y = fminf(g.y, 7.0f); up.x = __builtin_amdgcn_fmed3f(up.x, -7.0f, 7.0f); up.y = __builtin_amdgcn_fmed3f(up.y, -7.0f, 7.0f);
                    const f32x2 t = g * (-1.702f * 1.4426950408889634f); f32x2 d; d.x = __builtin_amdgcn_exp2f(fminf(t.x, 60.0f)); d.y = __builtin_amdgcn_exp2f(fminf(t.y, 60.0f)); d = d + 1.0f;
                    const float rp = __builtin_amdgcn_rcpf(d.x * d.y); const f32x2 sg = (f32x2){d.y, d.x} * rp;
                    o[p] = (up + 1.0f) * (g * sg); }
                if (MOE_F8) { u32x2 w; w.x = cvt4_fp8(o[0].x, o[0].y, o[1].x, o[1].y); w.y = cvt4_fp8(o[2].x, o[2].y, o[3].x, o[3].y); *(u32x2*)(act + (size_t)prow * DE + acol) = w; }
                else { u32x4 w; w.x = cvt_pk_bf16(o[0].x, o[0].y); w.y = cvt_pk_bf16(o[1].x, o[1].y); w.z = cvt_pk_bf16(o[2].x, o[2].y); w.w = cvt_pk_bf16(o[3].x, o[3].y); *(u32x4*)(act + ((size_t)prow * DE + acol) * 2) = w; } }
    }
};
struct EpiDown {
    static constexpr bool PERM = true;
    unsigned char* y; const float* bd; const float* sg;
    __device__ __forceinline__ void operator()(const Acc& acc, const Unit& u, int wr, int wc, int fr, int fq) const {
        const int prow0 = u.pm * BM + wr * 64 + fr, col0 = u.pn * BM + wc * 32 + 8 * fq;
        const float* bp = bd + (size_t)u.e * D + col0;
        f32x4 bv[2][2];
#pragma unroll
        for (int bj = 0; bj < 2; ++bj)
#pragma unroll
            for (int n = 0; n < 2; ++n) bv[bj][n] = *(const f32x4*)(bp + bj * HALF + 4 * n);
#pragma unroll
        for (int ai = 0; ai < 2; ++ai)
#pragma unroll
            for (int m = 0; m < 4; ++m) { const int prow = prow0 + ai * HALF + m * 16; const float gw = sg[prow] * 16.0f; unsigned char* rowp = y + (size_t)prow * D + col0;
#pragma unroll
                for (int bj = 0; bj < 2; ++bj) { const f32x4 v0 = (acc[ai][bj][m][0] * (MOE_F8 ? 0.03125f : 1.0f) + bv[bj][0]) * gw, v1 = (acc[ai][bj][m][1] * (MOE_F8 ? 0.03125f : 1.0f) + bv[bj][1]) * gw;
                    u32x2 w; w.x = cvt4_fp8(v0[0], v0[1], v0[2], v0[3]); w.y = cvt4_fp8(v1[0], v1[1], v1[2], v1[3]);
                    *(u32x2*)(rowp + bj * HALF) = w; } }
    }
};
struct EpiPle {
    static constexpr bool PERM = true;
    bf16_t* h3; const bf16_t* h2b; const unsigned char* pp; const float* rstd2;
    __device__ __forceinline__ void operator()(const Acc& acc, const Unit& u, int wr, int wc, int fr, int fq) const {
        const int row0 = u.pm * BM + wr * 64 + fr, col0 = u.pn * BM + wc * 32 + 8 * fq;
#pragma unroll
        for (int ai = 0; ai < 2; ++ai)
#pragma unroll
            for (int m = 0; m < 4; ++m) { const int row = row0 + ai * HALF + m * 16; const float r = rstd2[row] * 0.03125f; const size_t off = (size_t)row * D + col0;
#pragma unroll
                for (int bj = 0; bj < 2; ++bj) { const u32x2 pw = *(const u32x2*)(pp + off + bj * HALF); const u32x4 hw = *(const u32x4*)(h2b + off + bj * HALF);
                    float p[8]; fp8x4_to_f32(pw.x, p[0], p[1], p[2], p[3]); fp8x4_to_f32(pw.y, p[4], p[5], p[6], p[7]);
                    const f32x4 a0 = acc[ai][bj][m][0] * r, a1 = acc[ai][bj][m][1] * r; float o[8];
                    o[0] = bf_lo(hw.x) + sigmoidf_fast(a0[0]) * p[0]; o[1] = bf_hi(hw.x) + sigmoidf_fast(a0[1]) * p[1]; o[2] = bf_lo(hw.y) + sigmoidf_fast(a0[2]) * p[2]; o[3] = bf_hi(hw.y) + sigmoidf_fast(a0[3]) * p[3];
                    o[4] = bf_lo(hw.z) + sigmoidf_fast(a1[0]) * p[4]; o[5] = bf_hi(hw.z) + sigmoidf_fast(a1[1]) * p[5]; o[6] = bf_lo(hw.w) + sigmoidf_fast(a1[2]) * p[6]; o[7] = bf_hi(hw.w) + sigmoidf_fast(a1[3]) * p[7];
                    u32x4 w; w.x = cvt_pk_bf16(o[0], o[1]); w.y = cvt_pk_bf16(o[2], o[3]); w.z = cvt_pk_bf16(o[4], o[5]); w.w = cvt_pk_bf16(o[6], o[7]);
                    *(u32x4*)(h3 + off + bj * HALF) = w; }
                if (m & 1) asm volatile("" ::: "memory"); }
    }
};
}

struct Args { const void* in[20]; float* out; unsigned char* ws; int ph_lo, ph_hi; };
enum { I_X = 0, I_P, I_POS, I_WIN, I_WOUT, I_GNW, I_POOLW, I_POOLS, I_NMIX, I_NMOE, I_RW, I_RB, I_WGU, I_BGU, I_WD, I_BD, I_NPLE, I_WG, I_WP, I_NFIN };
constexpr int NPH = 13;

enum { WK_PLAIN = 0, WK_WIN = 1, WK_GU = 2 };
template <int KIND> __device__ __forceinline__ int dst_row(int c) {
    if (KIND == WK_WIN) { if (c < 1024) { const int sec = c >> 9, within = c & 511, head = within >> 6, d = within & 63; return (sec * 2 + (head >> 2)) * 256 + (d >> 5) * 128 + (head & 3) * 32 + (d & 31); } return c; }
    if (KIND == WK_GU) { const int a = c >> 1; return (a >> 7) * 256 + (c & 1) * 128 + (a & 127); }
    return c;
}
template <int KIND, bool OUT8> __device__ __forceinline__ void tr_item(const float* W, int K, int N, void* WT, LAS float* scr, int kb, int cb, int lane, const float* ks, float mul) {
    const int k0 = 64 * kb, c0 = 64 * cb; const bool ok = (c0 + lane) < N;
    const float* src = W + (size_t)k0 * N + c0 + lane;
    float tv[64];
#pragma unroll
    for (int kk = 0; kk < 64; ++kk) tv[kk] = ok ? src[(size_t)kk * N] : 0.f;
#pragma unroll
    for (int kk = 0; kk < 64; ++kk) scr[kk * 65 + lane] = tv[kk];
    const int c = lane & 7;
    f32x4 s0 = {mul, mul, mul, mul}, s1 = s0;
    if (ks) { s0 = *(const f32x4*)(ks + k0 + 8 * c) * mul; s1 = *(const f32x4*)(ks + k0 + 8 * c + 4) * mul; }
    LDS_WAIT(); asm volatile("" ::: "memory");
#pragma unroll
    for (int w = 0; w < 8; ++w) { const int r = (lane >> 3) + 8 * w; const LAS float* s = scr + (8 * c) * 65 + r;
        const float v0 = s[0 * 65] * s0[0], v1 = s[1 * 65] * s0[1], v2 = s[2 * 65] * s0[2], v3 = s[3 * 65] * s0[3], v4 = s[4 * 65] * s1[0], v5 = s[5 * 65] * s1[1], v6 = s[6 * 65] * s1[2], v7 = s[7 * 65] * s1[3];
        if (OUT8) { u32x2 o; o.x = cvt4_fp8(v0, v1, v2, v3); o.y = cvt4_fp8(v4, v5, v6, v7);
            if (c0 + r < N) *(u32x2*)((unsigned char*)WT + (size_t)dst_row<KIND>(c0 + r) * K + k0 + 8 * c) = o; }
        else { u32x4 o; o.x = cvt_pk_bf16(v0, v1); o.y = cvt_pk_bf16(v2, v3); o.z = cvt_pk_bf16(v4, v5); o.w = cvt_pk_bf16(v6, v7);
            if (c0 + r < N) *(u32x4*)((bf16_t*)WT + (size_t)dst_row<KIND>(c0 + r) * K + k0 + 8 * c) = o; } }
    LDS_WAIT(); asm volatile("" ::: "memory");
}
__device__ __forceinline__ void phase_prologue(const Args& a, LAS unsigned char* lds, int vcu, int G) {
    const int tid = threadIdx.x, lane = tid & 63, wave = __builtin_amdgcn_readfirstlane(tid >> 6);
    LAS float* scr = (LAS float*)(lds + wave * 16640);
    const int gw = vcu * 8 + wave, NGW = G * 8;
    unsigned char* ws = a.ws;
    constexpr int I_GU = NE * 16 * 32, I_DN = NE * 16 * 16, I_WINI = 16 * 40, I_SQ = 16 * 16, I_WPI = 4 * 16, I_RT = 16, I_PW = 4 * 4;
    constexpr int NITEMS = I_GU + I_DN + I_WINI + 2 * I_SQ + I_WPI + I_RT + I_PW;
    for (int it = gw; it < NITEMS; it += NGW) {
        int r = it;
        if (r < I_GU) { const int e = r / 512, q = r % 512; tr_item<WK_GU, MOE_F8 != 0>((const float*)a.in[I_WGU] + (size_t)e * D * 2 * DE, D, 2 * DE, ws + WS_WGU + (size_t)e * 2 * DE * D * (MOE_F8 ? 1 : 2), scr, q / 32, q % 32, lane, (const float*)a.in[I_NMOE], MOE_F8 ? 32.0f : 1.0f); continue; } r -= I_GU;
        if (r < I_DN) { const int e = r / 256, q = r % 256; tr_item<WK_PLAIN, MOE_F8 != 0>((const float*)a.in[I_WD] + (size_t)e * DE * D, DE, D, ws + WS_WD + (size_t)e * D * DE * (MOE_F8 ? 1 : 2), scr, q / 16, q % 16, lane, nullptr, MOE_F8 ? 32.0f : 1.0f); continue; } r -= I_DN;
        if (r < I_WINI) { tr_item<WK_WIN, false>((const float*)a.in[I_WIN], D, NIN, ws + WS_WIN, scr, r / 40, r % 40, lane, nullptr, 1.0f); continue; } r -= I_WINI;
        if (r < I_SQ) { tr_item<WK_PLAIN, false>((const float*)a.in[I_WOUT], D, D, ws + WS_WOUT, scr, r / 16, r % 16, lane, nullptr, 1.0f); continue; } r -= I_SQ;
        if (r < I_SQ) { tr_item<WK_PLAIN, true>((const float*)a.in[I_WG], D, D, ws + WS_WG, scr, r / 16, r % 16, lane, (const float*)a.in[I_NPLE], 32.0f); continue; } r -= I_SQ;
        if (r < I_WPI) { tr_item<WK_PLAIN, false>((const float*)a.in[I_WP], PLE, D, ws + WS_WPT, scr, r / 16, r % 16, lane, nullptr, 1.0f); continue; } r -= I_WPI;
        if (r < I_RT) { tr_item<WK_PLAIN, false>((const float*)a.in[I_RW], D, NE, ws + WS_ROUT, scr, r, 0, lane, (const float*)a.in[I_NMOE], 1.0f); continue; } r -= I_RT;
        { const int g = r / 4, q = r % 4; tr_item<WK_PLAIN, false>((const float*)a.in[I_POOLW] + (size_t)g * 128 * 128, 128, 128, ws + WS_PWT + (size_t)g * 128 * 128 * 2, scr, q / 2, q % 2, lane, nullptr, 1.0f); }
    }
    const float* x = (const float*)a.in[I_X]; const float* nw = (const float*)a.in[I_NMIX]; bf16_t* hn = (bf16_t*)(ws + WS_HN1);
    f32x4 wv[4];
#pragma unroll
    for (int j = 0; j < 4; ++j) wv[j] = *((const f32x4*)nw + lane + 64 * j);
    for (int m = gw; m < T; m += 2 * NGW) {
        const int m2 = m + NGW; const bool has2 = m2 < T;
        const f32x4* xr = (const f32x4*)(x + (size_t)m * D) + lane; const f32x4* xr2 = (const f32x4*)(x + (size_t)(has2 ? m2 : m) * D) + lane; f32x4 v[4], v2[4]; float s = 0.f, s2 = 0.f;
#pragma unroll
        for (int j = 0; j < 4; ++j) { v[j] = xr[64 * j]; v2[j] = xr2[64 * j]; }
#pragma unroll
        for (int j = 0; j < 4; ++j) { s += (v[j][0] * v[j][0] + v[j][1] * v[j][1]) + (v[j][2] * v[j][2] + v[j][3] * v[j][3]); s2 += (v2[j][0] * v2[j][0] + v2[j][1] * v2[j][1]) + (v2[j][2] * v2[j][2] + v2[j][3] * v2[j][3]); }
        const float rstd = __builtin_amdgcn_rsqf(wave_sum(s) * (1.f / D) + NORM_EPS), rstd2 = __builtin_amdgcn_rsqf(wave_sum(s2) * (1.f / D) + NORM_EPS);
        u32x2* o8 = (u32x2*)(hn + (size_t)m * D) + lane; u32x2* o82 = (u32x2*)(hn + (size_t)m2 * D) + lane;
#pragma unroll
        for (int j = 0; j < 4; ++j) { const f32x4 y = v[j] * rstd * wv[j]; u32x2 w; w.x = cvt_pk_bf16(y[0], y[1]); w.y = cvt_pk_bf16(y[2], y[3]); o8[64 * j] = w;
            if (has2) { const f32x4 y2 = v2[j] * rstd2 * wv[j]; u32x2 w2; w2.x = cvt_pk_bf16(y2[0], y2[1]); w2.y = cvt_pk_bf16(y2[2], y2[3]); o82[64 * j] = w2; } }
    }
    const f32x4* pv = (const f32x4*)a.in[I_P]; u32x2* pb = (u32x2*)(ws + WS_PB);
    for (size_t i = (size_t)vcu * 512 + tid; i < (size_t)T * PLE / 4; i += (size_t)G * 512) { const f32x4 v = pv[i]; u32x2 w; w.x = cvt_pk_bf16(v[0], v[1]); w.y = cvt_pk_bf16(v[2], v[3]); pb[i] = w; }
}

__device__ __forceinline__ int tt_off(int d, int m) { return d * 136 + ((((m >> 3) ^ ((d >> 3) & 7)) << 3) | (m & 7)); }
__device__ __forceinline__ void tt_write8(LAS bf16_t* base, int d0, int m, const u32x4 v) {
    const int blk = (((m >> 3) ^ ((d0 >> 3) & 7)) << 3) | (m & 7); LAS bf16_t* p = base + d0 * 136 + blk;
    p[0 * 136] = (bf16_t)(v.x & 0xffff); p[1 * 136] = (bf16_t)(v.x >> 16); p[2 * 136] = (bf16_t)(v.y & 0xffff); p[3 * 136] = (bf16_t)(v.y >> 16);
    p[4 * 136] = (bf16_t)(v.z & 0xffff); p[5 * 136] = (bf16_t)(v.z >> 16); p[6 * 136] = (bf16_t)(v.w & 0xffff); p[7 * 136] = (bf16_t)(v.w >> 16);
}
__device__ __forceinline__ void phase_kv(const Args& a, LAS unsigned char* lds, int G) {
    const int tid = threadIdx.x, lane = tid & 63, w = __builtin_amdgcn_readfirstlane(tid >> 6), fr = lane & 15, fq = lane >> 4;
    const bf16_t* Kb = (const bf16_t*)(a.ws + WS_K); const bf16_t* Vb = (const bf16_t*)(a.ws + WS_V); float* KV = (float*)(a.ws + WS_KV);
    const int seg = tid & 7, r0 = tid >> 3;
    u32x4 rk[2], rv[2];
    int u = blockIdx.x;
#define KV_LOAD(uu) do { const size_t tok0 = (size_t)((uu) >> 3) * CH; const int hc = ((uu) & 7) * HD; _Pragma("unroll") for (int i = 0; i < 2; ++i) { const size_t o = (tok0 + r0 + 64 * i) * 512 + hc + seg * 8; rk[i] = *(const u32x4*)(Kb + o); rv[i] = *(const u32x4*)(Vb + o); } } while (0)
    if (u < 2048) KV_LOAD(u);
    for (int buf = 0; u < 2048; u += G, buf ^= 1) {
        LAS bf16_t* KT = (LAS bf16_t*)(lds + buf * 34816); LAS bf16_t* VT = KT + 64 * 136;
#pragma unroll
        for (int i = 0; i < 2; ++i) { tt_write8(KT, seg * 8, r0 + 64 * i, rk[i]); tt_write8(VT, seg * 8, r0 + 64 * i, rv[i]); }
        __syncthreads();
        if (u + G < 2048) KV_LOAD(u + G);
        const int dt = w & 3; const float sc = __builtin_amdgcn_exp2f(127.0f * log2_gamma(u & 7));
#pragma unroll
        for (int q = 0; q < 2; ++q) { const int et = (w >> 2) * 2 + q; f32x4 acc = {0.f, 0.f, 0.f, 0.f};
#pragma unroll
            for (int ks = 0; ks < 4; ++ks) { const int d = 16 * dt + fr, e = 16 * et + fr, m0 = 32 * ks + 8 * fq;
                const bf16x8 A = *(const LAS bf16x8*)(KT + tt_off(d, m0)); const bf16x8 B = *(const LAS bf16x8*)(VT + tt_off(e, m0));
                acc = __builtin_amdgcn_mfma_f32_16x16x32_bf16(A, B, acc, 0, 0, 0); }
            *(f32x4*)(KV + (size_t)u * 4096 + (16 * et + fr) * 64 + 16 * dt + 4 * fq) = acc * sc; }
    }
#undef KV_LOAD
    __syncthreads();
}
__device__ __forceinline__ void phase_pool(const Args& a, LAS unsigned char* lds, int G) {
    const int tid = threadIdx.x, lane = tid & 63, w = __builtin_amdgcn_readfirstlane(tid >> 6), fr = lane & 15, fq = lane >> 4;
    const bf16_t* U = (const bf16_t*)(a.ws + WS_U); const bf16_t* PWt = (const bf16_t*)(a.ws + WS_PWT); bf16_t* MIX = (bf16_t*)(a.ws + WS_MIX);
    const float* pscale = (const float*)a.in[I_POOLS];
    LAS bf16_t* UB = (LAS bf16_t*)lds; LAS bf16_t* PA = (LAS bf16_t*)(lds + 38912); LAS bf16_t* PW = (LAS bf16_t*)(lds + 73728);
    int gl = -1;
    for (int u = blockIdx.x; u < (T / 128) * 4; u += G) {
        const int g = u & 3, t0 = (u >> 2) * 128;
        if (g != gl) { gl = g;
#pragma unroll
            for (int i = 0; i < 4; ++i) { const int p = tid + 512 * i, d = p >> 4, sg = p & 15; *(LAS u32x4*)(PW + d * 136 + sg * 8) = *(const u32x4*)(PWt + ((size_t)g * 128 + d) * 128 + sg * 8); } }
        const bool seq0 = (t0 & (SEQ - 1)) == 0;
#pragma unroll
        for (int i = 0; i < 5; ++i) { const int p = tid + 512 * i, lr = p >> 4, sg = p & 15;
            if (lr < 143) { u32x4 v = {0u, 0u, 0u, 0u}; if (lr >= 15 || !seq0) v = *(const u32x4*)(U + (size_t)(t0 - 15 + lr) * 512 + g * 128 + sg * 8); *(LAS u32x4*)(UB + lr * 136 + sg * 8) = v; } }
        __syncthreads();
        { const int cg = tid & 15, rg = tid >> 4, wnd = 2 << g;
#pragma unroll
          for (int q = 0; q < 4; ++q) { const int r = 4 * rg + q; const int s = (t0 + r) & (SEQ - 1); const float inv = 1.0f / (float)((s + 1) < wnd ? (s + 1) : wnd);
              float sum[8];
#pragma unroll
              for (int j = 0; j < 8; ++j) sum[j] = 0.f;
              for (int k = 0; k < wnd; ++k) { const u32x4 v = *(const LAS u32x4*)(UB + (r + 15 - k) * 136 + cg * 8);
                  sum[0] += bf_lo(v.x); sum[1] += bf_hi(v.x); sum[2] += bf_lo(v.y); sum[3] += bf_hi(v.y); sum[4] += bf_lo(v.z); sum[5] += bf_hi(v.z); sum[6] += bf_lo(v.w); sum[7] += bf_hi(v.w); }
              const u32x4 c = *(const LAS u32x4*)(UB + (r + 15) * 136 + cg * 8);
              u32x4 o; o.x = cvt_pk_bf16(sum[0] * inv - bf_lo(c.x), sum[1] * inv - bf_hi(c.x)); o.y = cvt_pk_bf16(sum[2] * inv - bf_lo(c.y), sum[3] * inv - bf_hi(c.y));
              o.z = cvt_pk_bf16(sum[4] * inv - bf_lo(c.z), sum[5] * inv - bf_hi(c.z)); o.w = cvt_pk_bf16(sum[6] * inv - bf_lo(c.w), sum[7] * inv - bf_hi(c.w));
              *(LAS u32x4*)(PA + r * 136 + cg * 8) = o; } }
        __syncthreads();
        f32x4 acc[8];
#pragma unroll
        for (int dt = 0; dt < 8; ++dt) acc[dt] = (f32x4){0.f, 0.f, 0.f, 0.f};
#pragma unroll
        for (int kk = 0; kk < 4; ++kk) { const bf16x8 B = *(const LAS bf16x8*)(PA + (16 * w + fr) * 136 + 32 * kk + 8 * fq);
#pragma unroll
            for (int dt = 0; dt < 8; ++dt) { const bf16x8 A = *(const LAS bf16x8*)(PW + (16 * dt + fr) * 136 + 32 * kk + 8 * fq); acc[dt] = __builtin_amdgcn_mfma_f32_16x16x32_bf16(A, B, acc[dt], 0, 0, 0); } }
        const size_t tok = (size_t)t0 + 16 * w + fr;
#pragma unroll
        for (int dt = 0; dt < 8; ++dt) { const int d = 16 * dt + 4 * fq; const f32x4 sc = *(const f32x4*)(pscale + g * 128 + d); const f32x4 o = acc[dt] * sc;
            u32x2 wv; wv.x = cvt_pk_bf16(o[0], o[1]); wv.y = cvt_pk_bf16(o[2], o[3]); *(u32x2*)(MIX + tok * D + 512 + g * 128 + d) = wv; }
        __syncthreads();
    }
}
__device__ __forceinline__ void phase_scan(const Args& a, int G) {
    const float* KV = (const float*)(a.ws + WS_KV); bf16_t* ST = (bf16_t*)(a.ws + WS_ST);
    for (int v = blockIdx.x * 512 + threadIdx.x; v < NBATCH * NH * 1024; v += G * 512) {
        const int bh = v >> 10, q = v & 1023, b = bh >> 3, h = bh & 7;
        const float lg = log2_gamma(h), gam = __builtin_amdgcn_exp2f(lg), cd = __builtin_amdgcn_exp2f(128.0f * lg);
        f32x4 s = {0.f, 0.f, 0.f, 0.f};
        for (int n0 = 0; n0 < NCH; n0 += 8) { f32x4 kv[8];
#pragma unroll
            for (int j = 0; j < 8; ++j) kv[j] = *(const f32x4*)(KV + ((size_t)((b * NCH + n0 + j) * NH + h)) * 4096 + q * 4);
#pragma unroll
            for (int j = 0; j < 8; ++j) { const f32x4 o = s * gam; u32x2 wv; wv.x = cvt_pk_bf16(o[0], o[1]); wv.y = cvt_pk_bf16(o[2], o[3]);
                *(u32x2*)(ST + ((size_t)((b * NCH + n0 + j) * NH + h)) * 4096 + q * 4) = wv; s = s * cd + kv[j]; } }
    }
}
__device__ __forceinline__ void phase_ret(const Args& a, LAS unsigned char* lds, int G) {
    const int tid = threadIdx.x, lane = tid & 63, w = __builtin_amdgcn_readfirstlane(tid >> 6), fr = lane & 15, fq = lane >> 4;
    const bf16_t* Qb = (const bf16_t*)(a.ws + WS_Q); const bf16_t* Kb = (const bf16_t*)(a.ws + WS_K); const bf16_t* Vb = (const bf16_t*)(a.ws + WS_V);
    const bf16_t* Gb = (const bf16_t*)(a.ws + WS_G); const bf16_t* STg = (const bf16_t*)(a.ws + WS_ST); bf16_t* MIX = (bf16_t*)(a.ws + WS_MIX);
    const float* gnw = (const float*)a.in[I_GNW];
    const int seg = tid & 7, r0 = tid >> 3;
    u32x4 rk[2], rv[2], rs; bf16x8 rq[2]; u32x2 rg[4];
    int u = blockIdx.x;
#define RT_LOAD(uu) do { const size_t tok0 = (size_t)((uu) >> 3) * CH; const int hc = ((uu) & 7) * HD; _Pragma("unroll") for (int i = 0; i < 2; ++i) { const size_t o = (tok0 + r0 + 64 * i) * 512 + hc + seg * 8; rk[i] = *(const u32x4*)(Kb + o); rv[i] = *(const u32x4*)(Vb + o); } \
        rs = *(const u32x4*)(STg + (size_t)(uu) * 4096 + r0 * 64 + seg * 8); \
        _Pragma("unroll") for (int kk = 0; kk < 2; ++kk) rq[kk] = *(const bf16x8*)(Qb + (tok0 + 16 * w + fr) * 512 + hc + 32 * kk + 8 * fq); \
        _Pragma("unroll") for (int et = 0; et < 4; ++et) rg[et] = *(const u32x2*)(Gb + (tok0 + 16 * w + fr) * 512 + hc + 16 * et + 4 * fq); } while (0)
    if (u < 2048) RT_LOAD(u);
    for (int buf = 0; u < 2048; u += G, buf ^= 1) {
        LAS bf16_t* Kr = (LAS bf16_t*)(lds + buf * 45056); LAS bf16_t* VT = Kr + 128 * 72; LAS bf16_t* SL = VT + 64 * 136;
#pragma unroll
        for (int i = 0; i < 2; ++i) { *(LAS u32x4*)(Kr + (r0 + 64 * i) * 72 + seg * 8) = rk[i]; tt_write8(VT, seg * 8, r0 + 64 * i, rv[i]); }
        *(LAS u32x4*)(SL + r0 * 72 + seg * 8) = rs;
        bf16x8 qf[2]; u32x2 gvv[4];
#pragma unroll
        for (int kk = 0; kk < 2; ++kk) qf[kk] = rq[kk];
#pragma unroll
        for (int et = 0; et < 4; ++et) gvv[et] = rg[et];
        __syncthreads();
        if (u + G < 2048) RT_LOAD(u + G);
        const size_t tok0 = (size_t)(u >> 3) * CH; const int hc = (u & 7) * HD; const size_t ctok = tok0 + 16 * w + fr;
        u32x2 pk[8];
#pragma unroll
        for (int am = 0; am < 8; ++am) {
            if (am <= w) { f32x4 s = {0.f, 0.f, 0.f, 0.f};
#pragma unroll
                for (int kk = 0; kk < 2; ++kk) { const bf16x8 A = *(const LAS bf16x8*)(Kr + (16 * am + fr) * 72 + 32 * kk + 8 * fq); s = __builtin_amdgcn_mfma_f32_16x16x32_bf16(A, qf[kk], s, 0, 0, 0); }
                if (am == w) {
#pragma unroll
                    for (int j = 0; j < 4; ++j) if (4 * fq + j > fr) s[j] = 0.f; }
                pk[am].x = cvt_pk_bf16(s[0], s[1]); pk[am].y = cvt_pk_bf16(s[2], s[3]);
            } else { pk[am].x = 0u; pk[am].y = 0u; } }
        f32x4 y[4];
#pragma unroll
        for (int et = 0; et < 4; ++et) y[et] = (f32x4){0.f, 0.f, 0.f, 0.f};
#pragma unroll
        for (int s2 = 0; s2 < 4; ++s2) {
            if (2 * s2 <= w) { u32x4 bw; bw.x = pk[2 * s2].x; bw.y = pk[2 * s2].y; bw.z = pk[2 * s2 + 1].x; bw.w = pk[2 * s2 + 1].y; const bf16x8 B = __builtin_bit_cast(bf16x8, bw);
#pragma unroll
                for (int et = 0; et < 4; ++et) { const int e = 16 * et + fr, es = (e >> 3) & 7;
                    const u32x2 lo = *(const LAS u32x2*)(VT + e * 136 + (((4 * s2 + (fq >> 1)) ^ es) << 3) + 4 * (fq & 1));
                    const u32x2 hi = *(const LAS u32x2*)(VT + e * 136 + (((4 * s2 + 2 + (fq >> 1)) ^ es) << 3) + 4 * (fq & 1));
                    u32x4 aw; aw.x = lo.x; aw.y = lo.y; aw.z = hi.x; aw.w = hi.y;
                    y[et] = __builtin_amdgcn_mfma_f32_16x16x32_bf16(__builtin_bit_cast(bf16x8, aw), B, y[et], 0, 0, 0); } } }
#pragma unroll
        for (int kk = 0; kk < 2; ++kk)
#pragma unroll
            for (int et = 0; et < 4; ++et) { const bf16x8 A = *(const LAS bf16x8*)(SL + (16 * et + fr) * 72 + 32 * kk + 8 * fq); y[et] = __builtin_amdgcn_mfma_f32_16x16x32_bf16(A, qf[kk], y[et], 0, 0, 0); }
        float s = 0.f;
#pragma unroll
        for (int et = 0; et < 4; ++et) s += (y[et][0] + y[et][1]) + (y[et][2] + y[et][3]);
        s += __shfl_xor(s, 16); s += __shfl_xor(s, 32);
        const float mean = s * (1.0f / 64.0f); float q2 = 0.f;
#pragma unroll
        for (int et = 0; et < 4; ++et) { const f32x4 d = y[et] - mean; q2 += (d[0] * d[0] + d[1] * d[1]) + (d[2] * d[2] + d[3] * d[3]); }
        q2 += __shfl_xor(q2, 16); q2 += __shfl_xor(q2, 32);
        const float rstd = __builtin_amdgcn_rsqf(q2 * (1.0f / 64.0f) + GN_EPS);
#pragma unroll
        for (int et = 0; et < 4; ++et) { const int col = hc + 16 * et + 4 * fq; const u32x2 gv = gvv[et]; const f32x4 gw = *(const f32x4*)(gnw + col);
            const float g0 = bf_lo(gv.x), g1 = bf_hi(gv.x), g2 = bf_lo(gv.y), g3 = bf_hi(gv.y);
            const float o0 = (y[et][0] - mean) * rstd * gw[0] * g0 * sigmoidf_fast(g0), o1 = (y[et][1] - mean) * rstd * gw[1] * g1 * sigmoidf_fast(g1);
            const float o2 = (y[et][2] - mean) * rstd * gw[2] * g2 * sigmoidf_fast(g2), o3 = (y[et][3] - mean) * rstd * gw[3] * g3 * sigmoidf_fast(g3);
            u32x2 wv; wv.x = cvt_pk_bf16(o0, o1); wv.y = cvt_pk_bf16(o2, o3); *(u32x2*)(MIX + ctok * D + col) = wv; }
    }
#undef RT_LOAD
    __syncthreads();
}

__device__ __forceinline__ void phase_router(const Args& a, LAS unsigned char* lds, int G) {
    const int tid = threadIdx.x, lane = tid & 63, w = __builtin_amdgcn_readfirstlane(tid >> 6), fr = lane & 15, fq = lane >> 4;
    const bf16_t* RT = (const bf16_t*)(a.ws + WS_ROUT); const bf16_t* H1W = (const bf16_t*)(a.ws + WS_HN1); const float* ssq = (const float*)(a.ws + WS_SSQ1);
    const float* rb = (const float*)a.in[I_RB];
    int* topi = (int*)(a.ws + WS_TOPI); float* topg = (float*)(a.ws + WS_TOPG); float* rstd1 = (float*)(a.ws + WS_RSTD1); int* bh = (int*)(a.ws + WS_BH);
    LAS bf16_t* RL = (LAS bf16_t*)lds;
    LAS float* LG = (LAS float*)(lds + 66048) + w * (16 * 33);
    LAS int* hist = (LAS int*)(lds + 66048 + 8 * 16 * 33 * 4);
#pragma unroll
    for (int i = 0; i < 8; ++i) { const int p = tid + 512 * i, e = p >> 7, sg = p & 127; *(LAS u32x4*)(RL + e * 1032 + sg * 8) = *(const u32x4*)(RT + (size_t)e * D + sg * 8); }
    for (int tb = blockIdx.x; tb < T / 128; tb += G) {
        if (tid < 32) hist[tid] = 0;
        __syncthreads();
        const size_t t0 = (size_t)tb * 128 + 16 * w;
        f32x4 acc0 = {0.f, 0.f, 0.f, 0.f}, acc1 = {0.f, 0.f, 0.f, 0.f};
#pragma unroll 8
        for (int kk = 0; kk < 32; ++kk) { const bf16x8 B = *(const bf16x8*)(H1W + (t0 + fr) * D + 32 * kk + 8 * fq);
            const bf16x8 A0 = *(const LAS bf16x8*)(RL + fr * 1032 + 32 * kk + 8 * fq), A1 = *(const LAS bf16x8*)(RL + (16 + fr) * 1032 + 32 * kk + 8 * fq);
            acc0 = __builtin_amdgcn_mfma_f32_16x16x32_bf16(A0, B, acc0, 0, 0, 0); acc1 = __builtin_amdgcn_mfma_f32_16x16x32_bf16(A1, B, acc1, 0, 0, 0); }
#pragma unroll
        for (int j = 0; j < 4; ++j) { LG[fr * 33 + 4 * fq + j] = acc0[j]; LG[fr * 33 + 16 + 4 * fq + j] = acc1[j]; }
        LDS_WAIT(); asm volatile("" ::: "memory");
        if (lane < 16) {
            const size_t t = t0 + lane; float sq = 0.f;
#pragma unroll
            for (int q = 0; q < 4; ++q) { const f32x4 v = *(const f32x4*)(ssq + t * 16 + 4 * q); sq += (v[0] + v[1]) + (v[2] + v[3]); }
            const float rstd = __builtin_amdgcn_rsqf(sq * (1.f / D) + NORM_EPS);
            float v0 = -3.0e38f, v1 = -3.0e38f, v2 = -3.0e38f, v3 = -3.0e38f; int i0 = 0, i1 = 0, i2 = 0, i3 = 0;
#pragma unroll
            for (int e = 0; e < NE; ++e) { const float v = LG[lane * 33 + e] * rstd + rb[e];
                if (v > v3) { if (v > v2) { v3 = v2; i3 = i2; if (v > v1) { v2 = v1; i2 = i1; if (v > v0) { v1 = v0; i1 = i0; v0 = v; i0 = e; } else { v1 = v; i1 = e; } } else { v2 = v; i2 = e; } } else { v3 = v; i3 = e; } } }
            const float e1 = __expf(v1 - v0), e2 = __expf(v2 - v0), e3 = __expf(v3 - v0), inv = 1.0f / (1.0f + e1 + e2 + e3);
            *(int4*)(topi + t * 4) = make_int4(i0, i1, i2, i3); *(float4*)(topg + t * 4) = make_float4(inv, e1 * inv, e2 * inv, e3 * inv); rstd1[t] = rstd;
            lds_inc(&hist[i0]); lds_inc(&hist[i1]); lds_inc(&hist[i2]); lds_inc(&hist[i3]);
        }
        __syncthreads();
        if (tid < 32) bh[tb * 32 + tid] = hist[tid];
        __syncthreads();
    }
}
__device__ __forceinline__ void vtab_put(unsigned* vt, int pos, unsigned tok) {
    const int tile = pos >> 8, r = pos & 255, hh = r >> 7, R = r & 127, rg = R >> 4, rr = R & 15;
#pragma unroll
    for (int ch = 0; ch < 2; ++ch)
#pragma unroll
        for (int p = 0; p < 4; ++p) { const int st = rg * 2 + ch, ob = rr * 64 + p * 16, sb = ob ^ (((ob >> 9) & 1) << 5), b = st * 1024 + sb, i = b >> 13, td = (b & 8191) >> 4;
            vt[((size_t)tile * 512 + td) * 4 + hh * 2 + i] = tok * (unsigned)(MOE_F8 ? D : 2 * D) + ch * 64 + p * 16; }
}
__device__ __forceinline__ void phase_place(const Args& a, LAS unsigned char* lds, int G) {
    const int tid = threadIdx.x;
    const int* bh = (const int*)(a.ws + WS_BH); const int* topi = (const int*)(a.ws + WS_TOPI); const float* topg = (const float*)(a.ws + WS_TOPG); const float* rstd1 = (const float*)(a.ws + WS_RSTD1);
    int* spos = (int*)(a.ws + WS_SPOS); float* SG = (float*)(a.ws + WS_SG); float* SR = (float*)(a.ws + WS_SR); unsigned* vt = (unsigned*)(a.ws + WS_VTAB);
    unsigned* ctl = (unsigned*)(a.ws + WS_CTL);
    LAS int* pt = (LAS int*)lds; LAS int* pb = pt + 512; LAS int* tot = pb + 512; LAS int* off = tot + 32; LAS int* base = off + 32; LAS int* rank = base + 32;
    constexpr int NTB = T / 128;
    for (int it = 0, tb = blockIdx.x; it == 0 || tb < NTB; ++it, tb += G) {
        const int e = tid & 31, part = tid >> 5; int st = 0, sb = 0;
        for (int b = part; b < NTB; b += 16) { const int v = bh[b * 32 + e]; st += v; if (b < tb) sb += v; }
        pt[tid] = st; pb[tid] = sb;
        __syncthreads();
        if (tid < 32) { int s1 = 0, s2 = 0;
#pragma unroll
            for (int q = 0; q < 16; ++q) { s1 += pt[q * 32 + tid]; s2 += pb[q * 32 + tid]; }
            tot[tid] = s1; base[tid] = s2; rank[tid] = 0; }
        __syncthreads();
        if (tid == 0) { int o = 0; for (int q = 0; q < NE; ++q) { off[q] = o; o += (tot[q] + 255) & ~255; } }
        __syncthreads();
        if (tb < NTB) {
            const int t = tb * 128 + (tid >> 2), k = tid & 3; const int ex = topi[t * 4 + k];
            const int pos = off[ex] + base[ex] + lds_inc(&rank[ex]);
            spos[t * 4 + k] = pos; SG[pos] = topg[t * 4 + k]; SR[pos] = rstd1[t]; vtab_put(vt, pos, (unsigned)t);
        }
        if (it == 0) {
            for (int ex = blockIdx.x; ex < NE; ex += G) { const int n = tot[ex], np = (n + 255) & ~255;
                for (int r = n + tid; r < np; r += 512) { const int pos = off[ex] + r; SG[pos] = 0.f; SR[pos] = 0.f; vtab_put(vt, pos, 0u); } }
            if (blockIdx.x == 0 && tid < 32) ctl[CW_TOT + tid] = (unsigned)tot[tid];
        }
        __syncthreads();
    }
}
__device__ __forceinline__ int build_tiles(const Args& a, LAS unsigned short* te) {
    const unsigned* ctl = (const unsigned*)(a.ws + WS_CTL);
    int o = 0;
    for (int e = 0; e < NE; ++e) { const int n = (int)((ctl[CW_TOT + e] + 255u) >> 8); for (int q = threadIdx.x; q < n; q += 512) te[o + q] = (unsigned short)e; o += n; }
    __syncthreads();
    return o;
}
__device__ __forceinline__ void phase_combine(const Args& a, int vcu, int G) {
    const int tid = threadIdx.x, lane = tid & 63, wave = tid >> 6; const int gw = vcu * 8 + wave, NGW = G * 8;
    bf16_t* hb = (bf16_t*)(a.ws + WS_HN1); unsigned char* h8 = a.ws + WS_H1F8; const unsigned char* Y = a.ws + WS_Y; const int* spos = (const int*)(a.ws + WS_SPOS); float* rstd2 = (float*)(a.ws + WS_RSTD2);
    for (int t = gw; t < T; t += NGW) {
        const int4 ps = *(const int4*)(spos + (size_t)t * 4);
        float v[2][8], y[2][8]; float s = 0.f;
#pragma unroll
        for (int j = 0; j < 2; ++j) { const u32x4 hv = *(const u32x4*)(hb + (size_t)t * D + 8 * lane + 512 * j);
            v[j][0] = bf_lo(hv.x); v[j][1] = bf_hi(hv.x); v[j][2] = bf_lo(hv.y); v[j][3] = bf_hi(hv.y); v[j][4] = bf_lo(hv.z); v[j][5] = bf_hi(hv.z); v[j][6] = bf_lo(hv.w); v[j][7] = bf_hi(hv.w);
#pragma unroll
            for (int q = 0; q < 8; ++q) y[j][q] = 0.f; }
#pragma unroll
        for (int k = 0; k < 4; ++k) { const int pk = k == 0 ? ps.x : (k == 1 ? ps.y : (k == 2 ? ps.z : ps.w));
#pragma unroll
            for (int j = 0; j < 2; ++j) { const u32x2 yv = *(const u32x2*)(Y + (size_t)pk * D + 8 * lane + 512 * j); float f[8];
                fp8x4_to_f32(yv.x, f[0], f[1], f[2], f[3]); fp8x4_to_f32(yv.y, f[4], f[5], f[6], f[7]);
#pragma unroll
                for (int q = 0; q < 8; ++q) y[j][q] += f[q]; } }
#pragma unroll
        for (int j = 0; j < 2; ++j) {
#pragma unroll
            for (int q = 0; q < 8; ++q) { v[j][q] += y[j][q] * 0.0625f; s += v[j][q] * v[j][q]; }
            u32x4 o; o.x = cvt_pk_bf16(v[j][0], v[j][1]); o.y = cvt_pk_bf16(v[j][2], v[j][3]); o.z = cvt_pk_bf16(v[j][4], v[j][5]); o.w = cvt_pk_bf16(v[j][6], v[j][7]);
            *(u32x4*)(hb + (size_t)t * D + 8 * lane + 512 * j) = o;
            u32x2 o8; o8.x = cvt4_fp8(v[j][0], v[j][1], v[j][2], v[j][3]); o8.y = cvt4_fp8(v[j][4], v[j][5], v[j][6], v[j][7]);
            *(u32x2*)(h8 + (size_t)t * D + 8 * lane + 512 * j) = o8; }
        s = wave_sum(s);
        if (lane == 0) rstd2[t] = __builtin_amdgcn_rsqf(s * (1.f / D) + NORM_EPS);
    }
}
__device__ __forceinline__ void phase_final(const Args& a, int vcu, int G) {
    const int tid = threadIdx.x, lane = tid & 63, wave = tid >> 6; const int gw = vcu * 8 + wave, NGW = G * 8;
    float* out = a.out; const bf16_t* h3 = (const bf16_t*)(a.ws + WS_H3B); const float* nw = (const float*)a.in[I_NFIN];
    f32x4 wv[2][2];
#pragma unroll
    for (int j = 0; j < 2; ++j) { wv[j][0] = *(const f32x4*)(nw + 8 * lane + 512 * j); wv[j][1] = *(const f32x4*)(nw + 8 * lane + 512 * j + 4); }
    float scale = 1.0f;
#if MK_DEBUG
    { const unsigned f = *(const unsigned*)(a.ws + WS_CTL + 4 * CW_FAIL); if (f) scale = 1.0f + 0.1f * (float)__builtin_ctz(f); }
#endif
    for (int t = gw; t < T; t += NGW) {
        f32x4 v[2][2]; float s = 0.f;
#pragma unroll
        for (int j = 0; j < 2; ++j) { const u32x4 hv = *(const u32x4*)(h3 + (size_t)t * D + 8 * lane + 512 * j);
            v[j][0] = (f32x4){bf_lo(hv.x), bf_hi(hv.x), bf_lo(hv.y), bf_hi(hv.y)}; v[j][1] = (f32x4){bf_lo(hv.z), bf_hi(hv.z), bf_lo(hv.w), bf_hi(hv.w)};
            s += (v[j][0][0] * v[j][0][0] + v[j][0][1] * v[j][0][1]) + (v[j][0][2] * v[j][0][2] + v[j][0][3] * v[j][0][3]) + (v[j][1][0] * v[j][1][0] + v[j][1][1] * v[j][1][1]) + (v[j][1][2] * v[j][1][2] + v[j][1][3] * v[j][1][3]); }
        const float rstd = __builtin_amdgcn_rsqf(wave_sum(s) * (1.f / D) + NORM_EPS) * scale;
#pragma unroll
        for (int j = 0; j < 2; ++j) { *(f32x4*)(out + (size_t)t * D + 8 * lane + 512 * j) = v[j][0] * rstd * wv[j][0]; *(f32x4*)(out + (size_t)t * D + 8 * lane + 512 * j + 4) = v[j][1] * rstd * wv[j][1]; }
    }
}

__global__ void __launch_bounds__(512, 2) fwd_kernel(Args args) {
    extern __shared__ __attribute__((aligned(16))) unsigned char lds_raw[];
    LAS unsigned char* lds = (LAS unsigned char*)lds_raw;
    const int tid = threadIdx.x, G = gridDim.x;
    const int vcu = (G % 8 == 0) ? ((int)blockIdx.x % 8) * (G / 8) + (int)blockIdx.x / 8 : (int)blockIdx.x;
    volatile LAS unsigned* MISC = (volatile LAS unsigned*)(lds + LCTL_OFF);
    if (tid < 4) MISC[tid] = 0u;
    __syncthreads();
    unsigned* ctl = (unsigned*)(args.ws + WS_CTL);
    XcdBarrier bar; bar.bar = ctl + CW_BAR; bar.x = 0; bar.st = nullptr;
    const int lo = args.ph_lo, hi = args.ph_hi;
    if (hi - lo > 1) bar = xcd_barrier_post(ctl + CW_BAR, MISC);
#ifndef PH_MASK
#define PH_MASK 0x1fff
#endif
#define IN(k) (((PH_MASK >> (k)) & 1) && lo <= (k) && (k) < hi)
#define SEAM(k) do { if (IN(k) && IN((k) + 1)) xcd_barrier(bar); } while (0)
    LAS unsigned short* te = (LAS unsigned short*)(lds + LCTL_OFF + 64);
    const char* ws = (const char*)args.ws;

    if (IN(0)) phase_prologue(args, lds, vcu, G);
    SEAM(0);
    if (IN(1)) {
        { pg8::DenseSched S; S.init(T, NIN, G, (int)blockIdx.x);
          pg8::EpiInProj E{(bf16_t*)(args.ws + WS_Q), (const int*)args.in[I_POS]};
          pg8::gemm_phase<false>(lds, ws + WS_HN1, ws + WS_WIN, D * 2, S, E); }
        { pg8::DenseSched S; S.init(T, D, G, (int)blockIdx.x);
          pg8::EpiPlainF8 E{args.ws + WS_PP, D};
          pg8::gemm_phase<false>(lds, ws + WS_PB, ws + WS_WPT, PLE * 2, S, E); }
    }
    SEAM(1);
    if (IN(2)) { phase_kv(args, lds, G); phase_pool(args, lds, G); }
    SEAM(2);
    if (IN(3)) phase_scan(args, G);
    SEAM(3);
    if (IN(4)) phase_ret(args, lds, G);
    SEAM(4);
    if (IN(5)) {
        pg8::DenseSched S; S.init(T, D, G, (int)blockIdx.x);
        pg8::EpiWout E{(const float*)args.in[I_X], (bf16_t*)(args.ws + WS_HN1), args.ws + WS_H1F8, (float*)(args.ws + WS_SSQ1)};
        pg8::gemm_phase<false>(lds, ws + WS_MIX, ws + WS_WOUT, D * 2, S, E);
    }
    SEAM(5);
    if (IN(6)) phase_router(args, lds, G);
    SEAM(6);
    if (IN(7)) phase_place(args, lds, G);
    SEAM(7);
    if (IN(8)) {
        const int MT = build_tiles(args, te);
        pg8::GroupSchedG S; S.nM = MT; S.nN = 2 * DE / 256; S.G = G; S.c = (int)blockIdx.x; S.NB = 2 * DE; S.te = te; S.vtab = args.ws + WS_VTAB;
        pg8::EpiGateUp E{args.ws + WS_ACT, (const float*)args.in[I_BGU], (const float*)(args.ws + WS_SR)};
        pg8::gemm_phase<MOE_F8 != 0>(lds, MOE_F8 ? ws + WS_H1F8 : ws + WS_HN1, ws + WS_WGU, MOE_F8 ? D : 2 * D, S, E);
    }
    SEAM(8);
    if (IN(9)) {
        const int MT = build_tiles(args, te);
        pg8::GroupSchedD S; S.nM = MT; S.nN = D / 256; S.G = G; S.c = (int)blockIdx.x; S.NB = D; S.te = te; S.vtab = nullptr;
        pg8::EpiDown E{args.ws + WS_Y, (const float*)args.in[I_BD], (const float*)(args.ws + WS_SG)};
        pg8::gemm_phase<MOE_F8 != 0>(lds, ws + WS_ACT, ws + WS_WD, MOE_F8 ? DE : 2 * DE, S, E);
    }
    SEAM(9);
    if (IN(10)) phase_combine(args, vcu, G);
    SEAM(10);
    if (IN(11)) {
        pg8::DenseSched S; S.init(T, D, G, (int)blockIdx.x);
        pg8::EpiPle E{(bf16_t*)(args.ws + WS_H3B), (const bf16_t*)(args.ws + WS_HN1), args.ws + WS_PP, (const float*)(args.ws + WS_RSTD2)};
        pg8::gemm_phase<true>(lds, ws + WS_H1F8, ws + WS_WG, D, S, E);
    }
    SEAM(11);
    if (IN(12)) phase_final(args, vcu, G);
#undef IN
#undef SEAM
}


extern "C" void kernel_launch(void* const* d_in, const int* in_sizes, int n_in, void* d_out, int out_size, void* d_ws, size_t ws_size, hipStream_t stream) {
    static int grid = 0;
    if (grid == 0) {
        if (n_in != 20 || in_sizes[0] != T * D || out_size != T * D || ws_size < WS_END) { fprintf(stderr, "kernel_launch: unexpected shapes (n_in %d, in0 %d, out %d, ws %zu < %zu)\n", n_in, n_in > 0 ? in_sizes[0] : -1, out_size, ws_size, (size_t)WS_END); grid = -1; return; }
        int dev = 0, cus = 0, per_cu = 0;
        if (hipGetDevice(&dev) != hipSuccess || hipDeviceGetAttribute(&cus, hipDeviceAttributeMultiprocessorCount, dev) != hipSuccess) { grid = -1; return; }
        if (hipFuncSetAttribute((const void*)fwd_kernel, hipFuncAttributeMaxDynamicSharedMemorySize, LDS_BYTES) != hipSuccess) { fprintf(stderr, "kernel_launch: hipFuncSetAttribute failed\n"); grid = -1; return; }
        if (hipOccupancyMaxActiveBlocksPerMultiprocessor(&per_cu, (const void*)fwd_kernel, 512, LDS_BYTES) != hipSuccess || per_cu < 1) { fprintf(stderr, "kernel_launch: occupancy query says %d\n", per_cu); (void)hipGetLastError(); }
        grid = cus;
    }
    if (grid < 0) return;
    if (hipMemsetAsync((char*)d_ws + WS_CTL, 0, CTL_ZERO_BYTES, stream) != hipSuccess) return;
    Args a{};
    for (int i = 0; i < 20; ++i) a.in[i] = d_in[i];
    a.out = (float*)d_out; a.ws = (unsigned char*)d_ws;
#if MK_PER_PHASE
    for (int p = 0; p < NPH; ++p) { a.ph_lo = p; a.ph_hi = p + 1; for (int r = 0; r < 1 + ((MK_REPEAT >> p) & 1); ++r) hipLaunchKernelGGL(fwd_kernel, dim3(grid), dim3(512), LDS_BYTES, stream, a); }
#else
    a.ph_lo = 0; a.ph_hi = NPH; hipLaunchKernelGGL(fwd_kernel, dim3(grid), dim3(512), LDS_BYTES, stream, a);
#endif
}
```

```cpp
#include <hip/hip_runtime.h>
#include <cstdio>
#include <cstdint>

#ifndef MK_PER_PHASE
#define MK_PER_PHASE 0
#endif
#ifndef MOE_F8
#define MOE_F8 1
#endif
#ifndef MK_REPEAT
#define MK_REPEAT 0x0
#endif
#ifndef MK_DEBUG
#define MK_DEBUG 0
#endif

#define GAS __attribute__((address_space(1)))
#define LAS __attribute__((address_space(3)))
typedef unsigned short bf16_t;
typedef short bf16x8 __attribute__((ext_vector_type(8)));
typedef float f32x4 __attribute__((ext_vector_type(4)));
typedef float f32x2 __attribute__((ext_vector_type(2)));
typedef unsigned u32x4 __attribute__((ext_vector_type(4)));
typedef unsigned u32x2 __attribute__((ext_vector_type(2)));
typedef int v8i __attribute__((ext_vector_type(8)));
typedef int v4i __attribute__((ext_vector_type(4)));

constexpr int T = 32768, D = 1024, SEQ = 4096, NBATCH = 8, NH = 8, HD = 64, CH = 128, NCH = 32;
constexpr int DRET = 512, DPOOL = 512, NIN = 2560, NE = 32, TOPK = 4, DE = 1024, PLE = 256;
constexpr float NORM_EPS = 1e-5f, GN_EPS = 1e-5f;
constexpr int MAXROWS = T * TOPK + NE * 256;
constexpr int MAXT = MAXROWS / 256;

constexpr size_t MiB = 1u << 20, KiB = 1u << 10;
constexpr size_t WS_CTL = 0, CTL_ZERO_BYTES = 64 * KiB;
constexpr size_t WS_ROUT = 1 * MiB, WS_PWT = 1 * MiB + 64 * KiB, WS_WPT = 1 * MiB + 256 * KiB;
constexpr size_t WS_TOPI = 2 * MiB, WS_TOPG = 2 * MiB + 512 * KiB, WS_SPOS = 3 * MiB, WS_RSTD1 = 3 * MiB + 512 * KiB, WS_RSTD2 = 3 * MiB + 640 * KiB, WS_BH = 3 * MiB + 768 * KiB;
constexpr size_t WS_SG = 4 * MiB, WS_SR = 5 * MiB, WS_SSQ1 = 6 * MiB, WS_VTAB = 8 * MiB;
constexpr size_t WS_WIN = 16 * MiB, WS_WOUT = 21 * MiB, WS_WG = 23 * MiB;
constexpr size_t WS_WGU = 32 * MiB, WS_WD = 160 * MiB, WS_PP = 224 * MiB;
constexpr size_t WS_HN1 = 288 * MiB  , WS_PB = 352 * MiB;
constexpr size_t WS_Q = 368 * MiB, WS_K = 400 * MiB, WS_V = 432 * MiB, WS_G = 464 * MiB, WS_U = 496 * MiB;
constexpr size_t WS_KV = 528 * MiB, WS_ST = 560 * MiB, WS_MIX = 576 * MiB;
constexpr size_t WS_H1F8 = 496 * MiB;
constexpr size_t WS_H3B = 368 * MiB;
constexpr size_t WS_ACT = 352 * MiB, WS_Y = 624 * MiB, WS_END = 896 * MiB;
static_assert(WS_K - WS_Q == (size_t)T * 512 * 2 && WS_V - WS_K == WS_K - WS_Q && WS_G - WS_V == WS_K - WS_Q && WS_U - WS_G == WS_K - WS_Q, "q|k|v|g|u equally spaced");
static_assert(WS_VTAB + (size_t)MAXT * 512 * 16 <= WS_WIN && WS_ACT + (size_t)MAXROWS * DE * 2 <= WS_Y && WS_Y + (size_t)MAXROWS * D * 2 <= WS_END, "ws map");
constexpr int CW_TMO = 0, CW_CODE = 1, CW_FAIL = 2, CW_TOT = 64, CW_BAR = 4096;

constexpr int VOFF_OFF = 131072;
constexpr int LCTL_OFF = 147456;
constexpr int LDS_BYTES = 151552;

#define LDS_WAIT() asm volatile("s_waitcnt lgkmcnt(0)" ::: "memory")
#define VM_WAIT() asm volatile("s_waitcnt vmcnt(0)" ::: "memory")
__device__ __forceinline__ unsigned cvt_pk_bf16(float lo, float hi) { unsigned r; asm volatile("v_cvt_pk_bf16_f32 %0, %1, %2" : "=v"(r) : "v"(lo), "v"(hi)); return r; }
__device__ __forceinline__ unsigned cvt4_fp8(float a, float b, float c, float d) { int w = __builtin_amdgcn_cvt_pk_fp8_f32(a, b, 0, false); w = __builtin_amdgcn_cvt_pk_fp8_f32(c, d, w, true); return (unsigned)w; }
__device__ __forceinline__ bf16x8 v8lo(const v8i x) { const v4i t = x.lo; return __builtin_bit_cast(bf16x8, t); }
__device__ __forceinline__ bf16x8 v8hi(const v8i x) { const v4i t = x.hi; return __builtin_bit_cast(bf16x8, t); }
__device__ __forceinline__ void fp8x4_to_f32(unsigned w, float& a, float& b, float& c, float& d) { const f32x2 lo = __builtin_amdgcn_cvt_pk_f32_fp8((int)w, false), hi = __builtin_amdgcn_cvt_pk_f32_fp8((int)w, true); a = lo[0]; b = lo[1]; c = hi[0]; d = hi[1]; }
__device__ __forceinline__ float bf_lo(unsigned w) { return __uint_as_float(w << 16); }
__device__ __forceinline__ float bf_hi(unsigned w) { return __uint_as_float(w & 0xffff0000u); }
__device__ __forceinline__ float wave_sum(float v) {
#pragma unroll
    for (int o = 1; o < 64; o <<= 1) v += __shfl_xor(v, o);
    return v;
}
__device__ __forceinline__ float sigmoidf_fast(float x) { return __builtin_amdgcn_rcpf(1.0f + __builtin_amdgcn_exp2f(-1.4426950408889634f * x)); }
__device__ __forceinline__ int lds_inc(LAS int* p) { return __hip_atomic_fetch_add(p, 1, __ATOMIC_RELAXED, __HIP_MEMORY_SCOPE_WORKGROUP); }
__device__ __forceinline__ float log2_gamma(int h) {
    const float x = __builtin_amdgcn_exp2f(-(float)(5 + h));
    const float ln = -x * (1.0f + x * (0.5f + x * (0.33333333f + x * (0.25f + x * 0.2f))));
    return ln * 1.4426950408889634f;
}

#define XB_TMO      128
#define XB_XCNT(j)  (256  + 64 * (j))
#define XB_XSUB(j)  (1280 + 64 * (j))
#define XB_XGEN(j)  (2304 + 64 * (j))
#define XB_TOP      3328
#define XB_TOPGEN   3392
#define XCD_BAR_WORDS 3456
#define XB_SPIN_CAP (1u << 18)
__device__ __forceinline__ unsigned xb_ld(unsigned* p)              { return __hip_atomic_load(p, __ATOMIC_RELAXED, __HIP_MEMORY_SCOPE_AGENT); }
__device__ __forceinline__ unsigned xb_add(unsigned* p, unsigned v) { return __hip_atomic_fetch_add(p, v, __ATOMIC_RELAXED, __HIP_MEMORY_SCOPE_AGENT); }
__device__ __forceinline__ unsigned xb_xcc_id() { return (unsigned)__builtin_amdgcn_s_getreg((3 << 11) | 20) & 0xFu; }
#define XB_SPIN(cond, bar) do { unsigned _sp = 0; while (cond) { __builtin_amdgcn_s_sleep(1); \
    if ((++_sp & 255u) == 0u) { if (xb_ld(&(bar)[XB_TMO])) break; if (_sp > XB_SPIN_CAP) { atomicAdd(&(bar)[XB_TMO], 1u); break; } } } } while (0)
struct XcdBarrier { unsigned* bar; unsigned x; volatile LAS unsigned* st; };
__device__ __forceinline__ XcdBarrier xcd_barrier_post(unsigned* bar, volatile LAS unsigned* st) {
    XcdBarrier b; b.bar = bar; b.x = xb_xcc_id(); b.st = st;
    if (threadIdx.x == 0) (void)xb_add(&bar[XB_XCNT(b.x)], 1u);
    return b;
}
__device__ __forceinline__ void xcd_barrier_complete(unsigned* bar, unsigned x, unsigned& nloc, unsigned& nx) {
    const unsigned G = gridDim.x * gridDim.y * gridDim.z;
    unsigned sum, cnt, mine, sp = 0u;
    for (;;) {
        sum = 0u; cnt = 0u; mine = 0u;
#pragma unroll
        for (unsigned j = 0; j < 16; ++j) { const unsigned c = xb_ld(&bar[XB_XCNT(j)]); sum += c; cnt += (c > 0u) ? 1u : 0u; mine = (j == x) ? c : mine; }
        if (sum == G) break;
        __builtin_amdgcn_s_sleep(1);
        if ((++sp & 255u) == 0u) { if (xb_ld(&bar[XB_TMO])) break; if (sp > XB_SPIN_CAP) { atomicAdd(&bar[XB_TMO], 1u); break; } }
    }
    nloc = mine > 0u ? mine : 1u; nx = cnt > 0u ? cnt : 1u;
}
__device__ __forceinline__ void xcd_barrier(const XcdBarrier& b) {
    asm volatile("s_waitcnt vmcnt(0)" ::: "memory");
    __syncthreads();
    if (threadIdx.x == 0) {
        unsigned* bar = b.bar;
        __builtin_amdgcn_s_waitcnt(0);
        unsigned nloc = b.st[0], nx = b.st[1];
        if (nloc == 0u) { xcd_barrier_complete(bar, b.x, nloc, nx); b.st[0] = nloc; b.st[1] = nx; }
        const unsigned old = xb_add(&bar[XB_XSUB(b.x)], 1u);
        const unsigned gen = old / nloc;
        if (old + 1u == (gen + 1u) * nloc) {
            __builtin_amdgcn_fence(__ATOMIC_RELEASE, "agent");
            asm volatile("s_waitcnt vmcnt(0)" ::: "memory");
            const unsigned og = xb_add(&bar[XB_TOP], 1u);
            const unsigned tg = og / nx;
            if (og + 1u == (tg + 1u) * nx) xb_add(&bar[XB_TOPGEN], 1u);
            else XB_SPIN(xb_ld(&bar[XB_TOPGEN]) == tg, bar);
            __builtin_amdgcn_fence(__ATOMIC_ACQUIRE, "agent");
            xb_add(&bar[XB_XGEN(b.x)], 1u);
            asm volatile("s_waitcnt vmcnt(0)" ::: "memory");
        } else {
            XB_SPIN(xb_ld(&bar[XB_XGEN(b.x)]) == gen, bar);
            __builtin_amdgcn_fence(__ATOMIC_ACQUIRE, "agent");
            asm volatile("s_waitcnt vmcnt(0)" ::: "memory");
        }
    }
    __syncthreads();
}

namespace pg8 {
constexpr int BM = 256, BK = 64, HALF = 128, HTB = HALF * BK * 2, STAGE_BYTES = 8 * HTB, NXCD = 8, WGM = 8;
__host__ __device__ __forceinline__ int lds_byte(int r, int c) { const int st = (r >> 4) * 2 + (c >> 5), rr = r & 15, cc = c & 31, ob = rr * 64 + cc * 2; return st * 1024 + (ob ^ (((ob >> 9) & 1) << 5)); }
__host__ __device__ __forceinline__ void stage_rc(int b, int& R, int& C) { const int st = b / 1024, sb = b % 1024, swz = sb ^ (((sb >> 9) & 1) << 5); R = (st >> 1) * 16 + swz / 64; C = (st & 1) * 32 + (swz % 64) / 2; }
__host__ __device__ __forceinline__ int perm32(int rho) { const int n = rho >> 4, i = rho & 15; return 8 * (i >> 2) + 4 * n + (i & 3); }
struct Unit { int pm, pn, e; };
__device__ __forceinline__ bool order_next(int i, int G, int c, int nM, int nN, int& pm, int& pn) {
    const int nwg = nM * nN; const long L = (long)i * G + c; if (L >= nwg) return false;
    int wgid = (int)L; { const int q = nwg / NXCD, r = nwg % NXCD, xcd = wgid % NXCD, off = wgid / NXCD; wgid = (xcd < r ? xcd * (q + 1) : r * (q + 1) + (xcd - r) * q) + off; }
    const int nig = WGM * nN, gid = wgid / nig, fm = gid * WGM, gsz = (nM - fm) < WGM ? (nM - fm) : WGM;
    pm = fm + ((wgid % nig) % gsz); pn = (wgid % nig) / gsz; return true;
}
struct DenseSched {
    static constexpr bool GATHER = false;
    int nM, nN, G, c; const unsigned char* vtab;
    __device__ __forceinline__ void init(int M, int N, int G_, int c_) { nM = M / BM; nN = N / BM; G = G_; c = c_; vtab = nullptr; }
    __device__ __forceinline__ bool next(int i, Unit& u) const { u.e = 0; return order_next(i, G, c, nM, nN, u.pm, u.pn); }
    __device__ __forceinline__ size_t b_off(const Unit& u, int RB) const { return (size_t)u.pn * BM * RB; }
};
struct GroupSched {
    static constexpr bool GATHER_ = false;
    int nM, nN, G, c, NB; const LAS unsigned short* te; const unsigned char* vtab;
    __device__ __forceinline__ bool next(int i, Unit& u) const { if (!order_next(i, G, c, nM, nN, u.pm, u.pn)) return false; u.e = __builtin_amdgcn_readfirstlane((int)te[u.pm]); return true; }
    __device__ __forceinline__ size_t b_off(const Unit& u, int RB) const { return ((size_t)u.e * NB + (size_t)u.pn * BM) * RB; }
};
struct GroupSchedG : GroupSched { static constexpr bool GATHER = true; };
struct GroupSchedD : GroupSched { static constexpr bool GATHER = false; };

template <bool F8, class Epi, class Sched>
__device__ __forceinline__ void gemm_phase(LAS unsigned char* lds, const char* A, const char* Bt, const int RB, const Sched& S, const Epi& E) {
    const int tid = threadIdx.x, wid = __builtin_amdgcn_readfirstlane(tid >> 6), lane = tid & 63, wr = wid >> 2, wc = wid & 3, fr = lane & 15, fq = lane >> 4;
    const int nt = RB / 128;
    unsigned voffB[2], cA[2]; int RA[2];
#pragma unroll
    for (int i = 0; i < 2; ++i) { int R, C; stage_rc(tid * 16 + i * 8192, R, C); const int Rb = Epi::PERM ? ((R & ~31) + perm32(R & 31)) : R;
        RA[i] = R; cA[i] = (unsigned)C * 2u; voffB[i] = (unsigned)(Rb * RB) + (unsigned)C * 2u; }
    const size_t kstep = (size_t)(BK * 2);
    const size_t hstep = (size_t)HALF * RB;
    const unsigned ldsw = (unsigned)wid * 1024u;
    const int aoff = lds_byte(wr * 64 + fr, fq * 8), boff = lds_byte(wc * 32 + fr, fq * 8);
#define PG8_SA(b, h) (((b) * 2 + (h)) * HTB)
#define PG8_SB(b, h) ((4 + (b) * 2 + (h)) * HTB)
#define PG8_STAGE(bufoff, gbase, voff) do { _Pragma("unroll") for (int _i = 0; _i < 2; ++_i) \
        __builtin_amdgcn_global_load_lds((const unsigned*)((const char*)(gbase) + (voff)[_i]), (LAS unsigned*)(lds + (bufoff) + ldsw + _i * 8192), 16, 0, 0); } while (0)
#define PG8_LDA(dst, b, h) do { _Pragma("unroll") for (int m = 0; m < 4; ++m) { dst[m].lo = *(const LAS v4i*)(lds + (b) + PG8_SA(0, h) + aoff + m * 2048); dst[m].hi = *(const LAS v4i*)(lds + (b) + PG8_SA(0, h) + aoff + m * 2048 + 1024); } } while (0)
#define PG8_LDB(dst, b, h) do { _Pragma("unroll") for (int n = 0; n < 2; ++n) { dst[n].lo = *(const LAS v4i*)(lds + (b) + PG8_SB(0, h) + boff + n * 2048); dst[n].hi = *(const LAS v4i*)(lds + (b) + PG8_SB(0, h) + boff + n * 2048 + 1024); } } while (0)
#define PG8_MMA(ai, bj, At, Bt_) do { __builtin_amdgcn_s_setprio(1); _Pragma("unroll") for (int m = 0; m < 4; ++m) _Pragma("unroll") for (int n = 0; n < 2; ++n) { \
        if constexpr (F8) acc[ai][bj][m][n] = __builtin_amdgcn_mfma_scale_f32_16x16x128_f8f6f4(Bt_[n], At[m], acc[ai][bj][m][n], 0, 0, 0, 0, 0, 0); \
        else { acc[ai][bj][m][n] = __builtin_amdgcn_mfma_f32_16x16x32_bf16(v8lo(Bt_[n]), v8lo(At[m]), acc[ai][bj][m][n], 0, 0, 0); \
               acc[ai][bj][m][n] = __builtin_amdgcn_mfma_f32_16x16x32_bf16(v8hi(Bt_[n]), v8hi(At[m]), acc[ai][bj][m][n], 0, 0, 0); } } \
        __builtin_amdgcn_s_setprio(0); } while (0)
#define PG8_WAIT_V(n) asm volatile("s_waitcnt vmcnt(" #n ")" ::: "memory")
#define PG8_WAIT_L(n) asm volatile("s_waitcnt lgkmcnt(" #n ")" ::: "memory")
#define PG8_BAR __builtin_amdgcn_s_barrier()
#define PG8_SCHED __builtin_amdgcn_sched_barrier(0)
#define PG8_DENSE_V(v, u) do { _Pragma("unroll") for (int _h = 0; _h < 2; ++_h) _Pragma("unroll") for (int _i = 0; _i < 2; ++_i) (v)[_h][_i] = (unsigned)((u).pm * BM + _h * HALF + RA[_i]) * (unsigned)RB + cA[_i]; } while (0)
    Unit cur, nxt; int ui = 0;
    if (!S.next(0, cur)) return;
    f32x4 acc[2][2][4][2];
#pragma unroll
    for (int a = 0; a < 2; ++a)
#pragma unroll
        for (int b = 0; b < 2; ++b)
#pragma unroll
            for (int m = 0; m < 4; ++m)
#pragma unroll
                for (int n = 0; n < 2; ++n) acc[a][b][m][n] = (f32x4){0.f, 0.f, 0.f, 0.f};
    v8i At[4], B0[2], B1[2];
    unsigned vc[2][2], v2[2][2];
    if constexpr (Sched::GATHER) {
        __builtin_amdgcn_global_load_lds((const unsigned*)(S.vtab + ((size_t)cur.pm * 512 + tid) * 16), (LAS unsigned*)(lds + VOFF_OFF + ldsw), 16, 0, 0);
        PG8_WAIT_V(0);
        const u32x4 tv = *(const LAS u32x4*)(lds + VOFF_OFF + tid * 16); vc[0][0] = tv.x; vc[0][1] = tv.y; vc[1][0] = tv.z; vc[1][1] = tv.w;
    } else { PG8_DENSE_V(vc, cur); }
    const char* cB = Bt + S.b_off(cur, RB);
    PG8_STAGE(PG8_SB(0, 0), cB, voffB); PG8_STAGE(PG8_SB(0, 1), cB + hstep, voffB); PG8_STAGE(PG8_SA(0, 0), A, vc[0]); PG8_STAGE(PG8_SA(0, 1), A, vc[1]);
    if (wr == 1) PG8_BAR;
    PG8_WAIT_V(2); PG8_BAR;
    PG8_STAGE(PG8_SB(1, 0), cB + kstep, voffB); PG8_STAGE(PG8_SA(1, 0), A + kstep, vc[0]); PG8_STAGE(PG8_SB(1, 1), cB + hstep + kstep, voffB);
    PG8_WAIT_V(6); PG8_BAR;
    for (;;) {
        const bool has_next = S.next(ui + 1, nxt);
        const char* nB = has_next ? Bt + S.b_off(nxt, RB) : cB;
        unsigned dlt = 0u;
        if (has_next) {
            if constexpr (Sched::GATHER) __builtin_amdgcn_global_load_lds((const unsigned*)(S.vtab + ((size_t)nxt.pm * 512 + tid) * 16), (LAS unsigned*)(lds + VOFF_OFF + ((ui + 1) & 1) * 8192 + ldsw), 16, 0, 0);
            else dlt = (unsigned)(nxt.pm - cur.pm) * (unsigned)(BM * RB);
        }
#pragma unroll
        for (int h = 0; h < 2; ++h) { v2[h][0] = vc[h][0]; v2[h][1] = vc[h][1]; }
#pragma nounroll
        for (int t = 0; t < nt; ++t) {
            const int bb = t & 1; const bool w1 = (t + 1 >= nt), w2 = (t + 2 >= nt);
            if (t == nt - 2 && has_next) {
                if constexpr (Sched::GATHER) { const u32x4 tv = *(const LAS u32x4*)(lds + VOFF_OFF + ((ui + 1) & 1) * 8192 + tid * 16); v2[0][0] = tv.x; v2[0][1] = tv.y; v2[1][0] = tv.z; v2[1][1] = tv.w; }
                else {
#pragma unroll
                    for (int h = 0; h < 2; ++h) { v2[h][0] += dlt; v2[h][1] += dlt; } }
            }
            const char* a1 = w1 ? A : A + (size_t)(t + 1) * kstep;
            const char* a2 = w2 ? A + (size_t)(t + 2 - nt) * kstep : A + (size_t)(t + 2) * kstep;
            const char* b2 = w2 ? nB + (size_t)(t + 2 - nt) * kstep : cB + (size_t)(t + 2) * kstep;
            unsigned va1[2], va2[2];
#pragma unroll
            for (int i = 0; i < 2; ++i) { va1[i] = w1 ? v2[1][i] : vc[1][i]; va2[i] = w2 ? v2[0][i] : vc[0][i]; }
            const int ob = bb * (2 * HTB), on = (bb ^ 1) * (2 * HTB);
            PG8_LDB(B0, ob, 0); PG8_LDB(B1, ob, 1); PG8_SCHED; PG8_LDA(At, ob, 0); PG8_STAGE(on + PG8_SA(0, 1), a1, va1);
            PG8_WAIT_V(8); PG8_WAIT_L(0); PG8_BAR; PG8_MMA(0, 0, At, B0); PG8_MMA(0, 1, At, B1); PG8_BAR; PG8_SCHED;
            PG8_LDA(At, ob, 1); PG8_STAGE(ob + PG8_SB(0, 0), b2, voffB); PG8_STAGE(ob + PG8_SB(0, 1), b2 + hstep, voffB); PG8_STAGE(ob + PG8_SA(0, 0), a2, va2);
            PG8_WAIT_V(8); PG8_WAIT_L(0); PG8_BAR; PG8_MMA(1, 0, At, B0); PG8_MMA(1, 1, At, B1); PG8_BAR; PG8_SCHED;
        }
        if (wr == 0) PG8_BAR;
        E(acc, cur, wr, wc, fr, fq);
        if (!has_next) break;
#pragma unroll
        for (int a = 0; a < 2; ++a)
#pragma unroll
            for (int b = 0; b < 2; ++b)
#pragma unroll
                for (int m = 0; m < 4; ++m)
#pragma unroll
                    for (int n = 0; n < 2; ++n) acc[a][b][m][n] = (f32x4){0.f, 0.f, 0.f, 0.f};
        cur = nxt; cB = nB; ++ui;
#pragma unroll
        for (int h = 0; h < 2; ++h) { vc[h][0] = v2[h][0]; vc[h][1] = v2[h][1]; }
        if (wr == 1) PG8_BAR;
    }
    PG8_WAIT_V(0);
    PG8_BAR;
#undef PG8_SA
#undef PG8_SB
#undef PG8_STAGE
#undef PG8_LDA
#undef PG8_LDB
#undef PG8_MMA
#undef PG8_WAIT_V
#undef PG8_WAIT_L
#undef PG8_BAR
#undef PG8_SCHED
#undef PG8_DENSE_V
}

typedef f32x4 Acc[2][2][4][2];
struct EpiInProj {
    static constexpr bool PERM = true;
    bf16_t* Q; const int* pos;
    __device__ __forceinline__ void operator()(const Acc& acc, const Unit& u, int wr, int wc, int fr, int fq) const {
        const int sec = u.pn >> 1, hf = u.pn & 1, row0 = u.pm * BM + wr * 64 + fr;
        if (sec >= 2) {
            bf16_t* base = Q + (size_t)sec * (size_t)(T * 512);
            const int col0 = hf * 256 + wc * 32 + 8 * fq;
#pragma unroll
            for (int ai = 0; ai < 2; ++ai)
#pragma unroll
                for (int m = 0; m < 4; ++m) { bf16_t* rowp = base + (size_t)(row0 + ai * HALF + m * 16) * 512 + col0;
#pragma unroll
                    for (int bj = 0; bj < 2; ++bj) { const f32x4 v0 = acc[ai][bj][m][0], v1 = acc[ai][bj][m][1];
                        u32x4 w; w.x = cvt_pk_bf16(v0[0], v0[1]); w.y = cvt_pk_bf16(v0[2], v0[3]); w.z = cvt_pk_bf16(v1[0], v1[1]); w.w = cvt_pk_bf16(v1[2], v1[3]);
                        *(u32x4*)(rowp + bj * HALF) = w; } }
        } else {
            bf16_t* base = Q + (size_t)sec * (size_t)(T * 512);
            const int head = hf * 4 + wc;
            const float lg = log2_gamma(head);
#pragma unroll
            for (int ai = 0; ai < 2; ++ai)
#pragma unroll
                for (int m = 0; m < 4; ++m) {
                    const int row = row0 + ai * HALF + m * 16; const float p = (float)pos[row]; const float c = (float)(row & (CH - 1));
                    const float sc = sec == 0 ? __builtin_amdgcn_exp2f(c * lg) : __builtin_amdgcn_exp2f(-c * lg) * 0.125f;
                    bf16_t* rowp = base + (size_t)row * 512 + head * 64 + 8 * fq;
#pragma unroll
                    for (int n = 0; n < 2; ++n) { float o1[4], o2[4];
#pragma unroll
                        for (int j = 0; j < 4; ++j) { const float ifr = __builtin_amdgcn_exp2f(-(float)(8 * fq + 4 * n + j) * (13.287712379549449f / 32.0f)) * 0.15915494309189535f;
                            const float rev = __builtin_amdgcn_fractf(p * ifr); const float sn = __builtin_amdgcn_sinf(rev), cs = __builtin_amdgcn_cosf(rev);
                            const float x1 = acc[ai][0][m][n][j], x2 = acc[ai][1][m][n][j];
                            o1[j] = (x1 * cs - x2 * sn) * sc; o2[j] = (x2 * cs + x1 * sn) * sc; }
                        u32x2 w; w.x = cvt_pk_bf16(o1[0], o1[1]); w.y = cvt_pk_bf16(o1[2], o1[3]); *(u32x2*)(rowp + 4 * n) = w;
                        w.x = cvt_pk_bf16(o2[0], o2[1]); w.y = cvt_pk_bf16(o2[2], o2[3]); *(u32x2*)(rowp + 32 + 4 * n) = w; }
                }
        }
    }
};
struct EpiPlainF8 {
    static constexpr bool PERM = true;
    unsigned char* O; int ldc;
    __device__ __forceinline__ void operator()(const Acc& acc, const Unit& u, int wr, int wc, int fr, int fq) const {
        const int row0 = u.pm * BM + wr * 64 + fr, col0 = u.pn * BM + wc * 32 + 8 * fq;
#pragma unroll
        for (int ai = 0; ai < 2; ++ai)
#pragma unroll
            for (int m = 0; m < 4; ++m) { unsigned char* rowp = O + (size_t)(row0 + ai * HALF + m * 16) * ldc + col0;
#pragma unroll
                for (int bj = 0; bj < 2; ++bj) { const f32x4 v0 = acc[ai][bj][m][0], v1 = acc[ai][bj][m][1];
                    u32x2 w; w.x = cvt4_fp8(v0[0], v0[1], v0[2], v0[3]); w.y = cvt4_fp8(v1[0], v1[1], v1[2], v1[3]);
                    *(u32x2*)(rowp + bj * HALF) = w; } }
    }
};
struct EpiWout {
    static constexpr bool PERM = true;
    const float* x; bf16_t* h1b; unsigned char* h1f8; float* ssq;
    __device__ __forceinline__ void operator()(const Acc& acc, const Unit& u, int wr, int wc, int fr, int fq) const {
        const int row0 = u.pm * BM + wr * 64 + fr, col0 = u.pn * BM + wc * 32 + 8 * fq;
#pragma unroll
        for (int ai = 0; ai < 2; ++ai)
#pragma unroll
            for (int m = 0; m < 4; ++m) { const int row = row0 + ai * HALF + m * 16; const size_t off = (size_t)row * D + col0; float s = 0.f;
#pragma unroll
                for (int bj = 0; bj < 2; ++bj) { const f32x4 x0 = *(const f32x4*)(x + off + bj * HALF), x1 = *(const f32x4*)(x + off + bj * HALF + 4);
                    const f32x4 h0 = acc[ai][bj][m][0] + x0, h1 = acc[ai][bj][m][1] + x1;
                    s += (h0[0] * h0[0] + h0[1] * h0[1]) + (h0[2] * h0[2] + h0[3] * h0[3]) + (h1[0] * h1[0] + h1[1] * h1[1]) + (h1[2] * h1[2] + h1[3] * h1[3]);
                    u32x4 w; w.x = cvt_pk_bf16(h0[0], h0[1]); w.y = cvt_pk_bf16(h0[2], h0[3]); w.z = cvt_pk_bf16(h1[0], h1[1]); w.w = cvt_pk_bf16(h1[2], h1[3]);
                    *(u32x4*)(h1b + off + bj * HALF) = w;
                    u32x2 q; q.x = cvt4_fp8(h0[0], h0[1], h0[2], h0[3]); q.y = cvt4_fp8(h1[0], h1[1], h1[2], h1[3]);
                    *(u32x2*)(h1f8 + off + bj * HALF) = q; }
                s += __shfl_xor(s, 16); s += __shfl_xor(s, 32);
                if (fq == 0) ssq[(size_t)row * 16 + u.pn * 4 + wc] = s;
                if (m & 1) asm volatile("" ::: "memory"); }
    }
};
struct EpiGateUp {
    static constexpr bool PERM = true;
    unsigned char* act; const float* bgu; const float* sr;
    __device__ __forceinline__ void operator()(const Acc& acc, const Unit& u, int wr, int wc, int fr, int fq) const {
        const int prow0 = u.pm * BM + wr * 64 + fr, acol = u.pn * 128 + wc * 32 + 8 * fq;
        const float* bp = bgu + (size_t)u.e * (2 * DE) + 2 * acol;
        f32x2 bg[4], bu[4];
#pragma unroll
        for (int q = 0; q < 4; ++q) { const f32x4 b4 = *(const f32x4*)(bp + 4 * q); bg[q] = (f32x2){b4[0], b4[2]}; bu[q] = (f32x2){b4[1], b4[3]}; }
        float rr[8];
#pragma unroll
        for (int i = 0; i < 8; ++i) rr[i] = sr[prow0 + (i >> 2) * HALF + (i & 3) * 16] * (MOE_F8 ? 0.03125f : 1.0f);
#pragma unroll
        for (int ai = 0; ai < 2; ++ai)
#pragma unroll
            for (int m = 0; m < 4; ++m) { const int prow = prow0 + ai * HALF + m * 16; const float r = rr[ai * 4 + m]; f32x2 o[4];
#pragma unroll
                for (int p = 0; p < 4; ++p) { const f32x4 ga = acc[ai][0][m][p >> 1], ua = acc[ai][1][m][p >> 1];
                    f32x2 g = (f32x2){ga[(p & 1) * 2], ga[(p & 1) * 2 + 1]} * r + bg[p], up = (f32x2){ua[(p & 1) * 2], ua[(p & 1) * 2 + 1]} * r + bu[p];
                    g.x = fminf(g.x, 7.0f); g.y = fminf(g.y, 7.0f); up.x = __builtin_amdgcn_fmed3f(up.x, -7.0f, 7.0f); up.y = __builtin_amdgcn_fmed3f(up.y, -7.0f, 7.0f);
                    const f32x2 t = g * (-1.702f * 1.4426950408889634f); f32x2 d; d.x = __builtin_amdgcn_exp2f(fminf(t.x, 60.0f)); d.y = __builtin_amdgcn_exp2f(fminf(t.y, 60.0f)); d = d + 1.0f;
                    const float rp = __builtin_amdgcn_rcpf(d.x * d.y); const f32x2 sg = (f32x2){d.y, d.x} * rp;
                    o[p] = (up + 1.0f) * (g * sg); }
                if (MOE_F8) { u32x2 w; w.x = cvt4_fp8(o[0].x, o[0].y, o[1].x, o[1].y); w.y = cvt4_fp8(o[2].x, o[2].y, o[3].x, o[3].y); *(u32x2*)(act + (size_t)prow * DE + acol) = w; }
                else { u32x4 w; w.x = cvt_pk_bf16(o[0].x, o[0].y); w.y = cvt_pk_bf16(o[1].x, o[1].y); w.z = cvt_pk_bf16(o[2].x, o[2].y); w.w = cvt_pk_bf16(o[3].x, o[3].y); *(u32x4*)(act + ((size_t)prow * DE + acol) * 2) = w; } }
    }
};
struct EpiDown {
    static constexpr bool PERM = true;
    unsigned char* y; const float* bd; const float* sg;
    __device__ __forceinline__ void operator()(const Acc& acc, const Unit& u, int wr, int wc, int fr, int fq) const {
        const int prow0 = u.pm * BM + wr * 64 + fr, col0 = u.pn * BM + wc * 32 + 8 * fq;
        const float* bp = bd + (size_t)u.e * D + col0;
        f32x4 bv[2][2];
#pragma unroll
        for (int bj = 0; bj < 2; ++bj)
#pragma unroll
            for (int n = 0; n < 2; ++n) bv[bj][n] = *(const f32x4*)(bp + bj * HALF + 4 * n);
#pragma unroll
        for (int ai = 0; ai < 2; ++ai)
#pragma unroll
            for (int m = 0; m < 4; ++m) { const int prow = prow0 + ai * HALF + m * 16; const float gw = sg[prow] * 16.0f; unsigned char* rowp = y + (size_t)prow * D + col0;
#pragma unroll
                for (int bj = 0; bj < 2; ++bj) { const f32x4 v0 = (acc[ai][bj][m][0] * (MOE_F8 ? 0.03125f : 1.0f) + bv[bj][0]) * gw, v1 = (acc[ai][bj][m][1] * (MOE_F8 ? 0.03125f : 1.0f) + bv[bj][1]) * gw;
                    u32x2 w; w.x = cvt4_fp8(v0[0], v0[1], v0[2], v0[3]); w.y = cvt4_fp8(v1[0], v1[1], v1[2], v1[3]);
                    *(u32x2*)(rowp + bj * HALF) = w; } }
    }
};
struct EpiPle {
    static constexpr bool PERM = true;
    bf16_t* h3; const bf16_t* h2b; const unsigned char* pp; const float* rstd2;
    __device__ __forceinline__ void operator()(const Acc& acc, const Unit& u, int wr, int wc, int fr, int fq) const {
        const int row0 = u.pm * BM + wr * 64 + fr, col0 = u.pn * BM + wc * 32 + 8 * fq;
#pragma unroll
        for (int ai = 0; ai < 2; ++ai)
#pragma unroll
            for (int m = 0; m < 4; ++m) { const int row = row0 + ai * HALF + m * 16; const float r = rstd2[row] * 0.03125f; const size_t off = (size_t)row * D + col0;
#pragma unroll
                for (int bj = 0; bj < 2; ++bj) { const u32x2 pw = *(const u32x2*)(pp + off + bj * HALF); const u32x4 hw = *(const u32x4*)(h2b + off + bj * HALF);
                    float p[8]; fp8x4_to_f32(pw.x, p[0], p[1], p[2], p[3]); fp8x4_to_f32(pw.y, p[4], p[5], p[6], p[7]);
                    const f32x4 a0 = acc[ai][bj][m][0] * r, a1 = acc[ai][bj][m][1] * r; float o[8];
                    o[0] = bf_lo(hw.x) + sigmoidf_fast(a0[0]) * p[0]; o[1] = bf_hi(hw.x) + sigmoidf_fast(a0[1]) * p[1]; o[2] = bf_lo(hw.y) + sigmoidf_fast(a0[2]) * p[2]; o[3] = bf_hi(hw.y) + sigmoidf_fast(a0[3]) * p[3];
                    o[4] = bf_lo(hw.z) + sigmoidf_fast(a1[0]) * p[4]; o[5] = bf_hi(hw.z) + sigmoidf_fast(a1[1]) * p[5]; o[6] = bf_lo(hw.w) + sigmoidf_fast(a1[2]) * p[6]; o[7] = bf_hi(hw.w) + sigmoidf_fast(a1[3]) * p[7];
                    u32x4 w; w.x = cvt_pk_bf16(o[0], o[1]); w.y = cvt_pk_bf16(o[2], o[3]); w.z = cvt_pk_bf16(o[4], o[5]); w.w = cvt_pk_bf16(o[6], o[7]);
                    *(u32x4*)(h3 + off + bj * HALF) = w; }
                if (m & 1) asm volatile("" ::: "memory"); }
    }
};
}

struct Args { const void* in[20]; float* out; unsigned char* ws; int ph_lo, ph_hi; };
enum { I_X = 0, I_P, I_POS, I_WIN, I_WOUT, I_GNW, I_POOLW, I_POOLS, I_NMIX, I_NMOE, I_RW, I_RB, I_WGU, I_BGU, I_WD, I_BD, I_NPLE, I_WG, I_WP, I_NFIN };
constexpr int NPH = 13;

enum { WK_PLAIN = 0, WK_WIN = 1, WK_GU = 2 };
template <int KIND> __device__ __forceinline__ int dst_row(int c) {
    if (KIND == WK_WIN) { if (c < 1024) { const int sec = c >> 9, within = c & 511, head = within >> 6, d = within & 63; return (sec * 2 + (head >> 2)) * 256 + (d >> 5) * 128 + (head & 3) * 32 + (d & 31); } return c; }
    if (KIND == WK_GU) { const int a = c >> 1; return (a >> 7) * 256 + (c & 1) * 128 + (a & 127); }
    return c;
}
template <int KIND, bool OUT8> __device__ __forceinline__ void tr_item(const float* W, int K, int N, void* WT, LAS float* scr, int kb, int cb, int lane, const float* ks, float mul) {
    const int k0 = 64 * kb, c0 = 64 * cb; const bool ok = (c0 + lane) < N;
    const float* src = W + (size_t)k0 * N + c0 + lane;
    float tv[64];
#pragma unroll
    for (int kk = 0; kk < 64; ++kk) tv[kk] = ok ? src[(size_t)kk * N] : 0.f;
#pragma unroll
    for (int kk = 0; kk < 64; ++kk) scr[kk * 65 + lane] = tv[kk];
    const int c = lane & 7;
    f32x4 s0 = {mul, mul, mul, mul}, s1 = s0;
    if (ks) { s0 = *(const f32x4*)(ks + k0 + 8 * c) * mul; s1 = *(const f32x4*)(ks + k0 + 8 * c + 4) * mul; }
    LDS_WAIT(); asm volatile("" ::: "memory");
#pragma unroll
    for (int w = 0; w < 8; ++w) { const int r = (lane >> 3) + 8 * w; const LAS float* s = scr + (8 * c) * 65 + r;
        const float v0 = s[0 * 65] * s0[0], v1 = s[1 * 65] * s0[1], v2 = s[2 * 65] * s0[2], v3 = s[3 * 65] * s0[3], v4 = s[4 * 65] * s1[0], v5 = s[5 * 65] * s1[1], v6 = s[6 * 65] * s1[2], v7 = s[7 * 65] * s1[3];
        if (OUT8) { u32x2 o; o.x = cvt4_fp8(v0, v1, v2, v3); o.y = cvt4_fp8(v4, v5, v6, v7);
            if (c0 + r < N) *(u32x2*)((unsigned char*)WT + (size_t)dst_row<KIND>(c0 + r) * K + k0 + 8 * c) = o; }
        else { u32x4 o; o.x = cvt_pk_bf16(v0, v1); o.y = cvt_pk_bf16(v2, v3); o.z = cvt_pk_bf16(v4, v5); o.w = cvt_pk_bf16(v6, v7);
            if (c0 + r < N) *(u32x4*)((bf16_t*)WT + (size_t)dst_row<KIND>(c0 + r) * K + k0 + 8 * c) = o; } }
    LDS_WAIT(); asm volatile("" ::: "memory");
}
template <int KIND> __device__ __forceinline__ void tr_item8(const float* W, int K, int N, unsigned char* WT, LAS float* scr, int kb, int cb, int lane, const float* ks, float mul) {
    const int k0 = 128 * kb, c0 = 32 * cb, col = lane & 31, rp = lane >> 5;
    const float* src = W + (size_t)(k0 + rp) * N + c0 + col;
    float tv[64];
#pragma unroll
    for (int i = 0; i < 64; ++i) tv[i] = src[(size_t)(2 * i) * N];
#pragma unroll
    for (int i = 0; i < 64; ++i) scr[(2 * i + rp) * 33 + col] = tv[i];
    LDS_WAIT(); asm volatile("" ::: "memory");
#pragma unroll
    for (int w = 0; w < 4; ++w) { const int r = (lane & 15) + 16 * (w & 1), c = (lane >> 4) + 4 * (w >> 1); const LAS float* sp = scr + (16 * c) * 33 + r;
        float v[16];
#pragma unroll
        for (int q = 0; q < 4; ++q) { f32x4 sc = {mul, mul, mul, mul}; if (ks) sc = *(const f32x4*)(ks + k0 + 16 * c + 4 * q) * mul;
            v[4 * q] = sp[(4 * q) * 33] * sc[0]; v[4 * q + 1] = sp[(4 * q + 1) * 33] * sc[1]; v[4 * q + 2] = sp[(4 * q + 2) * 33] * sc[2]; v[4 * q + 3] = sp[(4 * q + 3) * 33] * sc[3]; }
        u32x4 o; o.x = cvt4_fp8(v[0], v[1], v[2], v[3]); o.y = cvt4_fp8(v[4], v[5], v[6], v[7]); o.z = cvt4_fp8(v[8], v[9], v[10], v[11]); o.w = cvt4_fp8(v[12], v[13], v[14], v[15]);
        *(u32x4*)(WT + (size_t)dst_row<KIND>(c0 + r) * K + k0 + 16 * c) = o; }
    LDS_WAIT(); asm volatile("" ::: "memory");
}
__device__ __forceinline__ void phase_prologue(const Args& a, LAS unsigned char* lds, int vcu, int G) {
    const int tid = threadIdx.x, lane = tid & 63, wave = __builtin_amdgcn_readfirstlane(tid >> 6);
    LAS float* scr = (LAS float*)(lds + wave * 16896);
    const int gw = vcu * 8 + wave, NGW = G * 8;
    unsigned char* ws = a.ws;
    constexpr int I_GU = NE * 16 * 32, I_DN = NE * 16 * 16, I_WINI = 16 * 40, I_SQ = 16 * 16, I_WPI = 4 * 16, I_RT = 16, I_PW = 4 * 4;
    constexpr int NITEMS = I_GU + I_DN + I_WINI + 2 * I_SQ + I_WPI + I_RT + I_PW;
    for (int it = gw; it < NITEMS; it += NGW) {
        int r = it;
        if (r < I_GU) { const int e = r / 512, q = r % 512;
            if (MOE_F8) tr_item8<WK_GU>((const float*)a.in[I_WGU] + (size_t)e * D * 2 * DE, D, 2 * DE, ws + WS_WGU + (size_t)e * 2 * DE * D, scr, q / 64, q % 64, lane, (const float*)a.in[I_NMOE], 32.0f);
            else tr_item<WK_GU, false>((const float*)a.in[I_WGU] + (size_t)e * D * 2 * DE, D, 2 * DE, ws + WS_WGU + (size_t)e * 2 * DE * D * 2, scr, q / 32, q % 32, lane, (const float*)a.in[I_NMOE], 1.0f);
            continue; } r -= I_GU;
        if (r < I_DN) { const int e = r / 256, q = r % 256;
            if (MOE_F8) tr_item8<WK_PLAIN>((const float*)a.in[I_WD] + (size_t)e * DE * D, DE, D, ws + WS_WD + (size_t)e * D * DE, scr, q / 32, q % 32, lane, nullptr, 32.0f);
            else tr_item<WK_PLAIN, false>((const float*)a.in[I_WD] + (size_t)e * DE * D, DE, D, ws + WS_WD + (size_t)e * D * DE * 2, scr, q / 16, q % 16, lane, nullptr, 1.0f);
            continue; } r -= I_DN;
        if (r < I_WINI) { tr_item<WK_WIN, false>((const float*)a.in[I_WIN], D, NIN, ws + WS_WIN, scr, r / 40, r % 40, lane, nullptr, 1.0f); continue; } r -= I_WINI;
        if (r < I_SQ) { tr_item<WK_PLAIN, false>((const float*)a.in[I_WOUT], D, D, ws + WS_WOUT, scr, r / 16, r % 16, lane, nullptr, 1.0f); continue; } r -= I_SQ;
        if (r < I_SQ) { tr_item8<WK_PLAIN>((const float*)a.in[I_WG], D, D, ws + WS_WG, scr, r / 32, r % 32, lane, (const float*)a.in[I_NPLE], 32.0f); continue; } r -= I_SQ;
        if (r < I_WPI) { tr_item<WK_PLAIN, false>((const float*)a.in[I_WP], PLE, D, ws + WS_WPT, scr, r / 16, r % 16, lane, nullptr, 1.0f); continue; } r -= I_WPI;
        if (r < I_RT) { tr_item<WK_PLAIN, false>((const float*)a.in[I_RW], D, NE, ws + WS_ROUT, scr, r, 0, lane, (const float*)a.in[I_NMOE], 1.0f); continue; } r -= I_RT;
        { const int g = r / 4, q = r % 4; tr_item<WK_PLAIN, false>((const float*)a.in[I_POOLW] + (size_t)g * 128 * 128, 128, 128, ws + WS_PWT + (size_t)g * 128 * 128 * 2, scr, q / 2, q % 2, lane, nullptr, 1.0f); }
    }
    const float* x = (const float*)a.in[I_X]; const float* nw = (const float*)a.in[I_NMIX]; bf16_t* hn = (bf16_t*)(ws + WS_HN1);
    f32x4 wv[4];
#pragma unroll
    for (int j = 0; j < 4; ++j) wv[j] = *((const f32x4*)nw + lane + 64 * j);
    for (int m = gw; m < T; m += 2 * NGW) {
        const int m2 = m + NGW; const bool has2 = m2 < T;
        const f32x4* xr = (const f32x4*)(x + (size_t)m * D) + lane; const f32x4* xr2 = (const f32x4*)(x + (size_t)(has2 ? m2 : m) * D) + lane; f32x4 v[4], v2[4]; float s = 0.f, s2 = 0.f;
#pragma unroll
        for (int j = 0; j < 4; ++j) { v[j] = xr[64 * j]; v2[j] = xr2[64 * j]; }
#pragma unroll
        for (int j = 0; j < 4; ++j) { s += (v[j][0] * v[j][0] + v[j][1] * v[j][1]) + (v[j][2] * v[j][2] + v[j][3] * v[j][3]); s2 += (v2[j][0] * v2[j][0] + v2[j][1] * v2[j][1]) + (v2[j][2] * v2[j][2] + v2[j][3] * v2[j][3]); }
        const float rstd = __builtin_amdgcn_rsqf(wave_sum(s) * (1.f / D) + NORM_EPS), rstd2 = __builtin_amdgcn_rsqf(wave_sum(s2) * (1.f / D) + NORM_EPS);
        u32x2* o8 = (u32x2*)(hn + (size_t)m * D) + lane; u32x2* o82 = (u32x2*)(hn + (size_t)m2 * D) + lane;
#pragma unroll
        for (int j = 0; j < 4; ++j) { const f32x4 y = v[j] * rstd * wv[j]; u32x2 w; w.x = cvt_pk_bf16(y[0], y[1]); w.y = cvt_pk_bf16(y[2], y[3]); o8[64 * j] = w;
            if (has2) { const f32x4 y2 = v2[j] * rstd2 * wv[j]; u32x2 w2; w2.x = cvt_pk_bf16(y2[0], y2[1]); w2.y = cvt_pk_bf16(y2[2], y2[3]); o82[64 * j] = w2; } }
    }
    const f32x4* pv = (const f32x4*)a.in[I_P]; u32x2* pb = (u32x2*)(ws + WS_PB);
    for (size_t i = (size_t)vcu * 512 + tid; i < (size_t)T * PLE / 4; i += (size_t)G * 512) { const f32x4 v = pv[i]; u32x2 w; w.x = cvt_pk_bf16(v[0], v[1]); w.y = cvt_pk_bf16(v[2], v[3]); pb[i] = w; }
}

__device__ __forceinline__ int tt_off(int d, int m) { return d * 136 + ((((m >> 3) ^ ((d >> 3) & 7)) << 3) | (m & 7)); }
__device__ __forceinline__ void tt_write8(LAS bf16_t* base, int d0, int m, const u32x4 v) {
    const int blk = (((m >> 3) ^ ((d0 >> 3) & 7)) << 3) | (m & 7); LAS bf16_t* p = base + d0 * 136 + blk;
    p[0 * 136] = (bf16_t)(v.x & 0xffff); p[1 * 136] = (bf16_t)(v.x >> 16); p[2 * 136] = (bf16_t)(v.y & 0xffff); p[3 * 136] = (bf16_t)(v.y >> 16);
    p[4 * 136] = (bf16_t)(v.z & 0xffff); p[5 * 136] = (bf16_t)(v.z >> 16); p[6 * 136] = (bf16_t)(v.w & 0xffff); p[7 * 136] = (bf16_t)(v.w >> 16);
}
__device__ __forceinline__ void phase_kv(const Args& a, LAS unsigned char* lds, int G) {
    const int tid = threadIdx.x, lane = tid & 63, w = __builtin_amdgcn_readfirstlane(tid >> 6), fr = lane & 15, fq = lane >> 4;
    const bf16_t* Kb = (const bf16_t*)(a.ws + WS_K); const bf16_t* Vb = (const bf16_t*)(a.ws + WS_V); float* KV = (float*)(a.ws + WS_KV);
    const int seg = tid & 7, r0 = tid >> 3;
    u32x4 rk[2], rv[2];
    int u = blockIdx.x;
#define KV_LOAD(uu) do { const size_t tok0 = (size_t)((uu) >> 3) * CH; const int hc = ((uu) & 7) * HD; _Pragma("unroll") for (int i = 0; i < 2; ++i) { const size_t o = (tok0 + r0 + 64 * i) * 512 + hc + seg * 8; rk[i] = *(const u32x4*)(Kb + o); rv[i] = *(const u32x4*)(Vb + o); } } while (0)
    if (u < 2048) KV_LOAD(u);
    for (int buf = 0; u < 2048; u += G, buf ^= 1) {
        LAS bf16_t* KT = (LAS bf16_t*)(lds + buf * 34816); LAS bf16_t* VT = KT + 64 * 136;
#pragma unroll
        for (int i = 0; i < 2; ++i) { tt_write8(KT, seg * 8, r0 + 64 * i, rk[i]); tt_write8(VT, seg * 8, r0 + 64 * i, rv[i]); }
        __syncthreads();
        if (u + G < 2048) KV_LOAD(u + G);
        const int dt = w & 3; const float sc = __builtin_amdgcn_exp2f(127.0f * log2_gamma(u & 7));
#pragma unroll
        for (int q = 0; q < 2; ++q) { const int et = (w >> 2) * 2 + q; f32x4 acc = {0.f, 0.f, 0.f, 0.f};
#pragma unroll
            for (int ks = 0; ks < 4; ++ks) { const int d = 16 * dt + fr, e = 16 * et + fr, m0 = 32 * ks + 8 * fq;
                const bf16x8 A = *(const LAS bf16x8*)(KT + tt_off(d, m0)); const bf16x8 B = *(const LAS bf16x8*)(VT + tt_off(e, m0));
                acc = __builtin_amdgcn_mfma_f32_16x16x32_bf16(A, B, acc, 0, 0, 0); }
            *(f32x4*)(KV + (size_t)u * 4096 + (16 * et + fr) * 64 + 16 * dt + 4 * fq) = acc * sc; }
    }
#undef KV_LOAD
    __syncthreads();
}
__device__ __forceinline__ void phase_pool(const Args& a, LAS unsigned char* lds, int G) {
    const int tid = threadIdx.x, lane = tid & 63, w = __builtin_amdgcn_readfirstlane(tid >> 6), fr = lane & 15, fq = lane >> 4;
    const bf16_t* U = (const bf16_t*)(a.ws + WS_U); const bf16_t* PWt = (const bf16_t*)(a.ws + WS_PWT); bf16_t* MIX = (bf16_t*)(a.ws + WS_MIX);
    const float* pscale = (const float*)a.in[I_POOLS];
    LAS bf16_t* UB = (LAS bf16_t*)lds; LAS bf16_t* PA = (LAS bf16_t*)(lds + 38912); LAS bf16_t* PW = (LAS bf16_t*)(lds + 73728);
    int gl = -1;
    for (int u = blockIdx.x; u < (T / 128) * 4; u += G) {
        const int g = u & 3, t0 = (u >> 2) * 128;
        if (g != gl) { gl = g;
#pragma unroll
            for (int i = 0; i < 4; ++i) { const int p = tid + 512 * i, d = p >> 4, sg = p & 15; *(LAS u32x4*)(PW + d * 136 + sg * 8) = *(const u32x4*)(PWt + ((size_t)g * 128 + d) * 128 + sg * 8); } }
        const bool seq0 = (t0 & (SEQ - 1)) == 0;
#pragma unroll
        for (int i = 0; i < 5; ++i) { const int p = tid + 512 * i, lr = p >> 4, sg = p & 15;
            if (lr < 143) { u32x4 v = {0u, 0u, 0u, 0u}; if (lr >= 15 || !seq0) v = *(const u32x4*)(U + (size_t)(t0 - 15 + lr) * 512 + g * 128 + sg * 8); *(LAS u32x4*)(UB + lr * 136 + sg * 8) = v; } }
        __syncthreads();
        { const int cg = tid & 15, rg = tid >> 4, wnd = 2 << g;
#pragma unroll
          for (int q = 0; q < 4; ++q) { const int r = 4 * rg + q; const int s = (t0 + r) & (SEQ - 1); const float inv = 1.0f / (float)((s + 1) < wnd ? (s + 1) : wnd);
              float sum[8];
#pragma unroll
              for (int j = 0; j < 8; ++j) sum[j] = 0.f;
              for (int k = 0; k < wnd; ++k) { const u32x4 v = *(const LAS u32x4*)(UB + (r + 15 - k) * 136 + cg * 8);
                  sum[0] += bf_lo(v.x); sum[1] += bf_hi(v.x); sum[2] += bf_lo(v.y); sum[3] += bf_hi(v.y); sum[4] += bf_lo(v.z); sum[5] += bf_hi(v.z); sum[6] += bf_lo(v.w); sum[7] += bf_hi(v.w); }
              const u32x4 c = *(const LAS u32x4*)(UB + (r + 15) * 136 + cg * 8);
              u32x4 o; o.x = cvt_pk_bf16(sum[0] * inv - bf_lo(c.x), sum[1] * inv - bf_hi(c.x)); o.y = cvt_pk_bf16(sum[2] * inv - bf_lo(c.y), sum[3] * inv - bf_hi(c.y));
              o.z = cvt_pk_bf16(sum[4] * inv - bf_lo(c.z), sum[5] * inv - bf_hi(c.z)); o.w = cvt_pk_bf16(sum[6] * inv - bf_lo(c.w), sum[7] * inv - bf_hi(c.w));
              *(LAS u32x4*)(PA + r * 136 + cg * 8) = o; } }
        __syncthreads();
        f32x4 acc[8];
#pragma unroll
        for (int dt = 0; dt < 8; ++dt) acc[dt] = (f32x4){0.f, 0.f, 0.f, 0.f};
#pragma unroll
        for (int kk = 0; kk < 4; ++kk) { const bf16x8 B = *(const LAS bf16x8*)(PA + (16 * w + fr) * 136 + 32 * kk + 8 * fq);
#pragma unroll
            for (int dt = 0; dt < 8; ++dt) { const bf16x8 A = *(const LAS bf16x8*)(PW + (16 * dt + fr) * 136 + 32 * kk + 8 * fq); acc[dt] = __builtin_amdgcn_mfma_f32_16x16x32_bf16(A, B, acc[dt], 0, 0, 0); } }
        const size_t tok = (size_t)t0 + 16 * w + fr;
#pragma unroll
        for (int dt = 0; dt < 8; ++dt) { const int d = 16 * dt + 4 * fq; const f32x4 sc = *(const f32x4*)(pscale + g * 128 + d); const f32x4 o = acc[dt] * sc;
            u32x2 wv; wv.x = cvt_pk_bf16(o[0], o[1]); wv.y = cvt_pk_bf16(o[2], o[3]); *(u32x2*)(MIX + tok * D + 512 + g * 128 + d) = wv; }
        __syncthreads();
    }
}
__device__ __forceinline__ void phase_scan(const Args& a, int G) {
    const float* KV = (const float*)(a.ws + WS_KV); bf16_t* ST = (bf16_t*)(a.ws + WS_ST);
    for (int v = blockIdx.x * 512 + threadIdx.x; v < NBATCH * NH * 2048; v += G * 512) {
        const int bh = v >> 11, q = v & 2047, b = bh >> 3, h = bh & 7;
        const float lg = log2_gamma(h), gam = __builtin_amdgcn_exp2f(lg), cd = __builtin_amdgcn_exp2f(128.0f * lg);
        f32x2 s = {0.f, 0.f};
        for (int n0 = 0; n0 < NCH; n0 += 16) { f32x2 kv[16];
#pragma unroll
            for (int j = 0; j < 16; ++j) kv[j] = *(const f32x2*)(KV + ((size_t)((b * NCH + n0 + j) * NH + h)) * 4096 + q * 2);
#pragma unroll
            for (int j = 0; j < 16; ++j) { const f32x2 o = s * gam; *(unsigned*)(ST + ((size_t)((b * NCH + n0 + j) * NH + h)) * 4096 + q * 2) = cvt_pk_bf16(o[0], o[1]); s = s * cd + kv[j]; } }
    }
}
__device__ __forceinline__ void phase_ret(const Args& a, LAS unsigned char* lds, int G) {
    const int tid = threadIdx.x, lane = tid & 63, w = __builtin_amdgcn_readfirstlane(tid >> 6), fr = lane & 15, fq = lane >> 4;
    const bf16_t* Qb = (const bf16_t*)(a.ws + WS_Q); const bf16_t* Kb = (const bf16_t*)(a.ws + WS_K); const bf16_t* Vb = (const bf16_t*)(a.ws + WS_V);
    const bf16_t* Gb = (const bf16_t*)(a.ws + WS_G); const bf16_t* STg = (const bf16_t*)(a.ws + WS_ST); bf16_t* MIX = (bf16_t*)(a.ws + WS_MIX);
    const float* gnw = (const float*)a.in[I_GNW];
    const int seg = tid & 7, r0 = tid >> 3;
    u32x4 rk[2], rv[2], rs; bf16x8 rq[2]; u32x2 rg[4];
    int u = blockIdx.x;
#define RT_LOAD(uu) do { const size_t tok0 = (size_t)((uu) >> 3) * CH; const int hc = ((uu) & 7) * HD; _Pragma("unroll") for (int i = 0; i < 2; ++i) { const size_t o = (tok0 + r0 + 64 * i) * 512 + hc + seg * 8; rk[i] = *(const u32x4*)(Kb + o); rv[i] = *(const u32x4*)(Vb + o); } \
        rs = *(const u32x4*)(STg + (size_t)(uu) * 4096 + r0 * 64 + seg * 8); \
        _Pragma("unroll") for (int kk = 0; kk < 2; ++kk) rq[kk] = *(const bf16x8*)(Qb + (tok0 + 16 * w + fr) * 512 + hc + 32 * kk + 8 * fq); \
        _Pragma("unroll") for (int et = 0; et < 4; ++et) rg[et] = *(const u32x2*)(Gb + (tok0 + 16 * w + fr) * 512 + hc + 16 * et + 4 * fq); } while (0)
    if (u < 2048) RT_LOAD(u);
    for (int buf = 0; u < 2048; u += G, buf ^= 1) {
        LAS bf16_t* Kr = (LAS bf16_t*)(lds + buf * 45056); LAS bf16_t* VT = Kr + 128 * 72; LAS bf16_t* SL = VT + 64 * 136;
#pragma unroll
        for (int i = 0; i < 2; ++i) { *(LAS u32x4*)(Kr + (r0 + 64 * i) * 72 + seg * 8) = rk[i]; tt_write8(VT, seg * 8, r0 + 64 * i, rv[i]); }
        *(LAS u32x4*)(SL + r0 * 72 + seg * 8) = rs;
        bf16x8 qf[2]; u32x2 gvv[4];
#pragma unroll
        for (int kk = 0; kk < 2; ++kk) qf[kk] = rq[kk];
#pragma unroll
        for (int et = 0; et < 4; ++et) gvv[et] = rg[et];
        __syncthreads();
        if (u + G < 2048) RT_LOAD(u + G);
        const size_t tok0 = (size_t)(u >> 3) * CH; const int hc = (u & 7) * HD; const size_t ctok = tok0 + 16 * w + fr;
        u32x2 pk[8];
#pragma unroll
        for (int am = 0; am < 8; ++am) {
            if (am <= w) { f32x4 s = {0.f, 0.f, 0.f, 0.f};
#pragma unroll
                for (int kk = 0; kk < 2; ++kk) { const bf16x8 A = *(const LAS bf16x8*)(Kr + (16 * am + fr) * 72 + 32 * kk + 8 * fq); s = __builtin_amdgcn_mfma_f32_16x16x32_bf16(A, qf[kk], s, 0, 0, 0); }
                if (am == w) {
#pragma unroll
                    for (int j = 0; j < 4; ++j) if (4 * fq + j > fr) s[j] = 0.f; }
                pk[am].x = cvt_pk_bf16(s[0], s[1]); pk[am].y = cvt_pk_bf16(s[2], s[3]);
            } else { pk[am].x = 0u; pk[am].y = 0u; } }
        f32x4 y[4];
#pragma unroll
        for (int et = 0; et < 4; ++et) y[et] = (f32x4){0.f, 0.f, 0.f, 0.f};
#pragma unroll
        for (int s2 = 0; s2 < 4; ++s2) {
            if (2 * s2 <= w) { u32x4 bw; bw.x = pk[2 * s2].x; bw.y = pk[2 * s2].y; bw.z = pk[2 * s2 + 1].x; bw.w = pk[2 * s2 + 1].y; const bf16x8 B = __builtin_bit_cast(bf16x8, bw);
#pragma unroll
                for (int et = 0; et < 4; ++et) { const int e = 16 * et + fr, es = (e >> 3) & 7;
                    const u32x2 lo = *(const LAS u32x2*)(VT + e * 136 + (((4 * s2 + (fq >> 1)) ^ es) << 3) + 4 * (fq & 1));
                    const u32x2 hi = *(const LAS u32x2*)(VT + e * 136 + (((4 * s2 + 2 + (fq >> 1)) ^ es) << 3) + 4 * (fq & 1));
                    u32x4 aw; aw.x = lo.x; aw.y = lo.y; aw.z = hi.x; aw.w = hi.y;
                    y[et] = __builtin_amdgcn_mfma_f32_16x16x32_bf16(__builtin_bit_cast(bf16x8, aw), B, y[et], 0, 0, 0); } } }
#pragma unroll
        for (int kk = 0; kk < 2; ++kk)
#pragma unroll
            for (int et = 0; et < 4; ++et) { const bf16x8 A = *(const LAS bf16x8*)(SL + (16 * et + fr) * 72 + 32 * kk + 8 * fq); y[et] = __builtin_amdgcn_mfma_f32_16x16x32_bf16(A, qf[kk], y[et], 0, 0, 0); }
        float s = 0.f;
#pragma unroll
        for (int et = 0; et < 4; ++et) s += (y[et][0] + y[et][1]) + (y[et][2] + y[et][3]);
        s += __shfl_xor(s, 16); s += __shfl_xor(s, 32);
        const float mean = s * (1.0f / 64.0f); float q2 = 0.f;
#pragma unroll
        for (int et = 0; et < 4; ++et) { const f32x4 d = y[et] - mean; q2 += (d[0] * d[0] + d[1] * d[1]) + (d[2] * d[2] + d[3] * d[3]); }
        q2 += __shfl_xor(q2, 16); q2 += __shfl_xor(q2, 32);
        const float rstd = __builtin_amdgcn_rsqf(q2 * (1.0f / 64.0f) + GN_EPS);
#pragma unroll
        for (int et = 0; et < 4; ++et) { const int col = hc + 16 * et + 4 * fq; const u32x2 gv = gvv[et]; const f32x4 gw = *(const f32x4*)(gnw + col);
            const float g0 = bf_lo(gv.x), g1 = bf_hi(gv.x), g2 = bf_lo(gv.y), g3 = bf_hi(gv.y);
            const float o0 = (y[et][0] - mean) * rstd * gw[0] * g0 * sigmoidf_fast(g0), o1 = (y[et][1] - mean) * rstd * gw[1] * g1 * sigmoidf_fast(g1);
            const float o2 = (y[et][2] - mean) * rstd * gw[2] * g2 * sigmoidf_fast(g2), o3 = (y[et][3] - mean) * rstd * gw[3] * g3 * sigmoidf_fast(g3);
            u32x2 wv; wv.x = cvt_pk_bf16(o0, o1); wv.y = cvt_pk_bf16(o2, o3); *(u32x2*)(MIX + ctok * D + col) = wv; }
    }
#undef RT_LOAD
    __syncthreads();
}

__device__ __forceinline__ void phase_router(const Args& a, LAS unsigned char* lds, int G) {
    const int tid = threadIdx.x, lane = tid & 63, w = __builtin_amdgcn_readfirstlane(tid >> 6), fr = lane & 15, fq = lane >> 4;
    const bf16_t* RT = (const bf16_t*)(a.ws + WS_ROUT); const bf16_t* H1W = (const bf16_t*)(a.ws + WS_HN1); const float* ssq = (const float*)(a.ws + WS_SSQ1);
    const float* rb = (const float*)a.in[I_RB];
    int* topi = (int*)(a.ws + WS_TOPI); float* topg = (float*)(a.ws + WS_TOPG); float* rstd1 = (float*)(a.ws + WS_RSTD1); int* bh = (int*)(a.ws + WS_BH);
    LAS bf16_t* RL = (LAS bf16_t*)lds;
    LAS float* LG = (LAS float*)(lds + 66048) + w * (16 * 33);
    LAS int* hist = (LAS int*)(lds + 66048 + 8 * 16 * 33 * 4);
#pragma unroll
    for (int i = 0; i < 8; ++i) { const int p = tid + 512 * i, e = p >> 7, sg = p & 127; *(LAS u32x4*)(RL + e * 1032 + sg * 8) = *(const u32x4*)(RT + (size_t)e * D + sg * 8); }
    for (int tb = blockIdx.x; tb < T / 128; tb += G) {
        if (tid < 32) hist[tid] = 0;
        __syncthreads();
        const size_t t0 = (size_t)tb * 128 + 16 * w;
        f32x4 acc0 = {0.f, 0.f, 0.f, 0.f}, acc1 = {0.f, 0.f, 0.f, 0.f};
#pragma unroll 16
        for (int kk = 0; kk < 32; ++kk) { const bf16x8 B = *(const bf16x8*)(H1W + (t0 + fr) * D + 32 * kk + 8 * fq);
            const bf16x8 A0 = *(const LAS bf16x8*)(RL + fr * 1032 + 32 * kk + 8 * fq), A1 = *(const LAS bf16x8*)(RL + (16 + fr) * 1032 + 32 * kk + 8 * fq);
            acc0 = __builtin_amdgcn_mfma_f32_16x16x32_bf16(A0, B, acc0, 0, 0, 0); acc1 = __builtin_amdgcn_mfma_f32_16x16x32_bf16(A1, B, acc1, 0, 0, 0); }
#pragma unroll
        for (int j = 0; j < 4; ++j) { LG[fr * 33 + 4 * fq + j] = acc0[j]; LG[fr * 33 + 16 + 4 * fq + j] = acc1[j]; }
        LDS_WAIT(); asm volatile("" ::: "memory");
        if (lane < 16) {
            const size_t t = t0 + lane; float sq = 0.f;
#pragma unroll
            for (int q = 0; q < 4; ++q) { const f32x4 v = *(const f32x4*)(ssq + t * 16 + 4 * q); sq += (v[0] + v[1]) + (v[2] + v[3]); }
            const float rstd = __builtin_amdgcn_rsqf(sq * (1.f / D) + NORM_EPS);
            float v0 = -3.0e38f, v1 = -3.0e38f, v2 = -3.0e38f, v3 = -3.0e38f; int i0 = 0, i1 = 0, i2 = 0, i3 = 0;
#pragma unroll
            for (int e = 0; e < NE; ++e) { const float v = LG[lane * 33 + e] * rstd + rb[e];
                if (v > v3) { if (v > v2) { v3 = v2; i3 = i2; if (v > v1) { v2 = v1; i2 = i1; if (v > v0) { v1 = v0; i1 = i0; v0 = v; i0 = e; } else { v1 = v; i1 = e; } } else { v2 = v; i2 = e; } } else { v3 = v; i3 = e; } } }
            const float e1 = __expf(v1 - v0), e2 = __expf(v2 - v0), e3 = __expf(v3 - v0), inv = 1.0f / (1.0f + e1 + e2 + e3);
            *(int4*)(topi + t * 4) = make_int4(i0, i1, i2, i3); *(float4*)(topg + t * 4) = make_float4(inv, e1 * inv, e2 * inv, e3 * inv); rstd1[t] = rstd;
            lds_inc(&hist[i0]); lds_inc(&hist[i1]); lds_inc(&hist[i2]); lds_inc(&hist[i3]);
        }
        __syncthreads();
        if (tid < 32) bh[tb * 32 + tid] = hist[tid];
        __syncthreads();
    }
}
__device__ __forceinline__ void vtab_put(unsigned* vt, int pos, unsigned tok) {
    const int tile = pos >> 8, r = pos & 255, hh = r >> 7, R = r & 127, rg = R >> 4, rr = R & 15;
#pragma unroll
    for (int ch = 0; ch < 2; ++ch)
#pragma unroll
        for (int p = 0; p < 4; ++p) { const int st = rg * 2 + ch, ob = rr * 64 + p * 16, sb = ob ^ (((ob >> 9) & 1) << 5), b = st * 1024 + sb, i = b >> 13, td = (b & 8191) >> 4;
            vt[((size_t)tile * 512 + td) * 4 + hh * 2 + i] = tok * (unsigned)(MOE_F8 ? D : 2 * D) + ch * 64 + p * 16; }
}
__device__ __forceinline__ void phase_place(const Args& a, LAS unsigned char* lds, int G) {
    const int tid = threadIdx.x;
    const int* bh = (const int*)(a.ws + WS_BH); const int* topi = (const int*)(a.ws + WS_TOPI); const float* topg = (const float*)(a.ws + WS_TOPG); const float* rstd1 = (const float*)(a.ws + WS_RSTD1);
    int* spos = (int*)(a.ws + WS_SPOS); float* SG = (float*)(a.ws + WS_SG); float* SR = (float*)(a.ws + WS_SR); unsigned* vt = (unsigned*)(a.ws + WS_VTAB);
    unsigned* ctl = (unsigned*)(a.ws + WS_CTL);
    LAS int* pt = (LAS int*)lds; LAS int* pb = pt + 512; LAS int* tot = pb + 512; LAS int* off = tot + 32; LAS int* base = off + 32; LAS int* rank = base + 32;
    constexpr int NTB = T / 128;
    for (int it = 0, tb = blockIdx.x; it == 0 || tb < NTB; ++it, tb += G) {
        const int e = tid & 31, part = tid >> 5; int st = 0, sb = 0;
        for (int b = part; b < NTB; b += 16) { const int v = bh[b * 32 + e]; st += v; if (b < tb) sb += v; }
        pt[tid] = st; pb[tid] = sb;
        __syncthreads();
        if (tid < 32) { int s1 = 0, s2 = 0;
#pragma unroll
            for (int q = 0; q < 16; ++q) { s1 += pt[q * 32 + tid]; s2 += pb[q * 32 + tid]; }
            tot[tid] = s1; base[tid] = s2; rank[tid] = 0; }
        __syncthreads();
        if (tid == 0) { int o = 0; for (int q = 0; q < NE; ++q) { off[q] = o; o += (tot[q] + 255) & ~255; } }
        __syncthreads();
        if (tb < NTB) {
            const int t = tb * 128 + (tid >> 2), k = tid & 3; const int ex = topi[t * 4 + k];
            const int pos = off[ex] + base[ex] + lds_inc(&rank[ex]);
            spos[t * 4 + k] = pos; SG[pos] = topg[t * 4 + k]; SR[pos] = rstd1[t]; vtab_put(vt, pos, (unsigned)t);
        }
        if (it == 0) {
            for (int ex = blockIdx.x; ex < NE; ex += G) { const int n = tot[ex], np = (n + 255) & ~255;
                for (int r = n + tid; r < np; r += 512) { const int pos = off[ex] + r; SG[pos] = 0.f; SR[pos] = 0.f; vtab_put(vt, pos, 0u); } }
            if (blockIdx.x == 0 && tid < 32) ctl[CW_TOT + tid] = (unsigned)tot[tid];
        }
        __syncthreads();
    }
}
__device__ __forceinline__ int build_tiles(const Args& a, LAS unsigned short* te) {
    const unsigned* ctl = (const unsigned*)(a.ws + WS_CTL);
    int o = 0;
    for (int e = 0; e < NE; ++e) { const int n = (int)((ctl[CW_TOT + e] + 255u) >> 8); for (int q = threadIdx.x; q < n; q += 512) te[o + q] = (unsigned short)e; o += n; }
    __syncthreads();
    return o;
}
__device__ __forceinline__ void phase_combine(const Args& a, int vcu, int G) {
    const int tid = threadIdx.x, lane = tid & 63, wave = tid >> 6; const int gw = vcu * 8 + wave, NGW = G * 8;
    bf16_t* hb = (bf16_t*)(a.ws + WS_HN1); unsigned char* h8 = a.ws + WS_H1F8; const unsigned char* Y = a.ws + WS_Y; const int* spos = (const int*)(a.ws + WS_SPOS); float* rstd2 = (float*)(a.ws + WS_RSTD2);
    for (int t = gw; t < T; t += NGW) {
        const int4 ps = *(const int4*)(spos + (size_t)t * 4);
        float v[2][8], y[2][8]; float s = 0.f;
#pragma unroll
        for (int j = 0; j < 2; ++j) { const u32x4 hv = *(const u32x4*)(hb + (size_t)t * D + 8 * lane + 512 * j);
            v[j][0] = bf_lo(hv.x); v[j][1] = bf_hi(hv.x); v[j][2] = bf_lo(hv.y); v[j][3] = bf_hi(hv.y); v[j][4] = bf_lo(hv.z); v[j][5] = bf_hi(hv.z); v[j][6] = bf_lo(hv.w); v[j][7] = bf_hi(hv.w);
#pragma unroll
            for (int q = 0; q < 8; ++q) y[j][q] = 0.f; }
#pragma unroll
        for (int k = 0; k < 4; ++k) { const int pk = k == 0 ? ps.x : (k == 1 ? ps.y : (k == 2 ? ps.z : ps.w));
#pragma unroll
            for (int j = 0; j < 2; ++j) { const u32x2 yv = *(const u32x2*)(Y + (size_t)pk * D + 8 * lane + 512 * j); float f[8];
                fp8x4_to_f32(yv.x, f[0], f[1], f[2], f[3]); fp8x4_to_f32(yv.y, f[4], f[5], f[6], f[7]);
#pragma unroll
                for (int q = 0; q < 8; ++q) y[j][q] += f[q]; } }
#pragma unroll
        for (int j = 0; j < 2; ++j) {
#pragma unroll
            for (int q = 0; q < 8; ++q) { v[j][q] += y[j][q] * 0.0625f; s += v[j][q] * v[j][q]; }
            u32x4 o; o.x = cvt_pk_bf16(v[j][0], v[j][1]); o.y = cvt_pk_bf16(v[j][2], v[j][3]); o.z = cvt_pk_bf16(v[j][4], v[j][5]); o.w = cvt_pk_bf16(v[j][6], v[j][7]);
            *(u32x4*)(hb + (size_t)t * D + 8 * lane + 512 * j) = o;
            u32x2 o8; o8.x = cvt4_fp8(v[j][0], v[j][1], v[j][2], v[j][3]); o8.y = cvt4_fp8(v[j][4], v[j][5], v[j][6], v[j][7]);
            *(u32x2*)(h8 + (size_t)t * D + 8 * lane + 512 * j) = o8; }
        s = wave_sum(s);
        if (lane == 0) rstd2[t] = __builtin_amdgcn_rsqf(s * (1.f / D) + NORM_EPS);
    }
}
__device__ __forceinline__ void phase_final(const Args& a, int vcu, int G) {
    const int tid = threadIdx.x, lane = tid & 63, wave = tid >> 6; const int gw = vcu * 8 + wave, NGW = G * 8;
    float* out = a.out; const bf16_t* h3 = (const bf16_t*)(a.ws + WS_H3B); const float* nw = (const float*)a.in[I_NFIN];
    f32x4 wv[2][2];
#pragma unroll
    for (int j = 0; j < 2; ++j) { wv[j][0] = *(const f32x4*)(nw + 8 * lane + 512 * j); wv[j][1] = *(const f32x4*)(nw + 8 * lane + 512 * j + 4); }
    float scale = 1.0f;
#if MK_DEBUG
    { const unsigned f = *(const unsigned*)(a.ws + WS_CTL + 4 * CW_FAIL); if (f) scale = 1.0f + 0.1f * (float)__builtin_ctz(f); }
#endif
    for (int t = gw; t < T; t += NGW) {
        f32x4 v[2][2]; float s = 0.f;
#pragma unroll
        for (int j = 0; j < 2; ++j) { const u32x4 hv = *(const u32x4*)(h3 + (size_t)t * D + 8 * lane + 512 * j);
            v[j][0] = (f32x4){bf_lo(hv.x), bf_hi(hv.x), bf_lo(hv.y), bf_hi(hv.y)}; v[j][1] = (f32x4){bf_lo(hv.z), bf_hi(hv.z), bf_lo(hv.w), bf_hi(hv.w)};
            s += (v[j][0][0] * v[j][0][0] + v[j][0][1] * v[j][0][1]) + (v[j][0][2] * v[j][0][2] + v[j][0][3] * v[j][0][3]) + (v[j][1][0] * v[j][1][0] + v[j][1][1] * v[j][1][1]) + (v[j][1][2] * v[j][1][2] + v[j][1][3] * v[j][1][3]); }
        const float rstd = __builtin_amdgcn_rsqf(wave_sum(s) * (1.f / D) + NORM_EPS) * scale;
#pragma unroll
        for (int j = 0; j < 2; ++j) { *(f32x4*)(out + (size_t)t * D + 8 * lane + 512 * j) = v[j][0] * rstd * wv[j][0]; *(f32x4*)(out + (size_t)t * D + 8 * lane + 512 * j + 4) = v[j][1] * rstd * wv[j][1]; }
    }
}

__global__ void __launch_bounds__(512, 2) fwd_kernel(Args args) {
    extern __shared__ __attribute__((aligned(16))) unsigned char lds_raw[];
    LAS unsigned char* lds = (LAS unsigned char*)lds_raw;
    const int tid = threadIdx.x, G = gridDim.x;
    const int vcu = (G % 8 == 0) ? ((int)blockIdx.x % 8) * (G / 8) + (int)blockIdx.x / 8 : (int)blockIdx.x;
    volatile LAS unsigned* MISC = (volatile LAS unsigned*)(lds + LCTL_OFF);
    if (tid < 4) MISC[tid] = 0u;
    __syncthreads();
    unsigned* ctl = (unsigned*)(args.ws + WS_CTL);
    XcdBarrier bar; bar.bar = ctl + CW_BAR; bar.x = 0; bar.st = nullptr;
    const int lo = args.ph_lo, hi = args.ph_hi;
    if (hi - lo > 1) bar = xcd_barrier_post(ctl + CW_BAR, MISC);
#ifndef PH_MASK
#define PH_MASK 0x1fff
#endif
#define IN(k) (((PH_MASK >> (k)) & 1) && lo <= (k) && (k) < hi)
#define SEAM(k) do { if (IN(k) && IN((k) + 1)) xcd_barrier(bar); } while (0)
    LAS unsigned short* te = (LAS unsigned short*)(lds + LCTL_OFF + 64);
    const char* ws = (const char*)args.ws;

    if (IN(0)) phase_prologue(args, lds, vcu, G);
    SEAM(0);
    if (IN(1)) {
        { pg8::DenseSched S; S.init(T, NIN, G, (int)blockIdx.x);
          pg8::EpiInProj E{(bf16_t*)(args.ws + WS_Q), (const int*)args.in[I_POS]};
          pg8::gemm_phase<false>(lds, ws + WS_HN1, ws + WS_WIN, D * 2, S, E); }
        { pg8::DenseSched S; S.init(T, D, G, (int)blockIdx.x);
          pg8::EpiPlainF8 E{args.ws + WS_PP, D};
          pg8::gemm_phase<false>(lds, ws + WS_PB, ws + WS_WPT, PLE * 2, S, E); }
    }
    SEAM(1);
    if (IN(2)) { phase_kv(args, lds, G); phase_pool(args, lds, G); }
    SEAM(2);
    if (IN(3)) phase_scan(args, G);
    SEAM(3);
    if (IN(4)) phase_ret(args, lds, G);
    SEAM(4);
    if (IN(5)) {
        pg8::DenseSched S; S.init(T, D, G, (int)blockIdx.x);
        pg8::EpiWout E{(const float*)args.in[I_X], (bf16_t*)(args.ws + WS_HN1), args.ws + WS_H1F8, (float*)(args.ws + WS_SSQ1)};
        pg8::gemm_phase<false>(lds, ws + WS_MIX, ws + WS_WOUT, D * 2, S, E);
    }
    SEAM(5);
    if (IN(6)) phase_router(args, lds, G);
    SEAM(6);
    if (IN(7)) phase_place(args, lds, G);
    SEAM(7);
    if (IN(8)) {
        const int MT = build_tiles(args, te);
        pg8::GroupSchedG S; S.nM = MT; S.nN = 2 * DE / 256; S.G = G; S.c = (int)blockIdx.x; S.NB = 2 * DE; S.te = te; S.vtab = args.ws + WS_VTAB;
        pg8::EpiGateUp E{args.ws + WS_ACT, (const float*)args.in[I_BGU], (const float*)(args.ws + WS_SR)};
        pg8::gemm_phase<MOE_F8 != 0>(lds, MOE_F8 ? ws + WS_H1F8 : ws + WS_HN1, ws + WS_WGU, MOE_F8 ? D : 2 * D, S, E);
    }
    SEAM(8);
    if (IN(9)) {
        const int MT = build_tiles(args, te);
        pg8::GroupSchedD S; S.nM = MT; S.nN = D / 256; S.G = G; S.c = (int)blockIdx.x; S.NB = D; S.te = te; S.vtab = nullptr;
        pg8::EpiDown E{args.ws + WS_Y, (const float*)args.in[I_BD], (const float*)(args.ws + WS_SG)};
        pg8::gemm_phase<MOE_F8 != 0>(lds, ws + WS_ACT, ws + WS_WD, MOE_F8 ? DE : 2 * DE, S, E);
    }
    SEAM(9);
    if (IN(10)) phase_combine(args, vcu, G);
    SEAM(10);
    if (IN(11)) {
        pg8::DenseSched S; S.init(T, D, G, (int)blockIdx.x);
        pg8::EpiPle E{(bf16_t*)(args.ws + WS_H3B), (const bf16_t*)(args.ws + WS_HN1), args.ws + WS_PP, (const float*)(args.ws + WS_RSTD2)};
        pg8::gemm_phase<true>(lds, ws + WS_H1F8, ws + WS_WG, D, S, E);
    }
    SEAM(11);
    if (IN(12)) phase_final(args, vcu, G);
#undef IN
#undef SEAM
}


extern "C" void kernel_launch(void* const* d_in, const int* in_sizes, int n_in, void* d_out, int out_size, void* d_ws, size_t ws_size, hipStream_t stream) {
    static int grid = 0;
    if (grid == 0) {
        if (n_in != 20 || in_sizes[0] != T * D || out_size != T * D || ws_size < WS_END) { fprintf(stderr, "kernel_launch: unexpected shapes (n_in %d, in0 %d, out %d, ws %zu < %zu)\n", n_in, n_in > 0 ? in_sizes[0] : -1, out_size, ws_size, (size_t)WS_END); grid = -1; return; }
        int dev = 0, cus = 0, per_cu = 0;
        if (hipGetDevice(&dev) != hipSuccess || hipDeviceGetAttribute(&cus, hipDeviceAttributeMultiprocessorCount, dev) != hipSuccess) { grid = -1; return; }
        if (hipFuncSetAttribute((const void*)fwd_kernel, hipFuncAttributeMaxDynamicSharedMemorySize, LDS_BYTES) != hipSuccess) { fprintf(stderr, "kernel_launch: hipFuncSetAttribute failed\n"); grid = -1; return; }
        if (hipOccupancyMaxActiveBlocksPerMultiprocessor(&per_cu, (const void*)fwd_kernel, 512, LDS_BYTES) != hipSuccess || per_cu < 1) { fprintf(stderr, "kernel_launch: occupancy query says %d\n", per_cu); (void)hipGetLastError(); }
        grid = cus;
    }
    if (grid < 0) return;
    if (hipMemsetAsync((char*)d_ws + WS_CTL, 0, CTL_ZERO_BYTES, stream) != hipSuccess) return;
    Args a{};
    for (int i = 0; i < 20; ++i) a.in[i] = d_in[i];
    a.out = (float*)d_out; a.ws = (unsigned char*)d_ws;
#if MK_PER_PHASE
    for (int p = 0; p < NPH; ++p) { a.ph_lo = p; a.ph_hi = p + 1; for (int r = 0; r < 1 + ((MK_REPEAT >> p) & 1); ++r) hipLaunchKernelGGL(fwd_kernel, dim3(grid), dim3(512), LDS_BYTES, stream, a); }
#else
    a.ph_lo = 0; a.ph_hi = NPH; hipLaunchKernelGGL(fwd_kernel, dim3(grid), dim3(512), LDS_BYTES, stream, a);
#endif
}
```
